# Optimizing an MI355X kernel written in HIP

```python
import math
import numpy as np
import jax
import jax.numpy as jnp
from jax import lax

D_MODEL = 1024
BATCH = 8
SEQ = 4096
DEPTH = 1

HEAD_DIM = 64
GRID_W = 64
NA_HEADS = 8
NA_WIN_ROWS = 8
NA_WIN_COLS = 16
NA_QCOL_BLOCK = 16
NA_KCOL_BLOCK = NA_QCOL_BLOCK + NA_WIN_COLS
DIL_CONFIGS = ((128, 1), (512, 4), (2048, 16))
DIL_HEADS_PER_GROUP = 4
DIL_N_GROUPS = len(DIL_CONFIGS)
DIL_QBLOCK = 64
ROT_DIM = HEAD_DIM // 4
ROPE_THETA = 500000.0
NA_WIDTH = NA_HEADS * HEAD_DIM
DIL_WIDTH = DIL_N_GROUPS * DIL_HEADS_PER_GROUP * HEAD_DIM
DIL_OUT_WIDTH = DIL_HEADS_PER_GROUP * HEAD_DIM
IN_WIDTH = 3 * NA_WIDTH + 3 * DIL_WIDTH + 2 * D_MODEL
PEER_HEADS = 8
PEER_NKEYS = 128
PEER_NEXPERTS = PEER_NKEYS * PEER_NKEYS
PEER_QDIM = 256
PEER_TOPK = 16
PEER_CHUNK = 256
PLE_DIM = 256
RMS_EPS = 1e-6

kernel_name = "hybrid_na_dilated_peer_block"


def rms_norm(x, gain):
    x32 = x.astype(jnp.float32)
    y = x32 * lax.rsqrt(jnp.mean(x32 * x32, axis=-1, keepdims=True) + RMS_EPS)
    return (y * gain.astype(jnp.float32)).astype(x.dtype)


def partial_rotary(x, pos):
    half = ROT_DIM // 2
    inv_freq = jnp.power(jnp.float32(ROPE_THETA), -jnp.arange(half, dtype=jnp.float32) * 2.0 / ROT_DIM)
    ang = pos.astype(jnp.float32)[:, None] * inv_freq[None, :]
    cos = jnp.cos(ang)[:, None, :]
    sin = jnp.sin(ang)[:, None, :]
    xr = x[..., :ROT_DIM].astype(jnp.float32)
    x1, x2 = xr[..., :half], xr[..., half:]
    rot = jnp.concatenate([x1 * cos - x2 * sin, x2 * cos + x1 * sin], axis=-1)
    return jnp.concatenate([rot.astype(x.dtype), x[..., ROT_DIM:]], axis=-1)


def _na_static(width):
    ncb = width // NA_QCOL_BLOCK
    qc = np.arange(width).reshape(ncb, NA_QCOL_BLOCK)
    kc_start = np.clip(np.arange(ncb) * NA_QCOL_BLOCK - NA_WIN_COLS // 2, 0, width - NA_KCOL_BLOCK)
    kc = kc_start[:, None] + np.arange(NA_KCOL_BLOCK)[None, :]
    cs = np.clip(qc - NA_WIN_COLS // 2, 0, width - NA_WIN_COLS)
    kcb = kc[:, None, :]
    mask = (kcb >= cs[..., None]) & (kcb < cs[..., None] + NA_WIN_COLS)
    dc_idx = np.clip(kcb - qc[..., None] + NA_WIN_COLS - 1, 0, 2 * NA_WIN_COLS - 2)
    return kc, mask, dc_idx


def neighbourhood_attention(q, k, v, rpb):
    B, S, H, dh = q.shape
    rows = S // GRID_W
    kh = min(NA_WIN_ROWS, rows)
    ncb = GRID_W // NA_QCOL_BLOCK
    kc, mask, dc_idx = _na_static(GRID_W)
    mask_j = jnp.asarray(mask)[None, None, :, :, None, :]
    qg = q.reshape(B, rows, GRID_W, H, dh)
    kg = k.reshape(B, rows, GRID_W, H, dh)
    vg = v.reshape(B, rows, GRID_W, H, dh)
    scale = HEAD_DIM ** -0.5

    def one_row(r):
        rs = jnp.clip(r - kh // 2, 0, rows - kh)
        q_row = lax.dynamic_index_in_dim(qg, r, axis=1, keepdims=False)
        k_rows = lax.dynamic_slice_in_dim(kg, rs, kh, axis=1)
        v_rows = lax.dynamic_slice_in_dim(vg, rs, kh, axis=1)
        q_cb = q_row.reshape(B, ncb, NA_QCOL_BLOCK, H, dh)
        k_cb = jnp.take(k_rows, kc, axis=2)
        v_cb = jnp.take(v_rows, kc, axis=2)
        s = jnp.einsum('bjqhd,bljkhd->bhjqlk', q_cb, k_cb).astype(jnp.float32) * scale
        dr_idx = rs + jnp.arange(kh) - r + NA_WIN_ROWS - 1
        bias = rpb[:, dr_idx][:, :, dc_idx]
        bias = bias.transpose(0, 2, 3, 1, 4).astype(jnp.float32)
        s = jnp.where(mask_j, s + bias[None], -jnp.inf)
        shp = s.shape
        pr = jax.nn.softmax(s.reshape(shp[:4] + (kh * NA_KCOL_BLOCK,)), axis=-1).reshape(shp)
        o = jnp.einsum('bhjqlk,bljkhd->bjqhd', pr.astype(v.dtype), v_cb)
        return o.reshape(B, GRID_W, H, dh)

    out = lax.map(one_row, jnp.arange(rows))
    return out.transpose(1, 0, 2, 3, 4).reshape(B, S, H * dh)


def dilated_window_attention(q, k, v, window, dilation):
    B, S, H, dh = q.shape
    n = window // (2 * dilation)
    L = S // dilation
    qbs = math.gcd(L, DIL_QBLOCK)
    nblk = L // qbs
    kbs = qbs + 2 * n

    def to_res(t):
        return t.reshape(B, L, dilation, H, dh).transpose(0, 2, 1, 3, 4)

    qr, kr, vr = to_res(q), to_res(k), to_res(v)
    pad = ((0, 0), (0, 0), (n, n), (0, 0), (0, 0))
    kp = jnp.pad(kr, pad)
    vp = jnp.pad(vr, pad)
    kidx = (np.arange(nblk) * qbs)[:, None] + np.arange(kbs)[None, :]
    kb = jnp.take(kp, kidx, axis=2)
    vb = jnp.take(vp, kidx, axis=2)
    qb = qr.reshape(B, dilation, nblk, qbs, H, dh)
    s = jnp.einsum('brnqhd,brnkhd->brnhqk', qb, kb).astype(jnp.float32) * (HEAD_DIM ** -0.5)
    qi = np.arange(qbs)[:, None]
    kj = np.arange(kbs)[None, :]
    band = (kj - qi >= 0) & (kj - qi <= 2 * n)
    m_key = kidx - n
    inside = (m_key >= 0) & (m_key < L)
    mask = band[None] & inside[:, None, :]
    s = jnp.where(jnp.asarray(mask)[None, None, :, None, :, :], s, -jnp.inf)
    lse = jax.nn.logsumexp(s, axis=-1, keepdims=True)
    pr = jnp.exp(s - lse).astype(v.dtype)
    o = jnp.einsum('brnhqk,brnkhd->brnqhd', pr, vb)
    o = o.reshape(B, dilation, L, H, dh).transpose(0, 2, 1, 3, 4).reshape(B, S, H, dh)
    lse = lse[..., 0].transpose(0, 1, 2, 4, 3).reshape(B, dilation, L, H)
    lse = lse.transpose(0, 2, 1, 3).reshape(B, S, H)
    return o, lse


def peer_ffn(h, w_query, sub_keys, expert_u, expert_v):
    B, S, D = h.shape
    T = B * S
    chunk = math.gcd(T, PEER_CHUNK)
    half = PEER_QDIM // 2
    hf = h.reshape(T // chunk, chunk, D)
    k1 = sub_keys[0].astype(jnp.float32)
    k2 = sub_keys[1].astype(jnp.float32)

    def run(hc):
        q = (hc @ w_query).reshape(chunk, PEER_HEADS, PEER_QDIM).astype(jnp.float32)
        s1 = jnp.einsum('thd,nd->thn', q[..., :half], k1)
        s2 = jnp.einsum('thd,nd->thn', q[..., half:], k2)
        v1, i1 = lax.top_k(s1, PEER_TOPK)
        v2, i2 = lax.top_k(s2, PEER_TOPK)
        cand = (v1[..., :, None] + v2[..., None, :]).reshape(chunk, PEER_HEADS, PEER_TOPK * PEER_TOPK)
        cidx = (i1[..., :, None] * PEER_NKEYS + i2[..., None, :]).reshape(chunk, PEER_HEADS, PEER_TOPK * PEER_TOPK)
        sc, pos = lax.top_k(cand, PEER_TOPK)
        eidx = jnp.take_along_axis(cidx, pos, axis=-1)
        g = jax.nn.softmax(sc, axis=-1)
        u = jnp.take(expert_u, eidx, axis=0)
        a = jnp.einsum('thkd,td->thk', u, hc).astype(jnp.float32)
        act = (jax.nn.gelu(a, approximate=False) * g).astype(hc.dtype)
        vv = jnp.take(expert_v, eidx, axis=0)
        return jnp.einsum('thk,thkd->td', act, vv)

    return lax.map(run, hf).reshape(B, S, D)


def setup_inputs(seed: int = 0) -> dict:
    key = jax.random.key(seed)
    ks = jax.random.split(key, 20)

    def nrm(k, shape, scale):
        return jax.random.normal(k, shape, jnp.float32) * scale

    def gain(k, shape):
        return 1.0 + 0.05 * jax.random.normal(k, shape, jnp.float32)

    return {
        "x": nrm(ks[0], (BATCH, SEQ, D_MODEL), 1.0),
        "p": nrm(ks[1], (DEPTH, BATCH, SEQ, PLE_DIM), 1.0),
        "norm_mix": gain(ks[2], (DEPTH, D_MODEL)),
        "w_in": nrm(ks[3], (DEPTH, D_MODEL, IN_WIDTH), D_MODEL ** -0.5),
        "qk_norm_na": gain(ks[4], (DEPTH, 2, HEAD_DIM)),
        "na_rel_bias": nrm(ks[5], (DEPTH, NA_HEADS, 2 * NA_WIN_ROWS - 1, 2 * NA_WIN_COLS - 1), 0.2),
        "qk_norm_dil": gain(ks[6], (DEPTH, 2, HEAD_DIM)),
        "w_branch_na": nrm(ks[7], (DEPTH, NA_WIDTH, D_MODEL), NA_WIDTH ** -0.5),
        "w_branch_dil": nrm(ks[8], (DEPTH, DIL_OUT_WIDTH, D_MODEL), DIL_OUT_WIDTH ** -0.5),
        "w_out": nrm(ks[9], (DEPTH, D_MODEL, D_MODEL), D_MODEL ** -0.5),
        "norm_ffn": gain(ks[10], (DEPTH, D_MODEL)),
        "peer_w_query": nrm(ks[11], (DEPTH, D_MODEL, PEER_HEADS * PEER_QDIM), D_MODEL ** -0.5),
        "peer_sub_keys": nrm(ks[12], (DEPTH, 2, PEER_NKEYS, PEER_QDIM // 2), (PEER_QDIM // 2) ** -0.5),
        "peer_expert_u": nrm(ks[13], (DEPTH, PEER_NEXPERTS, D_MODEL), D_MODEL ** -0.5),
        "peer_expert_v": nrm(ks[14], (DEPTH, PEER_NEXPERTS, D_MODEL), PEER_HEADS ** -0.5),
        "norm_ple": gain(ks[15], (DEPTH, D_MODEL)),
        "w_ple_gate": nrm(ks[16], (DEPTH, D_MODEL, D_MODEL), D_MODEL ** -0.5),
        "w_ple": nrm(ks[17], (DEPTH, PLE_DIM, D_MODEL), PLE_DIM ** -0.5),
    }


def reference(x, p, norm_mix, w_in, qk_norm_na, na_rel_bias, qk_norm_dil, w_branch_na, w_branch_dil,
              w_out, norm_ffn, peer_w_query, peer_sub_keys, peer_expert_u, peer_expert_v,
              norm_ple, w_ple_gate, w_ple):
    B, S, D = x.shape
    pos = jnp.arange(S)
    splits = [int(c) for c in np.cumsum([NA_WIDTH] * 3 + [DIL_WIDTH] * 3 + [D_MODEL])]
    n_dil_heads = DIL_N_GROUPS * DIL_HEADS_PER_GROUP
    for i in range(DEPTH):
        h = rms_norm(x, norm_mix[i])
        proj = h @ w_in[i]
        qa, ka, va, qd, kd, vd, gate_na, gate_dil = jnp.split(proj, splits, axis=-1)

        qa = rms_norm(qa.reshape(B, S, NA_HEADS, HEAD_DIM), qk_norm_na[i, 0])
        ka = rms_norm(ka.reshape(B, S, NA_HEADS, HEAD_DIM), qk_norm_na[i, 1])
        va = va.reshape(B, S, NA_HEADS, HEAD_DIM)
        out_na = neighbourhood_attention(qa, ka, va, na_rel_bias[i])

        qd = partial_rotary(rms_norm(qd.reshape(B, S, n_dil_heads, HEAD_DIM), qk_norm_dil[i, 0]), pos)
        kd = partial_rotary(rms_norm(kd.reshape(B, S, n_dil_heads, HEAD_DIM), qk_norm_dil[i, 1]), pos)
        qd = qd.reshape(B, S, DIL_N_GROUPS, DIL_HEADS_PER_GROUP, HEAD_DIM)
        kd = kd.reshape(B, S, DIL_N_GROUPS, DIL_HEADS_PER_GROUP, HEAD_DIM)
        vd = vd.reshape(B, S, DIL_N_GROUPS, DIL_HEADS_PER_GROUP, HEAD_DIM)
        outs, lses = [], []
        for g, (window, dilation) in enumerate(DIL_CONFIGS):
            o_g, lse_g = dilated_window_attention(qd[:, :, g], kd[:, :, g], vd[:, :, g], window, dilation)
            outs.append(o_g)
            lses.append(lse_g)
        wts = jax.nn.softmax(jnp.stack(lses, axis=2), axis=2)
        out_dil = jnp.sum(wts[..., None] * jnp.stack(outs, axis=2).astype(jnp.float32), axis=2)
        out_dil = out_dil.astype(x.dtype).reshape(B, S, DIL_OUT_WIDTH)

        merged = (jax.nn.sigmoid(gate_na) * (out_na @ w_branch_na[i])
                  + jax.nn.sigmoid(gate_dil) * (out_dil @ w_branch_dil[i]))
        x = x + merged @ w_out[i]

        h = rms_norm(x, norm_ffn[i])
        x = x + peer_ffn(h, peer_w_query[i], peer_sub_keys[i], peer_expert_u[i], peer_expert_v[i])

        h = rms_norm(x, norm_ple[i])
        x = x + jax.nn.sigmoid(h @ w_ple_gate[i]) * (p[i] @ w_ple[i])
    return x
```

```cpp
#include <hip/hip_runtime.h>
#include <cstdio>
#include <cstdint>

#ifndef PEER_V_MFMA
#define PEER_V_MFMA 2
#endif
#ifndef MK_N_LAUNCHES
#define MK_N_LAUNCHES 1
#endif

#ifndef PROBE_REPEAT_MASK
#define PROBE_REPEAT_MASK 0
#endif
#ifndef REDUCE8
#define REDUCE8 reduce8
#endif
#ifndef PROBE_PRO
#define PROBE_PRO 0
#endif
#ifndef PHMASK
#define PHMASK 0xfff
#endif
#ifndef PROBE_PHASE
#define PROBE_PHASE -1
#endif
#ifndef PROBE_NOREPEAT
#define PROBE_NOREPEAT 0
#endif
#ifndef USE_REF_ATTN
#define USE_REF_ATTN 0
#endif
#ifndef PROBE_REPS
#define PROBE_REPS 1
#endif
#define LAS __attribute__((address_space(3)))
#define GAS __attribute__((address_space(1)))
typedef unsigned short bf16_t;
typedef short bf16x8 __attribute__((ext_vector_type(8)));
typedef float f32x4 __attribute__((ext_vector_type(4)));
typedef float f32x2 __attribute__((ext_vector_type(2)));
typedef unsigned u32x4 __attribute__((ext_vector_type(4)));
typedef unsigned u32x2 __attribute__((ext_vector_type(2)));
typedef __bf16 bf16v2 __attribute__((ext_vector_type(2)));
typedef _Float16 h16x8 __attribute__((ext_vector_type(8)));

constexpr int D = 1024, BATCH = 8, SEQ = 4096, T = BATCH * SEQ;
constexpr int NA_H = 8, DIL_H = 12, HD = 64;
constexpr int IN_W = 5888;
constexpr int NEXP = 16384;
constexpr float RMS_EPS = 1e-6f;
constexpr float LOG2E = 1.4426950408889634f;
constexpr float QSCALE = 0.125f * LOG2E;

constexpr size_t MiB = 1u << 20;
constexpr size_t WS_CTL = 0, CTL_ZERO_BYTES = 64 * 1024;
constexpr size_t WS_RSTD1 = 1 * MiB, WS_RSTD3 = 1 * MiB + 256 * 1024, WS_COS = 1 * MiB + 512 * 1024, WS_SIN = 1 * MiB + 768 * 1024;
constexpr size_t WS_SSQ2 = 2 * MiB;
constexpr size_t WS_LSE = 4 * MiB;
constexpr size_t WS_WIN = 8 * MiB, WS_WNA = 20 * MiB, WS_WDIL = 21 * MiB, WS_WOUT = 22 * MiB, WS_WSC = 24 * MiB, WS_WG = 28 * MiB, WS_WPLE = 30 * MiB;
constexpr size_t WS_EU = 32 * MiB, WS_EV = 48 * MiB, WS_PB = 96 * MiB;
constexpr size_t WS_SU = 6 * MiB, WS_SV = 6 * MiB + 65536;
constexpr size_t WS_QNA = 112 * MiB, WS_KNA = 144 * MiB, WS_VNA = 176 * MiB;
constexpr size_t WS_QDIL = 208 * MiB, WS_KDIL = 256 * MiB, WS_VDIL = 304 * MiB;
constexpr size_t WS_GATES = 352 * MiB;
constexpr size_t WS_MERGED = 112 * MiB;
constexpr size_t WS_TMP1 = 208 * MiB;
constexpr size_t WS_X1B = 176 * MiB;
constexpr size_t WS_SCORES = 240 * MiB;
constexpr size_t WS_RIDX = 112 * MiB, WS_RG = 128 * MiB;
constexpr size_t WS_PART = 240 * MiB;
constexpr size_t WS_COEF = 368 * MiB;
constexpr size_t WS_X2B = 384 * MiB;
constexpr size_t WS_TMP2 = 176 * MiB;
constexpr size_t WS_SSQ3 = 7 * MiB;
constexpr size_t WS_COEF8 = 144 * MiB;
constexpr size_t WS_HQ = 144 * MiB;
constexpr size_t WS_HS = 4 * MiB;
constexpr size_t WS_END = 512 * MiB;
constexpr int CW_QU = 12288, CW_QV = 12288 + 512;
constexpr size_t DO_XB = 0, DO_OG = 64 * MiB, DO_OUTDIL = 112 * MiB;
constexpr size_t WS_OUTNA = 480 * MiB;
constexpr int ACAT = 768;

constexpr int CW_BAR = 1024;

constexpr int RING_BYTES = 131072;
constexpr int EPI_OFF = RING_BYTES;
constexpr int MISC_OFF = 162816;
constexpr int LDS_BYTES = 163840;

__device__ __forceinline__ unsigned f2bf(float f) { unsigned u = __builtin_bit_cast(unsigned, f); return (u + 0x7fffu + ((u >> 16) & 1u)) >> 16; }
__device__ __forceinline__ unsigned pk2(float lo, float hi) { return f2bf(lo) | (f2bf(hi) << 16); }
__device__ __forceinline__ float bf_lo(unsigned w) { return __builtin_bit_cast(float, w << 16); }
__device__ __forceinline__ float bf_hi(unsigned w) { return __builtin_bit_cast(float, w & 0xffff0000u); }
__device__ __forceinline__ float bf2f(bf16_t b) { return __builtin_bit_cast(float, ((unsigned)b) << 16); }
__device__ __forceinline__ float wave_sum(float v) {
#pragma unroll
    for (int o = 1; o < 64; o <<= 1) v += __shfl_xor(v, o);
    return v;
}
__device__ __forceinline__ float wave_max(float v) {
#pragma unroll
    for (int o = 1; o < 64; o <<= 1) v = fmaxf(v, __shfl_xor(v, o));
    return v;
}
template <int CTRL> __device__ __forceinline__ float dppc(float v) { return __builtin_bit_cast(float, __builtin_amdgcn_update_dpp(0, __builtin_bit_cast(int, v), CTRL, 0xf, 0xf, true)); }
__device__ __forceinline__ float wave_sum_dpp(float t) {
    t += dppc<0xB1>(t); t += dppc<0x4E>(t); t += dppc<0x141>(t); t += dppc<0x128>(t);
    { float a = t, b = t; asm volatile("s_nop 1\n\tv_permlane16_swap_b32 %0, %1" : "+v"(a), "+v"(b)); t = a + b; }
    { float a = t, b = t; asm volatile("s_nop 1\n\tv_permlane32_swap_b32 %0, %1" : "+v"(a), "+v"(b)); t = a + b; }
    return t;
}
__device__ __forceinline__ void swap16(float& a, float& b) { asm("s_nop 1\n\tv_permlane16_swap_b32 %0, %1" : "+v"(a), "+v"(b)); }
__device__ __forceinline__ void swap32(float& a, float& b) { asm("s_nop 1\n\tv_permlane32_swap_b32 %0, %1" : "+v"(a), "+v"(b)); }
__device__ __forceinline__ float sum_x16_x32(float t) { float a = t, b = t; swap16(a, b); t = a + b; a = t; b = t; swap32(a, b); return a + b; }
__device__ __forceinline__ float max_x16_x32(float t) { float a = t, b = t; swap16(a, b); t = fmaxf(a, b); a = t; b = t; swap32(a, b); return fmaxf(a, b); }
__device__ __forceinline__ float other_x16(float t, int lane) { float a = t, b = t; swap16(a, b); return (lane & 16) ? a : b; }
__device__ __forceinline__ float sigmoidf_(float v) { return 1.0f / (1.0f + __expf(-v)); }
__device__ __forceinline__ float gelu_erf(float v) {
    const float av = fabsf(v), t = __builtin_amdgcn_rcpf(av * 0.2316418882f + 1.0f);
    float q = t * 0.5307027145f + (-0.7265760135f); q = q * t + 0.7107068705f; q = q * t + (-0.142248368f); q = q * t + 0.127414796f; q = q * t;
    const float e = __builtin_amdgcn_exp2f(v * v * (-0.72134752044f));
    const float m = v * (q * e);
    return v < 0.f ? m : v - m;
}

__device__ __forceinline__ int opaque_tid();
namespace pg8 {
#define PG8_LAS __attribute__((address_space(3)))
constexpr int BM = 256, BK = 64, HALF = 128, HTB = HALF * BK * 2, STAGE_BYTES = 8 * HTB, NXCD = 8, WGM = 8;
__host__ __device__ __forceinline__ int lds_byte(int r, int c) { const int st = (r >> 4) * 2 + (c >> 5), rr = r & 15, cc = c & 31, ob = rr * 64 + cc * 2; return st * 1024 + (ob ^ (((ob >> 9) & 1) << 5)); }
__host__ __device__ __forceinline__ void stage_rc(int b, int& R, int& C) { const int st = b / 1024, sb = b % 1024, swz = sb ^ (((sb >> 9) & 1) << 5); R = (st >> 1) * 16 + swz / 64; C = (st & 1) * 32 + (swz % 64) / 2; }
__host__ __device__ __forceinline__ int perm32(int rho) { const int n = rho >> 4, i = rho & 15; return 8 * (i >> 2) + 4 * n + (i & 3); }
struct Unit { int pm, pn; };
struct Gemm { const bf16_t* A; const bf16_t* Bt; int M, N, K; };
struct StaticOrder {
    int nM, nN, nwg, G, c;
    __host__ __device__ void init(int M, int N, int G_, int c_) { nM = M / BM; nN = N / BM; nwg = nM * nN; G = G_; c = c_; }
    __host__ __device__ bool next(int i, Unit& u) const {
        const long L = (long)i * G + c; if (L >= nwg) return false;
        int wgid = (int)L; { const int q = nwg / NXCD, r = nwg % NXCD, xcd = wgid % NXCD, off = wgid / NXCD; wgid = (xcd < r ? xcd * (q + 1) : r * (q + 1) + (xcd - r) * q) + off; }
        const int nig = WGM * nN, gid = wgid / nig, fm = gid * WGM, gsz = (nM - fm) < WGM ? (nM - fm) : WGM;
        u.pm = fm + ((wgid % nig) % gsz); u.pn = (wgid % nig) / gsz; return true;
    }
    __device__ __forceinline__ void a_ready(const Unit&) const {}
    __device__ __forceinline__ void done(const Unit&) const {}
};
struct SingleOrder {
    StaticOrder S; int i;
    __device__ bool next(int k, Unit& u) const { return k == 0 ? S.next(i, u) : false; }
    __device__ __forceinline__ void a_ready(const Unit&) const {}
    __device__ __forceinline__ void done(const Unit&) const {}
};
__device__ __forceinline__ unsigned cvt_pk_bf16(float lo, float hi) { unsigned r; asm volatile("v_cvt_pk_bf16_f32 %0, %1, %2" : "=v"(r) : "v"(lo), "v"(hi)); return r; }

typedef int i32x4v __attribute__((ext_vector_type(4)));
typedef int i32x8v __attribute__((ext_vector_type(8)));
template <bool FP8> struct FragSel;
template <> struct FragSel<false> {
    struct type { bf16x8 k[2]; };
    static __device__ __forceinline__ void load(type& d, const PG8_LAS unsigned char* p) { d.k[0] = *(const PG8_LAS bf16x8*)p; d.k[1] = *(const PG8_LAS bf16x8*)(p + 1024); }
    static __device__ __forceinline__ f32x4 mma(const type& a, const type& b, f32x4 c, int) { c = __builtin_amdgcn_mfma_f32_16x16x32_bf16(a.k[0], b.k[0], c, 0, 0, 0); return __builtin_amdgcn_mfma_f32_16x16x32_bf16(a.k[1], b.k[1], c, 0, 0, 0); }
};
template <> struct FragSel<true> {
    typedef i32x8v type;
    static __device__ __forceinline__ void load(type& d, const PG8_LAS unsigned char* p) { const i32x4v lo = *(const PG8_LAS i32x4v*)p, hi = *(const PG8_LAS i32x4v*)(p + 1024); d = __builtin_shufflevector(lo, hi, 0, 1, 2, 3, 4, 5, 6, 7); }
    static __device__ __forceinline__ f32x4 mma(const type& a, const type& b, f32x4 c, int sc) {
        asm volatile("v_mfma_scale_f32_16x16x128_f8f6f4 %0, %1, %2, %0, %3, %3 op_sel_hi:[0,0,0]" : "+v"(c) : "v"(a), "v"(b), "v"(sc));
        return c; }
};
template <class E, class = void> struct MidTiles { static constexpr int v = 0; };
template <class E> struct MidTiles<E, decltype((void)E::MID_TILES)> { static constexpr int v = E::MID_TILES; };
template <class Epi, class Sched, bool ALIGN_EPI = true, bool SP2 = true, bool FP8 = false>
__device__ __forceinline__ void gemm_phase(PG8_LAS unsigned char* lds, const Gemm g, const Sched& S, const Epi& E) {
    const int tid = opaque_tid(), wid = __builtin_amdgcn_readfirstlane(tid >> 6), lane = tid & 63, wr = wid >> 2, wc = wid & 3, fr = lane & 15, fq = lane >> 4;
    int sc7f = 0x7F7F7F7F; if constexpr (FP8) asm volatile("" : "+v"(sc7f));
    const int K = g.K, nt = FP8 ? K / 128 : K / BK;
    const int KB = FP8 ? K : 2 * K;
    unsigned voffA[2], voffB[2];
#pragma unroll
    for (int i = 0; i < 2; ++i) { int R, C; stage_rc(tid * 16 + i * 8192, R, C); const int Rb = 64 * (R >> 5) + perm32(R & 31);
        voffA[i] = (unsigned)(R * KB + 2 * C); voffB[i] = (unsigned)(Rb * KB + 2 * C); }
    const size_t kstep = (size_t)(BK * 2);
    const size_t hstep = (size_t)HALF * KB;
    const size_t hstepB = (size_t)32 * KB;
    const size_t tstep = 2 * hstep;
    const unsigned ldsw = (unsigned)wid * 1024u;
    const int aoff = lds_byte(wr * 64 + fr, fq * 8), boff = lds_byte(wc * 32 + fr, fq * 8);
#define PG8_SA(b, h) (((b) * 2 + (h)) * HTB)
#define PG8_SB(b, h) ((4 + (b) * 2 + (h)) * HTB)
#define PG8_STAGE(bufoff, gbase, voff) do { _Pragma("unroll") for (int _i = 0; _i < 2; ++_i) \
        __builtin_amdgcn_global_load_lds((const unsigned*)((const char*)(gbase) + (voff)[_i]), (PG8_LAS unsigned*)(lds + (bufoff) + ldsw + _i * 8192), 16, 0, 0); } while (0)
#define PG8_LDA(dst, b, h) do { _Pragma("unroll") for (int m = 0; m < 4; ++m) FragSel<FP8>::load(dst[m], lds + PG8_SA(b, h) + aoff + m * 2048); } while (0)
#define PG8_LDB(dst, b, h) do { _Pragma("unroll") for (int n = 0; n < 2; ++n) FragSel<FP8>::load(dst[n], lds + PG8_SB(b, h) + boff + n * 2048); } while (0)
#define PG8_MMA(ai, bj, At, Bt) do { __builtin_amdgcn_s_setprio(1); \
        _Pragma("unroll") for (int m = 0; m < 4; ++m) _Pragma("unroll") for (int n = 0; n < 2; ++n) acc[ai][bj][m][n] = FragSel<FP8>::mma(Bt[n], At[m], acc[ai][bj][m][n], sc7f); \
        __builtin_amdgcn_s_setprio(0); } while (0)
#define PG8_WAIT_V(n) asm volatile("s_waitcnt vmcnt(" #n ")" ::: "memory")
#define PG8_WAIT_L(n) asm volatile("s_waitcnt lgkmcnt(" #n ")" ::: "memory")
#define PG8_BAR __builtin_amdgcn_s_barrier()
#define PG8_SCHED __builtin_amdgcn_sched_barrier(0)
    Unit cur, nxt; int ui = 0;
    if (!S.next(0, cur)) return;
    f32x4 acc[2][2][4][2];
#pragma unroll
    for (int a = 0; a < 2; ++a)
#pragma unroll
        for (int b = 0; b < 2; ++b)
#pragma unroll
            for (int m = 0; m < 4; ++m)
#pragma unroll
                for (int n = 0; n < 2; ++n) acc[a][b][m][n] = (f32x4){0.f, 0.f, 0.f, 0.f};
    typedef typename FragSel<FP8>::type frag_t;
    frag_t At[4], B0[2], B1[2];
    const char* cA = (const char*)g.A + (size_t)cur.pm * tstep; const char* cB = (const char*)g.Bt + (size_t)cur.pn * tstep;
    S.a_ready(cur);
    if constexpr (SP2) {
        PG8_STAGE(PG8_SB(0, 0), cB, voffB); PG8_STAGE(PG8_SB(0, 1), cB + hstepB, voffB); PG8_STAGE(PG8_SA(0, 0), cA, voffA); PG8_STAGE(PG8_SA(0, 1), cA + hstep, voffA);
        if (wr == 1) PG8_BAR;
        PG8_WAIT_V(2); PG8_BAR;
        PG8_STAGE(PG8_SB(1, 0), cB + kstep, voffB); PG8_STAGE(PG8_SA(1, 0), cA + kstep, voffA); PG8_STAGE(PG8_SB(1, 1), cB + hstepB + kstep, voffB);
        PG8_WAIT_V(6); PG8_BAR;
    } else {
        PG8_STAGE(PG8_SB(0, 0), cB, voffB); PG8_STAGE(PG8_SA(0, 0), cA, voffA); PG8_STAGE(PG8_SB(0, 1), cB + hstepB, voffB); PG8_STAGE(PG8_SA(0, 1), cA + hstep, voffA);
        if (wr == 1) PG8_BAR;
        PG8_WAIT_V(4); PG8_BAR;
        PG8_STAGE(PG8_SB(1, 0), cB + kstep, voffB); PG8_STAGE(PG8_SA(1, 0), cA + kstep, voffA); PG8_STAGE(PG8_SB(1, 1), cB + hstepB + kstep, voffB);
        PG8_WAIT_V(6); PG8_BAR;
    }
    for (;;) {
        const bool has_next = S.next(ui + 1, nxt);
        const char* nA = has_next ? (const char*)g.A + (size_t)nxt.pm * tstep : cA; const char* nB = has_next ? (const char*)g.Bt + (size_t)nxt.pn * tstep : cB;
        for (int t = 0; t < nt; t += 2) {
            const bool last = (t == nt - 2);
            const char* a1 = cA + (size_t)(t + 1) * kstep;
            const char* a2 = last ? nA : cA + (size_t)(t + 2) * kstep; const char* b2 = last ? nB : cB + (size_t)(t + 2) * kstep;
            const char* a3 = a2 + kstep; const char* b3 = b2 + kstep;
            if (last && has_next) S.a_ready(nxt);
            if constexpr (SP2) {
            PG8_LDB(B0, 0, 0); PG8_LDB(B1, 0, 1); PG8_SCHED; PG8_LDA(At, 0, 0); PG8_STAGE(PG8_SA(1, 1), a1 + hstep, voffA);
            PG8_WAIT_V(8); PG8_WAIT_L(0); PG8_BAR; PG8_MMA(0, 0, At, B0); PG8_MMA(0, 1, At, B1); PG8_BAR; PG8_SCHED;
            PG8_LDA(At, 0, 1); PG8_STAGE(PG8_SB(0, 0), b2, voffB); PG8_STAGE(PG8_SB(0, 1), b2 + hstepB, voffB); PG8_STAGE(PG8_SA(0, 0), a2, voffA);
            PG8_WAIT_V(8); PG8_WAIT_L(0); PG8_BAR; PG8_MMA(1, 0, At, B0); PG8_MMA(1, 1, At, B1); PG8_BAR; PG8_SCHED;
            PG8_LDB(B0, 1, 0); PG8_LDB(B1, 1, 1); PG8_SCHED; PG8_LDA(At, 1, 0); PG8_STAGE(PG8_SA(0, 1), a2 + hstep, voffA);
            PG8_WAIT_V(8); PG8_WAIT_L(0); PG8_BAR; PG8_MMA(0, 0, At, B0); PG8_MMA(0, 1, At, B1); PG8_BAR; PG8_SCHED;
            PG8_LDA(At, 1, 1); PG8_STAGE(PG8_SB(1, 0), b3, voffB); PG8_STAGE(PG8_SB(1, 1), b3 + hstepB, voffB); PG8_STAGE(PG8_SA(1, 0), a3, voffA);
            PG8_WAIT_V(8); PG8_WAIT_L(0); PG8_BAR; PG8_MMA(1, 0, At, B0); PG8_MMA(1, 1, At, B1); PG8_BAR; PG8_SCHED;
            } else {
            PG8_LDB(B0, 0, 0); PG8_SCHED; PG8_LDA(At, 0, 0); PG8_STAGE(PG8_SA(1, 1), a1 + hstep, voffA);
            PG8_WAIT_L(8); PG8_BAR; PG8_WAIT_L(0); PG8_MMA(0, 0, At, B0); PG8_BAR; PG8_SCHED;
            PG8_LDB(B1, 0, 1); PG8_STAGE(PG8_SB(0, 0), b2, voffB);
            PG8_BAR; PG8_WAIT_L(0); PG8_MMA(0, 1, At, B1); PG8_BAR;
            PG8_LDA(At, 0, 1); PG8_STAGE(PG8_SA(0, 0), a2, voffA);
            PG8_BAR; PG8_WAIT_L(0); PG8_MMA(1, 0, At, B0); PG8_BAR; PG8_SCHED;
            PG8_STAGE(PG8_SB(0, 1), b2 + hstepB, voffB);
            PG8_WAIT_V(6); PG8_BAR; PG8_MMA(1, 1, At, B1); PG8_BAR;
            PG8_LDB(B0, 1, 0); PG8_SCHED; PG8_LDA(At, 1, 0); PG8_STAGE(PG8_SA(0, 1), a2 + hstep, voffA);
            PG8_WAIT_L(8); PG8_BAR; PG8_WAIT_L(0); PG8_MMA(0, 0, At, B0); PG8_BAR; PG8_SCHED;
            PG8_LDB(B1, 1, 1); PG8_STAGE(PG8_SB(1, 0), b3, voffB);
            PG8_BAR; PG8_WAIT_L(0); PG8_MMA(0, 1, At, B1); PG8_BAR;
            PG8_LDA(At, 1, 1); PG8_STAGE(PG8_SA(1, 0), a3, voffA);
            PG8_BAR; PG8_WAIT_L(0); PG8_MMA(1, 0, At, B0); PG8_BAR; PG8_SCHED;
            PG8_STAGE(PG8_SB(1, 1), b3 + hstepB, voffB);
            PG8_WAIT_V(6); PG8_BAR; PG8_MMA(1, 1, At, B1); PG8_BAR;
            }
            if constexpr (MidTiles<Epi>::v > 0) { if (t + 2 == MidTiles<Epi>::v) { asm volatile("s_nop 15\n\ts_nop 15" ::: "memory"); E.mid(acc, cur, wr, wc, fr, fq); } }
        }
        if constexpr (ALIGN_EPI) { if (wr == 0) PG8_BAR; }
        if constexpr (FP8) asm volatile("s_nop 15\n\ts_nop 15" ::: "memory");
        if constexpr (!Epi::AFTER_DRAIN) E(acc, cur, wr, wc, fr, fq);
        if (!has_next) break;
#pragma unroll
        for (int a = 0; a < 2; ++a)
#pragma unroll
            for (int b = 0; b < 2; ++b)
#pragma unroll
                for (int m = 0; m < 4; ++m)
#pragma unroll
                    for (int n = 0; n < 2; ++n) acc[a][b][m][n] = (f32x4){0.f, 0.f, 0.f, 0.f};
        cur = nxt; cA = nA; cB = nB; ++ui;
        if constexpr (ALIGN_EPI) { if (wr == 1) PG8_BAR; }
    }
    PG8_WAIT_V(0);
    if constexpr (!ALIGN_EPI) { if (wr == 0) PG8_BAR; }
    PG8_BAR;
    if constexpr (Epi::AFTER_DRAIN) E.fused(acc, cur, wr, wc, fr, fq, lds);
#undef PG8_SA
#undef PG8_SB
#undef PG8_STAGE
#undef PG8_LDA
#undef PG8_LDB
#undef PG8_MMA
#undef PG8_WAIT_V
#undef PG8_WAIT_L
#undef PG8_BAR
#undef PG8_SCHED
}
}
using pg8::cvt_pk_bf16;

#define XB_TMO      128
#define XB_XCNT(j)  (256  + 64 * (j))
#define XB_XSUB(j)  (1280 + 64 * (j))
#define XB_XGEN(j)  (2304 + 64 * (j))
#define XB_TOP      3328
#define XB_TOPGEN   3392
#define XCD_BAR_WORDS 3456
#define XB_SPIN_CAP (1u << 18)
__device__ __forceinline__ unsigned xb_ld(unsigned* p)              { return __hip_atomic_load(p, __ATOMIC_RELAXED, __HIP_MEMORY_SCOPE_AGENT); }
__device__ __forceinline__ unsigned xb_add(unsigned* p, unsigned v) { return __hip_atomic_fetch_add(p, v, __ATOMIC_RELAXED, __HIP_MEMORY_SCOPE_AGENT); }
__device__ __forceinline__ unsigned xb_xcc_id() { return (unsigned)__builtin_amdgcn_s_getreg((3 << 11) | 20) & 0xFu; }
#define XB_SPIN(cond, bar) do { unsigned _sp = 0; while (cond) { __builtin_amdgcn_s_sleep(1); \
    if ((++_sp & 255u) == 0u) { if (xb_ld(&(bar)[XB_TMO])) break; if (_sp > XB_SPIN_CAP) { atomicAdd(&(bar)[XB_TMO], 1u); break; } } } } while (0)
struct XcdBarrier { unsigned* bar; unsigned x; volatile LAS unsigned* st; };
__device__ __forceinline__ XcdBarrier xcd_barrier_post(unsigned* bar, volatile LAS unsigned* st) {
    XcdBarrier b; b.bar = bar; b.x = xb_xcc_id(); b.st = st;
    if (threadIdx.x == 0) (void)xb_add(&bar[XB_XCNT(b.x)], 1u);
    return b;
}
__device__ __forceinline__ void xcd_barrier_complete(unsigned* bar, unsigned x, unsigned& nloc, unsigned& nx) {
    const unsigned G = gridDim.x * gridDim.y * gridDim.z;
    unsigned sum, cnt, mine, sp = 0u;
    for (;;) {
        sum = 0u; cnt = 0u; mine = 0u;
#pragma unroll
        for (unsigned j = 0; j < 16; ++j) { const unsigned c = xb_ld(&bar[XB_XCNT(j)]); sum += c; cnt += (c > 0u) ? 1u : 0u; mine = (j == x) ? c : mine; }
        if (sum == G) break;
        __builtin_amdgcn_s_sleep(1);
        if ((++sp & 255u) == 0u) { if (xb_ld(&bar[XB_TMO])) break; if (sp > XB_SPIN_CAP) { atomicAdd(&bar[XB_TMO], 1u); break; } }
    }
    nloc = mine > 0u ? mine : 1u; nx = cnt > 0u ? cnt : 1u;
}
__device__ __forceinline__ void xcd_barrier(const XcdBarrier& b) {
    asm volatile("s_waitcnt vmcnt(0)" ::: "memory");
    __syncthreads();
    if (threadIdx.x == 0) {
        unsigned* bar = b.bar;
        __builtin_amdgcn_s_waitcnt(0);
        unsigned nloc = b.st[0], nx = b.st[1];
        if (nloc == 0u) { xcd_barrier_complete(bar, b.x, nloc, nx); b.st[0] = nloc; b.st[1] = nx; }
        const unsigned old = xb_add(&bar[XB_XSUB(b.x)], 1u);
        const unsigned gen = old / nloc;
        if (old + 1u == (gen + 1u) * nloc) {
            __builtin_amdgcn_fence(__ATOMIC_RELEASE, "agent");
            asm volatile("s_waitcnt vmcnt(0)" ::: "memory");
            const unsigned og = xb_add(&bar[XB_TOP], 1u);
            const unsigned tg = og / nx;
            if (og + 1u == (tg + 1u) * nx) xb_add(&bar[XB_TOPGEN], 1u);
            else XB_SPIN(xb_ld(&bar[XB_TOPGEN]) == tg, bar);
            __builtin_amdgcn_fence(__ATOMIC_ACQUIRE, "agent");
            xb_add(&bar[XB_XGEN(b.x)], 1u);
            asm volatile("s_waitcnt vmcnt(0)" ::: "memory");
        } else {
            XB_SPIN(xb_ld(&bar[XB_XGEN(b.x)]) == gen, bar);
            __builtin_amdgcn_fence(__ATOMIC_ACQUIRE, "agent");
            asm volatile("s_waitcnt vmcnt(0)" ::: "memory");
        }
    }
    __syncthreads();
}

struct Args { const float* in[18]; float* out; unsigned char* ws; int ph_lo, ph_hi, li, pad; };
enum { I_X = 0, I_P, I_NORM_MIX, I_W_IN, I_QKN_NA, I_RPB, I_QKN_DIL, I_W_BNA, I_W_BDIL, I_W_OUT, I_NORM_FFN, I_WQ, I_SUBK, I_EU, I_EV, I_NORM_PLE, I_W_PLEG, I_W_PLE };

__device__ __forceinline__ int opaque_tid() { int t = threadIdx.x; asm volatile("" : "+v"(t)); return t; }
struct Ctx {
    LAS unsigned char* lds;
    int G, vcu;
    const Args* a;
};
#define CTX_LANES() const int tid_ = opaque_tid(); const int lane = tid_ & 63; const int wave = __builtin_amdgcn_readfirstlane(tid_ >> 6); (void)lane; (void)wave

__device__ __forceinline__ unsigned pk4_fp8(float a, float b, float c, float d) { int w = 0; w = __builtin_amdgcn_cvt_pk_fp8_f32(a, b, w, false); w = __builtin_amdgcn_cvt_pk_fp8_f32(c, d, w, true); return (unsigned)w; }
constexpr float W8_SCALE = 64.0f, A8_SCALE = 8.0f;
__device__ __forceinline__ void p0_transpose_item(const float* W, const float* gain, int K, int N, bf16_t* WT, LAS float* scr, int item, int lane) {
    const int nblk = N / 32, kb = item / nblk, nb = item % nblk, k0 = 64 * kb, n0 = 32 * nb;
    f32x4 t[8];
#pragma unroll
    for (int i = 0; i < 8; ++i) t[i] = __builtin_nontemporal_load((const f32x4*)(W + (size_t)(k0 + 8 * i + (lane >> 3)) * N + n0 + 4 * (lane & 7)));
#pragma unroll
    for (int i = 0; i < 8; ++i) { const int kk = 8 * i + (lane >> 3); f32x4 w = t[i]; if (gain) w *= gain[k0 + kk]; LAS float* d = scr + kk * 33 + 4 * (lane & 7); d[0] = w.x; d[1] = w.y; d[2] = w.z; d[3] = w.w; }
    asm volatile("s_waitcnt lgkmcnt(0)" ::: "memory");
    const int c = lane & 7;
#pragma unroll
    for (int j = 0; j < 4; ++j) { const int n = (lane >> 3) + 8 * j; const LAS float* s = scr + (8 * c) * 33 + n;
        u32x4 o; o.x = pk2(s[0 * 33], s[1 * 33]); o.y = pk2(s[2 * 33], s[3 * 33]); o.z = pk2(s[4 * 33], s[5 * 33]); o.w = pk2(s[6 * 33], s[7 * 33]);
        *(u32x4*)(WT + (size_t)(n0 + n) * K + k0 + 8 * c) = o; }
    asm volatile("s_waitcnt lgkmcnt(0)" ::: "memory");
}

__device__ __forceinline__ void p0_transpose_item_fp8(const float* W, const float* gain, int K, int N, unsigned char* WT, LAS float* scr, int item, int lane, int pitch = 0) {
    if (pitch == 0) pitch = K;
    const int nblk = N / 32, kb = item / nblk, nb = item % nblk, k0 = 64 * kb, n0 = 32 * nb;
    f32x4 t[8];
#pragma unroll
    for (int i = 0; i < 8; ++i) t[i] = __builtin_nontemporal_load((const f32x4*)(W + (size_t)(k0 + 8 * i + (lane >> 3)) * N + n0 + 4 * (lane & 7)));
#pragma unroll
    for (int i = 0; i < 8; ++i) { const int kk = 8 * i + (lane >> 3); f32x4 w = t[i] * W8_SCALE; if (gain) w *= gain[k0 + kk]; LAS float* d = scr + kk * 33 + 4 * (lane & 7); d[0] = w.x; d[1] = w.y; d[2] = w.z; d[3] = w.w; }
    asm volatile("s_waitcnt lgkmcnt(0)" ::: "memory");
    const int c = lane & 7;
#pragma unroll
    for (int j = 0; j < 4; ++j) { const int n = (lane >> 3) + 8 * j; const LAS float* s = scr + (8 * c) * 33 + n;
        *(u32x2*)(WT + (size_t)(n0 + n) * pitch + k0 + 8 * c) = (u32x2){pk4_fp8(s[0 * 33], s[1 * 33], s[2 * 33], s[3 * 33]), pk4_fp8(s[4 * 33], s[5 * 33], s[6 * 33], s[7 * 33])}; }
    asm volatile("s_waitcnt lgkmcnt(0)" ::: "memory");
}
__device__ __forceinline__ void phase_prologue(const Ctx& C) {
    const Args& A = *C.a; unsigned char* ws = A.ws; CTX_LANES();
    LAS float* scr = (LAS float*)(C.lds + wave * 16384);
    const int gw = C.vcu * 8 + wave, NGW = C.G * 8;
    for (int rp_ = 0; rp_ < 1 + ((PROBE_PRO >> 0) & 1); ++rp_)
    {
        constexpr int I_IN = (D / 64) * (IN_W / 32), I_NA = (512 / 64) * (D / 32), I_DL = (256 / 64) * (D / 32), I_OUT = (D / 64) * (D / 32), I_G = I_OUT, I_PL = (256 / 64) * (D / 32);
        constexpr int NITEMS = I_IN + I_NA + I_DL + I_OUT + I_G + I_PL;
        for (int it = gw; it < NITEMS; it += NGW) {
            int r = it;
            if (r < I_IN) { p0_transpose_item_fp8(A.in[I_W_IN], A.in[I_NORM_MIX], D, IN_W, ws + WS_WIN, scr, r, lane); continue; } r -= I_IN;
            if (r < I_NA) { p0_transpose_item_fp8(A.in[I_W_BNA], nullptr, 512, D, ws + WS_WNA, scr, r, lane, ACAT); continue; } r -= I_NA;
            if (r < I_DL) { p0_transpose_item_fp8(A.in[I_W_BDIL], nullptr, 256, D, ws + WS_WNA + 512, scr, r, lane, ACAT); continue; } r -= I_DL;
            if (r < I_OUT) { p0_transpose_item_fp8(A.in[I_W_OUT], nullptr, D, D, ws + WS_WOUT, scr, r, lane); continue; } r -= I_OUT;
            if (r < I_G) { p0_transpose_item(A.in[I_W_PLEG], A.in[I_NORM_PLE], D, D, (bf16_t*)(ws + WS_WG), scr, r, lane); continue; } r -= I_G;
            p0_transpose_item(A.in[I_W_PLE], nullptr, 256, D, (bf16_t*)(ws + WS_WPLE), scr, r, lane);
        }
    }
    for (int rp_ = 0; rp_ < 1 + ((PROBE_PRO >> 1) & 1); ++rp_)
    {
        const float* wq = A.in[I_WQ]; const float* sk = A.in[I_SUBK]; const float* gf = A.in[I_NORM_FFN];
        bf16_t* wsc = (bf16_t*)(ws + WS_WSC);
        for (int it = gw; it < 16 * 64; it += NGW) {
            const int hs = it >> 6, k0 = (it & 63) * 16, side = hs & 1;
#pragma unroll
            for (int i = 0; i < 8; ++i) { const int e = i * 64 + lane; const int kk = e >> 5, c4 = e & 31;
                *(LAS f32x4*)(scr + kk * 128 + c4 * 4) = *(const f32x4*)(wq + (size_t)(k0 + kk) * 2048 + hs * 128 + c4 * 4); }
            asm volatile("s_waitcnt lgkmcnt(0)" ::: "memory");
            float acc0[16], acc1[16];
#pragma unroll
            for (int kk = 0; kk < 16; ++kk) { acc0[kk] = 0.f; acc1[kk] = 0.f; }
            const float* r0 = sk + ((size_t)side * 128 + lane) * 128; const float* r1 = r0 + 64 * 128;
#pragma unroll 8
            for (int d4 = 0; d4 < 32; ++d4) {
                const f32x4 a = *(const f32x4*)(r0 + d4 * 4), b = *(const f32x4*)(r1 + d4 * 4);
#pragma unroll
                for (int kk = 0; kk < 16; ++kk) { const f32x4 w = *(const LAS f32x4*)(scr + kk * 128 + d4 * 4);
                    acc0[kk] += a.x * w.x + a.y * w.y + a.z * w.z + a.w * w.w; acc1[kk] += b.x * w.x + b.y * w.y + b.z * w.z + b.w * w.w; }
            }
            unsigned o0[8], o1[8];
#pragma unroll
            for (int j = 0; j < 8; ++j) { const float g0 = gf[k0 + 2 * j], g1 = gf[k0 + 2 * j + 1]; o0[j] = pk2(acc0[2 * j] * g0, acc0[2 * j + 1] * g1); o1[j] = pk2(acc1[2 * j] * g0, acc1[2 * j + 1] * g1); }
            bf16_t* d0 = wsc + (size_t)(hs * 128 + lane) * D + k0; bf16_t* d1 = d0 + (size_t)64 * D;
            *(u32x4*)d0 = (u32x4){o0[0], o0[1], o0[2], o0[3]}; *(u32x4*)(d0 + 8) = (u32x4){o0[4], o0[5], o0[6], o0[7]};
            *(u32x4*)d1 = (u32x4){o1[0], o1[1], o1[2], o1[3]}; *(u32x4*)(d1 + 8) = (u32x4){o1[4], o1[5], o1[6], o1[7]};
            asm volatile("s_waitcnt lgkmcnt(0)" ::: "memory");
        }
    }
    for (int rp_ = 0; rp_ < 1 + ((PROBE_PRO >> 2) & 1); ++rp_)
    {
        const size_t gt = (size_t)(C.vcu * 512 + tid_), NT = (size_t)C.G * 512;
#define CVT_PASS(SRC, DST, CNT) do { const float* s_ = (SRC); bf16_t* d_ = (DST); const size_t c_ = (CNT); \
            for (size_t i = gt; i < c_; i += 4 * NT) { f32x4 a_[4], b_[4]; \
                _Pragma("unroll") for (int q = 0; q < 4; ++q) { const size_t iq = i + q * NT; if (iq < c_) { a_[q] = __builtin_nontemporal_load((const f32x4*)(s_ + iq * 8)); b_[q] = __builtin_nontemporal_load((const f32x4*)(s_ + iq * 8 + 4)); } } \
                _Pragma("unroll") for (int q = 0; q < 4; ++q) { const size_t iq = i + q * NT; if (iq < c_) *(u32x4*)(d_ + iq * 8) = (u32x4){pk2(a_[q].x, a_[q].y), pk2(a_[q].z, a_[q].w), pk2(b_[q].x, b_[q].y), pk2(b_[q].z, b_[q].w)}; } } } while (0)
        CVT_PASS(A.in[I_P], (bf16_t*)(ws + WS_PB), (size_t)T * 256 / 8);
#undef CVT_PASS
        float* ct = (float*)(ws + WS_COS); float* st = (float*)(ws + WS_SIN);
        for (size_t i = gt; i < 4096 * 8; i += NT) {
            const int pos = (int)(i >> 3), f = (int)(i & 7);
            const float invf[8] = {1.0f, 0.19392274f, 0.03760603f, 0.0072926646f, 0.0014142136f, 0.0002742482f, 5.3182957e-05f, 1.0313385e-05f};
            float fr_ = invf[0];
#pragma unroll
            for (int q = 1; q < 8; ++q) fr_ = (f == q) ? invf[q] : fr_;
            const float ang = (float)pos * fr_;
            double tt = (double)ang * 0.15915494309189535; tt -= floor(tt);
            ct[i] = __builtin_amdgcn_cosf((float)tt); st[i] = __builtin_amdgcn_sinf((float)tt);
        }
    }
    for (int rp_ = 0; rp_ < 1 + ((PROBE_PRO >> 3) & 1); ++rp_)
    {
        auto load_rows = [&](f32x4 (&v)[4][4], const int rr0) __attribute__((always_inline)) {
#pragma unroll
            for (int r = 0; r < 4; ++r) { const int rr = rr0 + r, e = rr & (NEXP - 1), which = rr >> 14;
                const float* src = (which ? A.in[I_EV] : A.in[I_EU]) + (size_t)e * D + 16 * lane;
#pragma unroll
                for (int j = 0; j < 4; ++j) v[r][j] = __builtin_nontemporal_load((const f32x4*)(src + 4 * j)); }
        };
        auto quant_rows = [&](const f32x4 (&v)[4][4], const int rr0) __attribute__((always_inline)) {
#pragma unroll
            for (int r = 0; r < 4; ++r) { const int rr = rr0 + r, e = rr & (NEXP - 1), which = rr >> 14;
                float ss = 0.f;
#pragma unroll
                for (int j = 0; j < 4; ++j) ss += (v[r][j].x * v[r][j].x + v[r][j].y * v[r][j].y) + (v[r][j].z * v[r][j].z + v[r][j].w * v[r][j].w);
                ss = wave_sum_dpp(ss);
                const float rms = sqrtf(ss * (1.0f / D));
                const float sc = which ? 0.5f * rms : 0.335f * rms, inv = rms > 0.f ? 1.0f / sc : 0.f;
                unsigned w[2];
                if (which) {
#define NIB_FP4(x_) ({ const float t_ = (x_) * inv; const float a_ = fabsf(t_); \
                       (unsigned)((a_ >= 0.25f) + (a_ >= 0.75f) + (a_ >= 1.25f) + (a_ >= 1.75f) + (a_ >= 2.5f) + (a_ >= 3.5f) + (a_ >= 5.0f)) | (t_ < 0.f ? 8u : 0u); })
#pragma unroll
                    for (int hh = 0; hh < 2; ++hh) { const f32x4 a = v[r][2 * hh], b = v[r][2 * hh + 1];
                        w[hh] = NIB_FP4(a.x) | (NIB_FP4(a.y) << 4) | (NIB_FP4(a.z) << 8) | (NIB_FP4(a.w) << 12) | (NIB_FP4(b.x) << 16) | (NIB_FP4(b.y) << 20) | (NIB_FP4(b.z) << 24) | (NIB_FP4(b.w) << 28); }
#undef NIB_FP4
                } else {
#define NIB_I4(x_) ((unsigned)(int)fminf(fmaxf(__builtin_rintf((x_) * inv), -8.f), 7.f) & 15u)
#pragma unroll
                    for (int hh = 0; hh < 2; ++hh) { const f32x4 a = v[r][2 * hh], b = v[r][2 * hh + 1];
                        w[hh] = NIB_I4(a.x) | (NIB_I4(b.x) << 4) | (NIB_I4(a.y) << 8) | (NIB_I4(b.y) << 12) | (NIB_I4(a.z) << 16) | (NIB_I4(b.z) << 20) | (NIB_I4(a.w) << 24) | (NIB_I4(b.w) << 28); }
#undef NIB_I4
                }
                *(u32x2*)(ws + (which ? WS_EV : WS_EU) + (size_t)(lane >> 4) * (NEXP * 128) + (size_t)e * 128 + 8 * (lane & 15)) = (u32x2){w[0], w[1]};
                if (lane == 0) ((float*)(ws + (which ? WS_SV : WS_SU)))[e] = sc; }
        };
        {
            f32x4 va[4][4], vb[4][4];
            const int step = NGW * 4, end = 2 * NEXP, r0 = gw * 4;
            const int nb = r0 < end ? (end - r0 + step - 1) / step : 0;
            if (nb > 0) load_rows(va, r0);
            int k = 0;
#pragma unroll 1
            for (; k + 2 < nb; k += 2) {
                load_rows(vb, r0 + (k + 1) * step); quant_rows(va, r0 + k * step);
                load_rows(va, r0 + (k + 2) * step); quant_rows(vb, r0 + (k + 1) * step);
            }
            if (k + 1 < nb) { load_rows(vb, r0 + (k + 1) * step); quant_rows(va, r0 + k * step); quant_rows(vb, r0 + (k + 1) * step); }
            else if (k < nb) quant_rows(va, r0 + k * step);
        }
    }
    for (int rp_ = 0; rp_ < 1 + ((PROBE_PRO >> 4) & 1); ++rp_)
    {
        const float* x = A.in[I_X]; bf16_t* xb = (bf16_t*)((unsigned char*)A.out + DO_XB); float* rs = (float*)(ws + WS_RSTD1);
        auto load_x = [&](f32x4 (&v)[4][4], const int m0) __attribute__((always_inline)) {
#pragma unroll
            for (int r = 0; r < 4; ++r) { const f32x4* xr = (const f32x4*)(x + (size_t)(m0 + r) * D) + lane * 2;
#pragma unroll
                for (int j = 0; j < 2; ++j) { v[r][2 * j] = xr[128 * j]; v[r][2 * j + 1] = xr[128 * j + 1]; } }
        };
        auto conv_x = [&](const f32x4 (&v)[4][4], const int m0) __attribute__((always_inline)) {
#pragma unroll
            for (int r = 0; r < 4; ++r) { float s = 0.f;
#pragma unroll
                for (int j = 0; j < 4; ++j) s += (v[r][j].x * v[r][j].x + v[r][j].y * v[r][j].y) + (v[r][j].z * v[r][j].z + v[r][j].w * v[r][j].w);
                s = wave_sum_dpp(s);
                if (lane == 0) rs[m0 + r] = 1.0f / sqrtf(s * (1.0f / D) + RMS_EPS);
                u32x2* o = (u32x2*)((unsigned char*)xb + (size_t)(m0 + r) * D) + lane;
#pragma unroll
                for (int j = 0; j < 2; ++j) o[64 * j] = (u32x2){pk4_fp8(v[r][2 * j].x, v[r][2 * j].y, v[r][2 * j].z, v[r][2 * j].w), pk4_fp8(v[r][2 * j + 1].x, v[r][2 * j + 1].y, v[r][2 * j + 1].z, v[r][2 * j + 1].w)}; }
        };
        {
            f32x4 va[4][4], vb[4][4];
            const int step = NGW * 4, r0 = gw * 4;
            const int nb = r0 < T ? (T - r0 + step - 1) / step : 0;
            if (nb > 0) load_x(va, r0);
            int k = 0;
#pragma unroll 1
            for (; k + 2 < nb; k += 2) {
                load_x(vb, r0 + (k + 1) * step); conv_x(va, r0 + k * step);
                load_x(va, r0 + (k + 2) * step); conv_x(vb, r0 + (k + 1) * step);
            }
            if (k + 1 < nb) { load_x(vb, r0 + (k + 1) * step); conv_x(va, r0 + k * step); conv_x(vb, r0 + (k + 1) * step); }
            else if (k < nb) conv_x(va, r0 + k * step);
        }
    }
}

using pg8::Unit;
struct EpiProj {
    static constexpr bool AFTER_DRAIN = false;
    const float* rstd; const float* qkn_na; const float* qkn_dil; const float* cosT; const float* sinT;
    unsigned char* wsb;
    __device__ __forceinline__ void operator()(const f32x4 (&acc)[2][2][4][2], const Unit& u, int wr, int wc, int fr, int fq) const {
        const int pn = u.pn;
        int kind, sub;
        if (pn < 6) { kind = pn >> 1; sub = pn & 1; } else if (pn < 15) { kind = 3 + (pn - 6) / 3; sub = (pn - 6) % 3; } else { kind = 6; sub = pn - 15; }
        const bool is_qk = (kind == 0 || kind == 1 || kind == 3 || kind == 4);
        const bool is_dil = (kind >= 3 && kind <= 5);
        const float* gainp = (kind < 3 ? qkn_na : qkn_dil) + ((kind == 1 || kind == 4) ? 64 : 0);
        float gn[2][8];
#pragma unroll
        for (int bj = 0; bj < 2; ++bj) {
            if (is_qk) { const f32x4 g0 = *(const f32x4*)(gainp + 32 * bj + 8 * fq), g1 = *(const f32x4*)(gainp + 32 * bj + 8 * fq + 4);
                gn[bj][0] = g0.x; gn[bj][1] = g0.y; gn[bj][2] = g0.z; gn[bj][3] = g0.w; gn[bj][4] = g1.x; gn[bj][5] = g1.y; gn[bj][6] = g1.z; gn[bj][7] = g1.w; }
            else {
#pragma unroll
                for (int j = 0; j < 8; ++j) gn[bj][j] = 1.f; }
        }
        const float qs = (kind == 0 || kind == 3) ? QSCALE : 1.0f;
        const size_t boff = kind < 3 ? (WS_QNA + (size_t)kind * (WS_KNA - WS_QNA)) : (kind < 6 ? (WS_QDIL + (size_t)(kind - 3) * (WS_KDIL - WS_QDIL)) : WS_GATES);
        bf16_t* base = (bf16_t*)(wsb + boff);
        float rsv[8];
#pragma unroll
        for (int q = 0; q < 8; ++q) rsv[q] = rstd[u.pm * 256 + (q >> 2) * 128 + wr * 64 + (q & 3) * 16 + fr] * (1.0f / W8_SCALE);
        const float fr0 = 0.15915494f, fr1 = 0.030863762f, fr2 = 0.0059851858f, fr3 = 0.0011606637f, fr4 = 0.00022508f, fr5 = 4.3648e-05f, fr6 = 8.4643e-06f, fr7 = 1.6414e-06f;
#pragma unroll
        for (int ai = 0; ai < 2; ++ai)
#pragma unroll
            for (int m = 0; m < 4; ++m) {
                const int row = u.pm * 256 + ai * 128 + wr * 64 + m * 16 + fr;
                const float rs = rsv[ai * 4 + m];
                float v[2][8];
#pragma unroll
                for (int bj = 0; bj < 2; ++bj)
#pragma unroll
                    for (int n = 0; n < 2; ++n)
#pragma unroll
                        for (int j = 0; j < 4; ++j) v[bj][4 * n + j] = acc[ai][bj][m][n][j] * rs;
                if (kind == 6) {
                    bf16_t* rowp = base + (size_t)row * 2048 + sub * 256 + wc * 64 + 8 * fq;
#pragma unroll
                    for (int bj = 0; bj < 2; ++bj) { u32x4 w;
                        w.x = cvt_pk_bf16(sigmoidf_(v[bj][0]), sigmoidf_(v[bj][1])); w.y = cvt_pk_bf16(sigmoidf_(v[bj][2]), sigmoidf_(v[bj][3]));
                        w.z = cvt_pk_bf16(sigmoidf_(v[bj][4]), sigmoidf_(v[bj][5])); w.w = cvt_pk_bf16(sigmoidf_(v[bj][6]), sigmoidf_(v[bj][7]));
                        *(u32x4*)(rowp + 32 * bj) = w; }
                    continue;
                }
                if (is_qk) {
                    float ss = 0.f;
#pragma unroll
                    for (int bj = 0; bj < 2; ++bj)
#pragma unroll
                        for (int j = 0; j < 8; ++j) ss += v[bj][j] * v[bj][j];
                    ss = sum_x16_x32(ss);
                    const float r = 1.0f / sqrtf(ss * (1.0f / 64.0f) + RMS_EPS);
#pragma unroll
                    for (int bj = 0; bj < 2; ++bj)
#pragma unroll
                        for (int j = 0; j < 8; ++j) v[bj][j] = v[bj][j] * r * gn[bj][j];
                    if (is_dil) {
                        const float pos = (float)(row & (SEQ - 1));
                        const float frq[8] = {fr0, fr1, fr2, fr3, fr4, fr5, fr6, fr7};
                        float cs[8], sn[8];
#pragma unroll
                        for (int j = 0; j < 8; ++j) { const float t = __builtin_amdgcn_fractf(pos * frq[j]); cs[j] = __builtin_amdgcn_cosf(t); sn[j] = __builtin_amdgcn_sinf(t); }
#pragma unroll
                        for (int j = 0; j < 8; ++j) {
                            const float own = v[0][j], oth = other_x16(own, fq << 4);
                            const float rot = (fq == 0) ? (own * cs[j] - oth * sn[j]) : (own * cs[j] + oth * sn[j]);
                            v[0][j] = (fq < 2) ? rot : own;
                        }
                    }
                }
                const int b = row >> 12, s = row & (SEQ - 1);
                size_t off;
                if (!is_dil) { const int head = sub * 4 + wc; off = ((size_t)(b * NA_H + head) * SEQ + s) * HD; }
                else { const int g = sub, sh = 2 * g, L = SEQ >> sh; const int sp = (s & ((1 << sh) - 1)) * L + (s >> sh); off = ((size_t)((b * 3 + g) * 4 + wc) * SEQ + sp) * HD; }
                bf16_t* rowp = base + off + 8 * fq;
#pragma unroll
                for (int bj = 0; bj < 2; ++bj) { u32x4 w;
                    w.x = cvt_pk_bf16(v[bj][0] * qs, v[bj][1] * qs); w.y = cvt_pk_bf16(v[bj][2] * qs, v[bj][3] * qs); w.z = cvt_pk_bf16(v[bj][4] * qs, v[bj][5] * qs); w.w = cvt_pk_bf16(v[bj][6] * qs, v[bj][7] * qs);
                    *(u32x4*)(rowp + 32 * bj) = w; }
            }
    }
};
template <int MODE> struct EpiGate {
    static constexpr bool AFTER_DRAIN = false;
    bf16_t* O; const bf16_t* G; int ldg; int gcol0; const bf16_t* P; float ascale;
    __device__ __forceinline__ void operator()(const f32x4 (&acc)[2][2][4][2], const Unit& u, int wr, int wc, int fr, int fq) const {
        const int row0 = u.pm * 256 + wr * 64 + fr, col0 = u.pn * 256 + wc * 64 + 8 * fq;
        u32x4 gq[2][2], pq[2][2];
#define EG_LOAD(buf, it) do { const int r_ = row0 + ((it) >> 2) * 128 + ((it) & 3) * 16; \
            if (MODE <= 1) { gq[buf][0] = *(const u32x4*)(G + (size_t)r_ * ldg + gcol0 + col0); gq[buf][1] = *(const u32x4*)(G + (size_t)r_ * ldg + gcol0 + col0 + 32); } \
            if (MODE == 1) { pq[buf][0] = *(const u32x4*)(P + (size_t)r_ * D + col0); pq[buf][1] = *(const u32x4*)(P + (size_t)r_ * D + col0 + 32); } } while (0)
        EG_LOAD(0, 0);
#pragma unroll
        for (int it = 0; it < 8; ++it) {
            const int ai = it >> 2, m = it & 3, row = row0 + ai * 128 + m * 16;
            if (it + 1 < 8) EG_LOAD((it + 1) & 1, it + 1);
#pragma unroll
            for (int bj = 0; bj < 2; ++bj) {
                float v[8];
#pragma unroll
                for (int n = 0; n < 2; ++n)
#pragma unroll
                    for (int j = 0; j < 4; ++j) v[4 * n + j] = acc[ai][bj][m][n][j] * ascale;
                if (MODE <= 1) { const u32x4 g = gq[it & 1][bj];
                    v[0] *= bf_lo(g.x); v[1] *= bf_hi(g.x); v[2] *= bf_lo(g.y); v[3] *= bf_hi(g.y); v[4] *= bf_lo(g.z); v[5] *= bf_hi(g.z); v[6] *= bf_lo(g.w); v[7] *= bf_hi(g.w); }
                if (MODE == 1) { const u32x4 p = pq[it & 1][bj];
                    v[0] += bf_lo(p.x); v[1] += bf_hi(p.x); v[2] += bf_lo(p.y); v[3] += bf_hi(p.y); v[4] += bf_lo(p.z); v[5] += bf_hi(p.z); v[6] += bf_lo(p.w); v[7] += bf_hi(p.w); }
                if (MODE == 1) *(u32x2*)((unsigned char*)O + (size_t)row * D + col0 + 32 * bj) = (u32x2){pk4_fp8(v[0] * A8_SCALE, v[1] * A8_SCALE, v[2] * A8_SCALE, v[3] * A8_SCALE), pk4_fp8(v[4] * A8_SCALE, v[5] * A8_SCALE, v[6] * A8_SCALE, v[7] * A8_SCALE)};
                else *(u32x4*)(O + (size_t)row * D + col0 + 32 * bj) = (u32x4){cvt_pk_bf16(v[0], v[1]), cvt_pk_bf16(v[2], v[3]), cvt_pk_bf16(v[4], v[5]), cvt_pk_bf16(v[6], v[7])};
            }
            asm volatile("" ::: "memory");
        }
#undef EG_LOAD
    }
};
struct EpiMerge {
    static constexpr bool AFTER_DRAIN = false; static constexpr int MID_TILES = 4;
    unsigned char* O; const bf16_t* G; float ascale;
    __device__ __forceinline__ void mid(f32x4 (&acc)[2][2][4][2], const Unit& u, int wr, int wc, int fr, int fq) const {
        asm volatile("" : "+v"(fr), "+v"(fq));
        const int row0 = u.pm * 256 + wr * 64 + fr, col0 = u.pn * 256 + wc * 64 + 8 * fq;
#pragma unroll
        for (int it = 0; it < 8; ++it) {
            const int ai = it >> 2, m = it & 3, row = row0 + ai * 128 + m * 16;
            const bf16_t* gp = G + (size_t)row * 2048 + col0;
#define EM_R(nw, dw, lo) ((lo ? bf_lo(nw) : bf_hi(nw)) * __builtin_amdgcn_rcpf(fmaxf(lo ? bf_lo(dw) : bf_hi(dw), 1e-30f)))
#pragma unroll
            for (int bj = 0; bj < 2; ++bj) {
                const u32x4 n0 = *(const u32x4*)(gp + 32 * bj), d0 = *(const u32x4*)(gp + 1024 + 32 * bj);
                acc[ai][bj][m][0] *= (f32x4){EM_R(n0.x, d0.x, 1), EM_R(n0.x, d0.x, 0), EM_R(n0.y, d0.y, 1), EM_R(n0.y, d0.y, 0)}; acc[ai][bj][m][1] *= (f32x4){EM_R(n0.z, d0.z, 1), EM_R(n0.z, d0.z, 0), EM_R(n0.w, d0.w, 1), EM_R(n0.w, d0.w, 0)};
                asm volatile("" ::: "memory");
            }
#undef EM_R
            asm volatile("" ::: "memory");
        }
    }
    __device__ __forceinline__ void operator()(const f32x4 (&acc)[2][2][4][2], const Unit& u, int wr, int wc, int fr, int fq) const {
        asm volatile("" : "+v"(fr), "+v"(fq));
        const int row0 = u.pm * 256 + wr * 64 + fr, col0 = u.pn * 256 + wc * 64 + 8 * fq;
        u32x4 gq[2][2];
#define EM_LOAD(buf, it) do { const bf16_t* gp_ = G + (size_t)(row0 + ((it) >> 2) * 128 + ((it) & 3) * 16) * 2048 + 1024 + col0; gq[buf][0] = *(const u32x4*)gp_; gq[buf][1] = *(const u32x4*)(gp_ + 32); } while (0)
        EM_LOAD(0, 0);
        const float sc = ascale * A8_SCALE;
#pragma unroll
        for (int it = 0; it < 8; ++it) {
            const int ai = it >> 2, m = it & 3, row = row0 + ai * 128 + m * 16;
            if (it + 1 < 8) EM_LOAD((it + 1) & 1, it + 1);
#pragma unroll
            for (int bj = 0; bj < 2; ++bj) { const u32x4 g = gq[it & 1][bj]; const f32x4 a = acc[ai][bj][m][0] * sc, b = acc[ai][bj][m][1] * sc;
                *(u32x2*)(O + (size_t)row * D + col0 + 32 * bj) = (u32x2){pk4_fp8(a.x * bf_lo(g.x), a.y * bf_hi(g.x), a.z * bf_lo(g.y), a.w * bf_hi(g.y)), pk4_fp8(b.x * bf_lo(g.z), b.y * bf_hi(g.z), b.z * bf_lo(g.w), b.w * bf_hi(g.w))}; }
            asm volatile("" ::: "memory");
        }
#undef EM_LOAD
    }
};
struct EpiResid {
    static constexpr bool AFTER_DRAIN = false;
    const float* x; float* out; bf16_t* xb; float* ssq; float ascale;
    __device__ __forceinline__ void operator()(const f32x4 (&acc)[2][2][4][2], const Unit& u, int wr, int wc, int fr, int fq) const {
        const int row0 = u.pm * 256 + wr * 64 + fr, col0 = u.pn * 256 + wc * 64 + 8 * fq;
        f32x4 xq[2][4];
#define ER_LOAD(buf, it) do { const float* p_ = x + (size_t)(row0 + ((it) >> 2) * 128 + ((it) & 3) * 16) * D + col0; \
            xq[buf][0] = *(const f32x4*)p_; xq[buf][1] = *(const f32x4*)(p_ + 4); xq[buf][2] = *(const f32x4*)(p_ + 32); xq[buf][3] = *(const f32x4*)(p_ + 36); } while (0)
        ER_LOAD(0, 0);
#pragma unroll
        for (int it = 0; it < 8; ++it) {
            const int ai = it >> 2, m = it & 3, row = row0 + ai * 128 + m * 16;
            if (it + 1 < 8) ER_LOAD((it + 1) & 1, it + 1);
            float ss = 0.f;
#pragma unroll
            for (int bj = 0; bj < 2; ++bj) {
                const size_t o = (size_t)row * D + col0 + 32 * bj;
                const f32x4 a = xq[it & 1][2 * bj] + acc[ai][bj][m][0] * ascale, b = xq[it & 1][2 * bj + 1] + acc[ai][bj][m][1] * ascale;
                *(u32x4*)(xb + o) = (u32x4){cvt_pk_bf16(a.x, a.y), cvt_pk_bf16(a.z, a.w), cvt_pk_bf16(b.x, b.y), cvt_pk_bf16(b.z, b.w)};
                ss += (a.x * a.x + a.y * a.y) + (a.z * a.z + a.w * a.w) + (b.x * b.x + b.y * b.y) + (b.z * b.z + b.w * b.w);
            }
            ss = sum_x16_x32(ss);
            if (fq == 0) ssq[(size_t)row * 16 + u.pn * 4 + wc] = ss;
            asm volatile("" ::: "memory");
        }
#undef ER_LOAD
    }
};
struct EpiScores {
    static constexpr bool AFTER_DRAIN = false;
    const float* ssq; _Float16* S;
    __device__ __forceinline__ void operator()(const f32x4 (&acc)[2][2][4][2], const Unit& u, int wr, int wc, int fr, int fq) const {
        const int row0 = u.pm * 256 + wr * 64 + fr, col0 = u.pn * 256 + wc * 64 + 8 * fq;
        float rsv[8];
#pragma unroll
        for (int it = 0; it < 8; ++it) {
            const f32x4* sp = (const f32x4*)(ssq + (size_t)(row0 + (it >> 2) * 128 + (it & 3) * 16) * 16);
            const f32x4 s0 = sp[0], s1 = sp[1], s2 = sp[2], s3 = sp[3];
            const float tot = ((s0.x + s0.y) + (s0.z + s0.w)) + ((s1.x + s1.y) + (s1.z + s1.w)) + ((s2.x + s2.y) + (s2.z + s2.w)) + ((s3.x + s3.y) + (s3.z + s3.w));
            rsv[it] = 1.0f / sqrtf(tot * (1.0f / D) + RMS_EPS);
        }
#pragma unroll
        for (int it = 0; it < 8; ++it) {
            const int ai = it >> 2, m = it & 3, row = row0 + ai * 128 + m * 16; const float rs = rsv[it];
#pragma unroll
            for (int bj = 0; bj < 2; ++bj) {
                const size_t o = (size_t)row * 2048 + col0 + 32 * bj;
                const f32x4 a = acc[ai][bj][m][0] * rs, b = acc[ai][bj][m][1] * rs;
                *(h16x8*)(S + o) = (h16x8){(_Float16)a.x, (_Float16)a.y, (_Float16)a.z, (_Float16)a.w, (_Float16)b.x, (_Float16)b.y, (_Float16)b.z, (_Float16)b.w};
            }
        }
    }
};
struct EpiFinal {
    static constexpr bool AFTER_DRAIN = false;
    float* out; const float* rstd3; const bf16_t* ple; const bf16_t* x2b;
    __device__ __forceinline__ void operator()(const f32x4 (&acc)[2][2][4][2], const Unit& u, int wr, int wc, int fr, int fq) const {
        const int row0 = u.pm * 256 + wr * 64 + fr, col0 = u.pn * 256 + wc * 64 + 8 * fq;
        u32x4 pq[2][2], xq[2][2]; f32x4 qq[2][2];
#define EF_LOAD(buf, it) do { const size_t r_ = (size_t)(row0 + ((it) >> 2) * 128 + ((it) & 3) * 16); \
            pq[buf][0] = *(const u32x4*)(ple + r_ * D + col0); pq[buf][1] = *(const u32x4*)(ple + r_ * D + col0 + 32); \
            xq[buf][0] = *(const u32x4*)(x2b + r_ * D + col0); xq[buf][1] = *(const u32x4*)(x2b + r_ * D + col0 + 32); \
            qq[buf][0] = *(const f32x4*)(rstd3 + r_ * 8); qq[buf][1] = *(const f32x4*)(rstd3 + r_ * 8 + 4); } while (0)
        EF_LOAD(0, 0);
#pragma unroll
        for (int it = 0; it < 8; ++it) {
            const int ai = it >> 2, m = it & 3, row = row0 + ai * 128 + m * 16;
            if (it + 1 < 8) EF_LOAD((it + 1) & 1, it + 1);
            const f32x4 q0 = qq[it & 1][0], q1 = qq[it & 1][1];
            const float rs = 1.0f / sqrtf((((q0.x + q0.y) + (q0.z + q0.w)) + ((q1.x + q1.y) + (q1.z + q1.w))) * (1.0f / D) + RMS_EPS);
#pragma unroll
            for (int bj = 0; bj < 2; ++bj) {
                const size_t o = (size_t)row * D + col0 + 32 * bj;
                const u32x4 p = pq[it & 1][bj], xw = xq[it & 1][bj];
                f32x4 a = (f32x4){bf_lo(xw.x), bf_hi(xw.x), bf_lo(xw.y), bf_hi(xw.y)}, b = (f32x4){bf_lo(xw.z), bf_hi(xw.z), bf_lo(xw.w), bf_hi(xw.w)};
                const f32x4 g0 = acc[ai][bj][m][0] * rs, g1 = acc[ai][bj][m][1] * rs;
                a.x += sigmoidf_(g0.x) * bf_lo(p.x); a.y += sigmoidf_(g0.y) * bf_hi(p.x); a.z += sigmoidf_(g0.z) * bf_lo(p.y); a.w += sigmoidf_(g0.w) * bf_hi(p.y);
                b.x += sigmoidf_(g1.x) * bf_lo(p.z); b.y += sigmoidf_(g1.y) * bf_hi(p.z); b.z += sigmoidf_(g1.z) * bf_lo(p.w); b.w += sigmoidf_(g1.w) * bf_hi(p.w);
                __builtin_nontemporal_store(a, (f32x4*)(out + o)); __builtin_nontemporal_store(b, (f32x4*)(out + o + 4));
            }
            asm volatile("" ::: "memory");
        }
#undef EF_LOAD
    }
};

__device__ __forceinline__ void load_row64(const bf16_t* p, float (&q)[64]) {
#pragma unroll
    for (int i = 0; i < 8; ++i) { const u32x4 w = *(const u32x4*)(p + 8 * i);
        q[8 * i + 0] = bf_lo(w.x); q[8 * i + 1] = bf_hi(w.x); q[8 * i + 2] = bf_lo(w.y); q[8 * i + 3] = bf_hi(w.y); q[8 * i + 4] = bf_lo(w.z); q[8 * i + 5] = bf_hi(w.z); q[8 * i + 6] = bf_lo(w.w); q[8 * i + 7] = bf_hi(w.w); }
}
__device__ __forceinline__ float dot_row64(const bf16_t* p, const float (&q)[64]) {
    float s = 0.f;
#pragma unroll
    for (int i = 0; i < 8; ++i) { const u32x4 w = *(const u32x4*)(p + 8 * i);
        s += q[8 * i + 0] * bf_lo(w.x) + q[8 * i + 1] * bf_hi(w.x) + q[8 * i + 2] * bf_lo(w.y) + q[8 * i + 3] * bf_hi(w.y) + q[8 * i + 4] * bf_lo(w.z) + q[8 * i + 5] * bf_hi(w.z) + q[8 * i + 6] * bf_lo(w.w) + q[8 * i + 7] * bf_hi(w.w); }
    return s;
}
__device__ __forceinline__ void phase_attention_ref(const Ctx& C) {
    const Args& A = *C.a; unsigned char* ws = A.ws; CTX_LANES();
    const int gw = C.vcu * 8 + wave, NGW = C.G * 8;
    const bf16_t* qna = (const bf16_t*)(ws + WS_QNA); const bf16_t* kna = (const bf16_t*)(ws + WS_KNA); const bf16_t* vna = (const bf16_t*)(ws + WS_VNA);
    const float* rpb = A.in[I_RPB];
    bf16_t* outna = (bf16_t*)(ws + WS_OUTNA);
    for (int it = gw; it < BATCH * NA_H * SEQ; it += NGW) {
        const int c = it & 63, r = (it >> 6) & 63, h = (it >> 12) & 7, b = it >> 15;
        const int rs = min(max(r - 4, 0), 56), cs = min(max(c - 8, 0), 48);
        const size_t hb = (size_t)(b * NA_H + h) * SEQ;
        float q[64]; load_row64(qna + (hb + r * 64 + c) * HD, q);
        float sc[2];
#pragma unroll
        for (int t = 0; t < 2; ++t) { const int kr = rs + (lane >> 4) + 4 * t, kc = cs + (lane & 15);
            const float s = dot_row64(kna + (hb + kr * 64 + kc) * HD, q);
            const float bias = rpb[(h * 15 + (kr - r + 7)) * 31 + (kc - c + 15)];
            sc[t] = s + bias * LOG2E; }
        const float mx = wave_max(fmaxf(sc[0], sc[1]));
        const float p0 = __builtin_amdgcn_exp2f(sc[0] - mx), p1 = __builtin_amdgcn_exp2f(sc[1] - mx);
        const float l = wave_sum(p0 + p1);
        float o = 0.f;
        for (int kk = 0; kk < 128; ++kk) { const int src = kk & 63; const float p = __shfl(kk < 64 ? p0 : p1, src);
            const int kr = rs + (src >> 4) + 4 * (kk >> 6), kc = cs + (src & 15);
            o += p * bf2f(vna[(hb + kr * 64 + kc) * HD + lane]); }
        outna[(size_t)(b * SEQ + r * 64 + c) * 512 + h * 64 + lane] = (bf16_t)f2bf(o / l);
    }
    const bf16_t* qd = (const bf16_t*)(ws + WS_QDIL); const bf16_t* kd = (const bf16_t*)(ws + WS_KDIL); const bf16_t* vd = (const bf16_t*)(ws + WS_VDIL);
    bf16_t* og = (bf16_t*)((unsigned char*)A.out + DO_OG); float* lse = (float*)(ws + WS_LSE);
    for (int it = gw; it < BATCH * DIL_H * SEQ; it += NGW) {
        const int sp = it & 4095, bh = it >> 12, hh = bh & 3, g = (bh >> 2) % 3, b = bh / 12;
        const int sh = 2 * g, L = SEQ >> sh, res = sp / L, mq = sp % L;
        const size_t hb = (size_t)bh * SEQ + (size_t)res * L;
        float q[64]; load_row64(qd + (hb + mq) * HD, q);
        float sc[3];
#pragma unroll
        for (int t = 0; t < 3; ++t) { const int kk = lane + 64 * t, mk = mq - 64 + kk; const bool ok = (kk <= 128) && (mk >= 0) && (mk < L);
            const int mc = min(max(mk, 0), L - 1);
            const float s = dot_row64(kd + (hb + mc) * HD, q);
            sc[t] = ok ? s : -INFINITY; }
        const float mx = wave_max(fmaxf(fmaxf(sc[0], sc[1]), sc[2]));
        float p[3];
#pragma unroll
        for (int t = 0; t < 3; ++t) p[t] = __builtin_amdgcn_exp2f(sc[t] - mx);
        const float l = wave_sum(p[0] + p[1] + p[2]);
        float o = 0.f;
        for (int kk = 0; kk <= 128; ++kk) { const int src = kk & 63; const float pv = __shfl(kk < 64 ? p[0] : (kk < 128 ? p[1] : p[2]), src);
            const int mc = min(max(mq - 64 + kk, 0), L - 1);
            o += pv * bf2f(vd[(hb + mc) * HD + lane]); }
        const int s = mq * (1 << sh) + res;
        const size_t tok = (size_t)b * SEQ + s;
        og[((size_t)g * T + tok) * 256 + hh * 64 + lane] = (bf16_t)f2bf(o / l);
        if (lane == 0) lse[((size_t)g * T + tok) * 4 + hh] = mx + __builtin_amdgcn_logf(l);
    }
}


typedef short s16x4 __attribute__((ext_vector_type(4)));
__device__ __forceinline__ void glds16(const void* g, LAS unsigned char* l) { __builtin_amdgcn_global_load_lds((const unsigned*)g, (LAS unsigned*)l, 16, 0, 0); }
__device__ __forceinline__ bf16x8 tr_pair(LAS unsigned char* p) {
    const s16x4 lo = __builtin_amdgcn_ds_read_tr16_b64_v4i16((LAS s16x4*)p), hi = __builtin_amdgcn_ds_read_tr16_b64_v4i16((LAS s16x4*)(p + 16 * 128));
    return __builtin_shufflevector(lo, hi, 0, 1, 2, 3, 4, 5, 6, 7);
}
__device__ __forceinline__ bf16x8 pack_p(const f32x4& a, const f32x4& b) {
    u32x4 w; w.x = cvt_pk_bf16(a.x, a.y); w.y = cvt_pk_bf16(a.z, a.w); w.z = cvt_pk_bf16(b.x, b.y); w.w = cvt_pk_bf16(b.z, b.w);
    return __builtin_bit_cast(bf16x8, w);
}
constexpr int DIL_KB = 32768, DIL_VB = 34816, DIL_BUF = DIL_KB + DIL_VB;
constexpr int NA_TILE = 15 * 32 * 128, NA_BIAS_OFF = 2 * NA_TILE;

struct DilUnit { int bh, g, sh, L, res, M0; };
__device__ __forceinline__ DilUnit dil_unit(int u) { DilUnit d; d.bh = u >> 5; d.g = (d.bh >> 2) % 3; d.sh = 2 * d.g; d.L = SEQ >> d.sh; const int sp0 = (u & 31) * 128; d.res = sp0 >> (12 - d.sh); d.M0 = sp0 & (d.L - 1); return d; }

__device__ __forceinline__ void phase_attention(const Ctx& C) {
    const Args& A = *C.a; unsigned char* ws = A.ws; CTX_LANES();
    const int i16 = lane & 15, g4 = lane >> 4;
    LAS unsigned char* lds = C.lds;
    const int kaddr0 = i16 * 128 + ((g4 ^ (i16 & 7)) * 16), kaddr1 = i16 * 128 + (((g4 + 4) ^ (i16 & 7)) * 16);
    int vaddr[4];
#pragma unroll
    for (int n = 0; n < 4; ++n) vaddr[n] = (4 * g4 + (i16 >> 2)) * 128 + ((n ^ (2 * (g4 & 1) + (i16 >> 3))) * 32) + (i16 & 3) * 8;
    const int lrow = lane >> 3, cpos = lane & 7;

    {
        const bf16_t* qna = (const bf16_t*)(ws + WS_QNA); const bf16_t* kna = (const bf16_t*)(ws + WS_KNA); const bf16_t* vna = (const bf16_t*)(ws + WS_VNA);
        const float* rpb = A.in[I_RPB]; bf16_t* outna = (bf16_t*)(ws + WS_OUTNA);
        LAS float* bt = (LAS float*)(lds + NA_BIAS_OFF);
        for (int u = C.vcu; u < BATCH * NA_H * 4 * 8; u += C.G) {
            const int R = u & 7, j = (u >> 3) & 3, h = (u >> 5) & 7, b = u >> 8;
            const int lo = min(max(8 * R - 4, 0), 49), kc0 = min(max(16 * j - 8, 0), 32);
            const size_t hb = (size_t)(b * NA_H + h) * SEQ;
#pragma unroll
            for (int i = 0; i < 8; ++i) { const int inst = wave + 8 * i;
                if (inst < 60) { const size_t tok = hb + (size_t)(lo + (inst >> 2)) * 64 + kc0 + 8 * (inst & 3) + lrow;
                    glds16(kna + tok * HD + ((cpos ^ lrow) * 8), lds + inst * 1024);
                    glds16(vna + tok * HD + ((cpos ^ (2 * ((lrow >> 1) & 3))) * 8), lds + NA_TILE + inst * 1024); } }
            if (tid_ < 15 * 32) { const int dr = tid_ >> 5, dc = tid_ & 31; bt[8 + tid_] = (dc < 31) ? rpb[(h * 15 + dr) * 31 + dc] * LOG2E : 0.f; }
            const int r = 8 * R + wave, rs = min(max(r - 4, 0), 56), roff = rs - lo, c = 16 * j + i16, cs = min(max(c - 8, 0), 48);
            bf16x8 qf0, qf1;
            { const bf16_t* qp = qna + (hb + r * 64 + c) * HD + 8 * g4; qf0 = *(const bf16x8*)qp; qf1 = *(const bf16x8*)(qp + 32); }
            asm volatile("s_waitcnt vmcnt(0) lgkmcnt(0)" ::: "memory");
            __syncthreads();
            f32x4 s[16];
            LAS unsigned char* kb = lds + roff * 32 * 128;
#pragma unroll
            for (int hf = 0; hf < 2; ++hf) {
                bf16x8 kf[8][2];
#pragma unroll
                for (int tt = 0; tt < 8; ++tt) { const int t = 8 * hf + tt, koff = ((t >> 1) * 32 + 16 * (t & 1)) * 128; kf[tt][0] = *(const LAS bf16x8*)(kb + koff + kaddr0); kf[tt][1] = *(const LAS bf16x8*)(kb + koff + kaddr1); }
#pragma unroll
                for (int tt = 0; tt < 8; ++tt) { f32x4 acc = (f32x4){0.f, 0.f, 0.f, 0.f};
                    acc = __builtin_amdgcn_mfma_f32_16x16x32_bf16(kf[tt][0], qf0, acc, 0, 0, 0);
                    acc = __builtin_amdgcn_mfma_f32_16x16x32_bf16(kf[tt][1], qf1, acc, 0, 0, 0);
                    s[8 * hf + tt] = acc; }
            }
            const int kcl0 = kc0 + 4 * g4 - cs;
            const LAS float* bp = bt + 8 + (rs - r + 7) * 32 + (kc0 + 4 * g4 - c + 15);
            float mx = -INFINITY;
#pragma unroll
            for (int t = 0; t < 16; ++t)
#pragma unroll
                for (int e = 0; e < 4; ++e) { const int rel = kcl0 + 16 * (t & 1) + e; const bool ok = (rel >= 0) && (rel < 16);
                    const float v = s[t][e] + bp[(t >> 1) * 32 + 16 * (t & 1) + e];
                    s[t][e] = ok ? v : -INFINITY; mx = fmaxf(mx, s[t][e]); }
            mx = max_x16_x32(mx);
            float l = 0.f;
#pragma unroll
            for (int t = 0; t < 16; ++t)
#pragma unroll
                for (int e = 0; e < 4; ++e) { s[t][e] = __builtin_amdgcn_exp2f(s[t][e] - mx); l += s[t][e]; }
            l = sum_x16_x32(l);
            f32x4 o[4];
#pragma unroll
            for (int n = 0; n < 4; ++n) o[n] = (f32x4){0.f, 0.f, 0.f, 0.f};
            LAS unsigned char* vb = lds + NA_TILE + roff * 32 * 128;
            {
                bf16x8 va[4], vn[4];
#pragma unroll
                for (int n = 0; n < 4; ++n) va[n] = tr_pair(vb + vaddr[n]);
#pragma unroll
                for (int ks = 0; ks < 8; ++ks) {
                    if (ks + 1 < 8) {
#pragma unroll
                        for (int n = 0; n < 4; ++n) vn[n] = tr_pair(vb + (ks + 1) * 32 * 128 + vaddr[n]); }
                    const bf16x8 pf = pack_p(s[2 * ks], s[2 * ks + 1]);
#pragma unroll
                    for (int n = 0; n < 4; ++n) o[n] = __builtin_amdgcn_mfma_f32_16x16x32_bf16(va[n], pf, o[n], 0, 0, 0);
#pragma unroll
                    for (int n = 0; n < 4; ++n) va[n] = vn[n];
                }
            }
            const float inv = 1.0f / l;
            unsigned char* op = (unsigned char*)outna + ((size_t)b * SEQ + r * 64 + c) * ACAT + h * 64 + 4 * g4;
            const float inv8 = inv * A8_SCALE;
#pragma unroll
            for (int n = 0; n < 4; ++n) *(unsigned*)(op + 16 * n) = pk4_fp8(o[n].x * inv8, o[n].y * inv8, o[n].z * inv8, o[n].w * inv8);
            __syncthreads();
        }
    }
    {
        const bf16_t* qd = (const bf16_t*)(ws + WS_QDIL); const bf16_t* kd = (const bf16_t*)(ws + WS_KDIL); const bf16_t* vd = (const bf16_t*)(ws + WS_VDIL);
        bf16_t* og = (bf16_t*)((unsigned char*)A.out + DO_OG); float* lse = (float*)(ws + WS_LSE);
        constexpr int NU = BATCH * DIL_H * 32;
        bf16x8 qn0, qn1;
        auto issue = [&](int u, int buf) {
            const DilUnit d = dil_unit(u);
            const size_t sb = (size_t)d.bh * SEQ + (size_t)d.res * d.L;
            LAS unsigned char* kb = lds + buf * DIL_BUF; LAS unsigned char* vb = kb + DIL_KB;
#pragma unroll
            for (int i = 0; i < 4; ++i) { const int inst = wave * 4 + i, row = inst * 8 + lrow; const int mp = min(max(d.M0 - 64 + row, 0), d.L - 1);
                glds16(kd + (sb + mp) * HD + ((cpos ^ lrow) * 8), kb + inst * 1024);
                glds16(vd + (sb + mp) * HD + ((cpos ^ (2 * ((lrow >> 1) & 3))) * 8), vb + inst * 1024); }
            if (wave < 2) { const int inst = 32 + wave, row = inst * 8 + lrow; const int mp = min(max(d.M0 - 64 + row, 0), d.L - 1);
                glds16(vd + (sb + mp) * HD + ((cpos ^ (2 * ((lrow >> 1) & 3))) * 8), vb + inst * 1024); }
            const bf16_t* qp = qd + (sb + d.M0 + 16 * wave + i16) * HD + 8 * g4; qn0 = *(const bf16x8*)qp; qn1 = *(const bf16x8*)(qp + 32);
        };
        int u = C.vcu, it = 0;
        if (u < NU) issue(u, 0);
        for (; u < NU; u += C.G, ++it) {
            const int buf = it & 1;
            asm volatile("s_waitcnt vmcnt(0)" ::: "memory");
            asm volatile("s_waitcnt lgkmcnt(0)" ::: "memory"); __builtin_amdgcn_s_barrier(); asm volatile("" ::: "memory");
            const bf16x8 qf0 = qn0, qf1 = qn1;
            if (u + C.G < NU) issue(u + C.G, buf ^ 1);
            const DilUnit d = dil_unit(u);
            LAS unsigned char* kb = lds + buf * DIL_BUF + wave * 16 * 128; LAS unsigned char* vb = lds + buf * DIL_BUF + DIL_KB + wave * 16 * 128;
            f32x4 s[10];
            {   bf16x8 kf[9][2];
#pragma unroll
                for (int t = 0; t < 9; ++t) { kf[t][0] = *(const LAS bf16x8*)(kb + t * 16 * 128 + kaddr0); kf[t][1] = *(const LAS bf16x8*)(kb + t * 16 * 128 + kaddr1); }
#pragma unroll
                for (int t = 0; t < 9; ++t) { f32x4 acc = (f32x4){0.f, 0.f, 0.f, 0.f};
                    acc = __builtin_amdgcn_mfma_f32_16x16x32_bf16(kf[t][0], qf0, acc, 0, 0, 0);
                    acc = __builtin_amdgcn_mfma_f32_16x16x32_bf16(kf[t][1], qf1, acc, 0, 0, 0);
                    s[t] = acc; }
            }
            s[9] = (f32x4){0.f, 0.f, 0.f, 0.f};
            const int mlo = d.M0 + 16 * wave - 64;
            float mx = -INFINITY;
#pragma unroll
            for (int t = 0; t < 9; ++t)
#pragma unroll
                for (int e = 0; e < 4; ++e) { const int kk = 16 * t + 4 * g4 + e, mk = mlo + kk; const bool ok = (kk >= i16) && (kk <= i16 + 128) && (mk >= 0) && (mk < d.L);
                    s[t][e] = ok ? s[t][e] : -INFINITY; mx = fmaxf(mx, s[t][e]); }
            mx = max_x16_x32(mx);
            float l = 0.f;
#pragma unroll
            for (int t = 0; t < 9; ++t)
#pragma unroll
                for (int e = 0; e < 4; ++e) { s[t][e] = __builtin_amdgcn_exp2f(s[t][e] - mx); l += s[t][e]; }
            l = sum_x16_x32(l);
            f32x4 o[4];
#pragma unroll
            for (int n = 0; n < 4; ++n) o[n] = (f32x4){0.f, 0.f, 0.f, 0.f};
            {   bf16x8 va[4], vn[4];
#pragma unroll
                for (int n = 0; n < 4; ++n) va[n] = tr_pair(vb + vaddr[n]);
#pragma unroll
                for (int ks = 0; ks < 5; ++ks) {
                    if (ks + 1 < 5) {
#pragma unroll
                        for (int n = 0; n < 4; ++n) vn[n] = tr_pair(vb + (ks + 1) * 32 * 128 + vaddr[n]); }
                    const bf16x8 pf = pack_p(s[2 * ks], s[2 * ks + 1]);
#pragma unroll
                    for (int n = 0; n < 4; ++n) o[n] = __builtin_amdgcn_mfma_f32_16x16x32_bf16(va[n], pf, o[n], 0, 0, 0);
#pragma unroll
                    for (int n = 0; n < 4; ++n) va[n] = vn[n];
                }
            }
            const float inv = 1.0f / l;
            const int m = d.M0 + 16 * wave + i16, b = d.bh / 12, hh = d.bh & 3;
            const size_t tok = (size_t)b * SEQ + ((size_t)m << d.sh) + d.res;
            bf16_t* op = og + ((size_t)d.g * T + tok) * 256 + hh * 64 + 4 * g4;
#pragma unroll
            for (int n = 0; n < 4; ++n) *(u32x2*)(op + 16 * n) = (u32x2){cvt_pk_bf16(o[n].x * inv, o[n].y * inv), cvt_pk_bf16(o[n].z * inv, o[n].w * inv)};
            if (g4 == 0) lse[((size_t)d.g * T + tok) * 4 + hh] = mx + __builtin_amdgcn_logf(l);
        }
        asm volatile("s_waitcnt vmcnt(0)" ::: "memory");
        __syncthreads();
    }
}

__device__ __forceinline__ void phase_dil_combine(const Ctx& C) {
    const Args& A = *C.a; unsigned char* ws = A.ws;
    const bf16_t* og = (const bf16_t*)((unsigned char*)A.out + DO_OG); const float* lse = (const float*)(ws + WS_LSE);
    unsigned char* od = ws + WS_OUTNA + 512; CTX_LANES();
    const size_t gt = (size_t)(C.vcu * 512 + tid_), NT = (size_t)C.G * 512;
    for (size_t i = gt; i < (size_t)T * 32; i += NT) {
        const size_t tok = i >> 5; const int ch = (int)(i & 31), hh = ch >> 3;
        const float l0 = lse[(0 * (size_t)T + tok) * 4 + hh], l1 = lse[(1 * (size_t)T + tok) * 4 + hh], l2 = lse[(2 * (size_t)T + tok) * 4 + hh];
        const float mx = fmaxf(l0, fmaxf(l1, l2));
        float w0 = __builtin_amdgcn_exp2f(l0 - mx), w1 = __builtin_amdgcn_exp2f(l1 - mx), w2 = __builtin_amdgcn_exp2f(l2 - mx);
        const float inv = 1.0f / (w0 + w1 + w2); w0 *= inv; w1 *= inv; w2 *= inv;
        const u32x4 a = *(const u32x4*)(og + (0 * (size_t)T + tok) * 256 + ch * 8), b = *(const u32x4*)(og + (1 * (size_t)T + tok) * 256 + ch * 8), c = *(const u32x4*)(og + (2 * (size_t)T + tok) * 256 + ch * 8);
        w0 *= A8_SCALE; w1 *= A8_SCALE; w2 *= A8_SCALE;
        u32x2 o;
        o.x = pk4_fp8(w0 * bf_lo(a.x) + w1 * bf_lo(b.x) + w2 * bf_lo(c.x), w0 * bf_hi(a.x) + w1 * bf_hi(b.x) + w2 * bf_hi(c.x), w0 * bf_lo(a.y) + w1 * bf_lo(b.y) + w2 * bf_lo(c.y), w0 * bf_hi(a.y) + w1 * bf_hi(b.y) + w2 * bf_hi(c.y));
        o.y = pk4_fp8(w0 * bf_lo(a.z) + w1 * bf_lo(b.z) + w2 * bf_lo(c.z), w0 * bf_hi(a.z) + w1 * bf_hi(b.z) + w2 * bf_hi(c.z), w0 * bf_lo(a.w) + w1 * bf_lo(b.w) + w2 * bf_lo(c.w), w0 * bf_hi(a.w) + w1 * bf_hi(b.w) + w2 * bf_hi(c.w));
        *(u32x2*)(od + tok * ACAT + ch * 8) = o;
    }
}

__device__ __forceinline__ void ins16(float (&a)[16], float x) {
    float prev = a[0]; a[0] = fmaxf(prev, x);
#pragma unroll
    for (int i = 1; i < 16; ++i) { const float cur = a[i]; a[i] = __builtin_amdgcn_fmed3f(prev, cur, x); prev = cur; }
}
struct EpiScoresTopk {
    static constexpr bool AFTER_DRAIN = true;
    const float* ssq; unsigned short* ridx; float* rg;
    __device__ __forceinline__ void fused(const f32x4 (&acc)[2][2][4][2], const Unit& u, int wr, int wc, int fr, int fq, PG8_LAS unsigned char* lds) const {
        constexpr int SROW = 528;
        const int tid = opaque_tid();
        {
            const int row0l = wr * 64 + fr, colb = (wc * 64 + 8 * fq) * 2;
#pragma unroll
            for (int it = 0; it < 8; ++it) {
                const int ai = it >> 2, m = it & 3, rl = row0l + ai * 128 + m * 16;
                const f32x4* sp = (const f32x4*)(ssq + (size_t)(u.pm * 256 + rl) * 16);
                const f32x4 s0 = sp[0], s1 = sp[1], s2 = sp[2], s3 = sp[3];
                const float tot = ((s0.x + s0.y) + (s0.z + s0.w)) + ((s1.x + s1.y) + (s1.z + s1.w)) + ((s2.x + s2.y) + (s2.z + s2.w)) + ((s3.x + s3.y) + (s3.z + s3.w));
                const float rs = 1.0f / sqrtf(tot * (1.0f / D) + RMS_EPS);
#pragma unroll
                for (int bj = 0; bj < 2; ++bj) {
                    const f32x4 a = acc[ai][bj][m][0] * rs, b = acc[ai][bj][m][1] * rs;
                    *(PG8_LAS h16x8*)(lds + rl * SROW + colb + 64 * bj) = (h16x8){(_Float16)a.x, (_Float16)a.y, (_Float16)a.z, (_Float16)a.w, (_Float16)b.x, (_Float16)b.y, (_Float16)b.z, (_Float16)b.w};
                }
            }
        }
        __syncthreads();
        const int row = tid & 255, side = tid >> 8;
        float a1[16];
#pragma unroll
        for (int i = 0; i < 16; ++i) a1[i] = -1e30f;
#pragma unroll
        for (int i = 0; i < 16; ++i) { const h16x8 v = *(const PG8_LAS h16x8*)(lds + row * SROW + side * 256 + i * 16);
#pragma unroll
            for (int j = 0; j < 8; ++j) ins16(a1, __builtin_bit_cast(float, (__builtin_bit_cast(unsigned, (float)v[j]) & ~0x7Fu) | (unsigned)(i * 8 + j))); }
        __syncthreads();
        PG8_LAS float* lst = (PG8_LAS float*)(lds + tid * 80);
#pragma unroll
        for (int i = 0; i < 4; ++i) *(PG8_LAS f32x4*)(lst + 4 * i) = (f32x4){a1[4 * i], a1[4 * i + 1], a1[4 * i + 2], a1[4 * i + 3]};
        __syncthreads();
        if (side == 0) {
            float a2[16];
            const PG8_LAS float* pl = (const PG8_LAS float*)(lds + (tid + 256) * 80);
#pragma unroll
            for (int i = 0; i < 4; ++i) { const f32x4 q = *(const PG8_LAS f32x4*)(pl + 4 * i); a2[4 * i] = q.x; a2[4 * i + 1] = q.y; a2[4 * i + 2] = q.z; a2[4 * i + 3] = q.w; }
            PG8_LAS unsigned char* ib = lds + 512 * 80 + tid * 32;
            float v1[16], v2[16];
#pragma unroll
            for (int i = 0; i < 16; ++i) { const unsigned b1 = __builtin_bit_cast(unsigned, a1[i]), b2 = __builtin_bit_cast(unsigned, a2[i]);
                v1[i] = __builtin_bit_cast(float, b1 & ~0x7Fu); v2[i] = __builtin_bit_cast(float, b2 & ~0x7Fu);
                ib[i] = (unsigned char)(b1 & 0x7Fu); ib[16 + i] = (unsigned char)(b2 & 0x7Fu); }
            float cc[16];
#pragma unroll
            for (int i = 0; i < 16; ++i) cc[i] = -1e30f;
#pragma unroll
            for (int i = 0; i < 16; ++i)
#pragma unroll
                for (int j = 0; j < 16; ++j)
                    if ((i + 1) * (j + 1) <= 16) { const float s = v1[i] + v2[j]; ins16(cc, __builtin_bit_cast(float, (__builtin_bit_cast(unsigned, s) & ~0xFFu) | (unsigned)(i * 16 + j))); }
            asm volatile("s_waitcnt lgkmcnt(0)" ::: "memory");
            float sv[16]; int ei[16]; float mx = -1e30f;
#pragma unroll
            for (int k = 0; k < 16; ++k) { const unsigned b = __builtin_bit_cast(unsigned, cc[k]); sv[k] = __builtin_bit_cast(float, b & ~0xFFu); const int i = (b >> 4) & 15, j = b & 15;
                const int i1 = ib[i], i2 = ib[16 + j]; ei[k] = i1 * 128 + i2; mx = fmaxf(mx, sv[k]); }
            float sum = 0.f;
#pragma unroll
            for (int k = 0; k < 16; ++k) { sv[k] = __expf(sv[k] - mx); sum += sv[k]; }
            const float inv = 1.0f / sum;
            const size_t ob = (size_t)(u.pm * 256 + row) * 128 + (size_t)u.pn * 16;
#pragma unroll
            for (int k = 0; k < 4; ++k) { *(f32x4*)(rg + ob + 4 * k) = (f32x4){sv[4 * k] * inv, sv[4 * k + 1] * inv, sv[4 * k + 2] * inv, sv[4 * k + 3] * inv};
                *(u32x2*)(ridx + ob + 4 * k) = (u32x2){(unsigned)ei[4 * k] | ((unsigned)ei[4 * k + 1] << 16), (unsigned)ei[4 * k + 2] | ((unsigned)ei[4 * k + 3] << 16)}; }
        }
        asm volatile("s_waitcnt lgkmcnt(0)" ::: "memory");
        __syncthreads();
    }
};
__device__ __forceinline__ void phase_topk(const Ctx& C) {
    const Args& A = *C.a; unsigned char* ws = A.ws; CTX_LANES();
    const _Float16* S = (const _Float16*)(ws + WS_SCORES); unsigned short* ridx = (unsigned short*)(ws + WS_RIDX); float* rg = (float*)(ws + WS_RG);
    LAS unsigned char* scr = C.lds + wave * 9216;
    const int gw = C.vcu * 8 + wave, NGW = C.G * 8;
    for (int it = gw; it < T / 8; it += NGW) {
        const _Float16* base = S + (size_t)it * 8 * 2048;
        float a1[16], a2[16];
#pragma unroll
        for (int i = 0; i < 16; ++i) { a1[i] = -1e30f; a2[i] = -1e30f; }
#pragma unroll 1
        for (int c = 0; c < 4; ++c) {
#pragma unroll
            for (int i = 0; i < 8; ++i) { const int q = i * 64 + lane, task = q >> 3, part = q & 7;
                *(LAS u32x4*)(scr + task * 144 + part * 16) = *(const u32x4*)(base + (size_t)task * 256 + c * 64 + part * 8); }
            asm volatile("s_waitcnt vmcnt(0) lgkmcnt(0)" ::: "memory");
            if (c < 2) {
#pragma unroll
                for (int i = 0; i < 8; ++i) { const h16x8 v = *(const LAS h16x8*)(scr + lane * 144 + i * 16);
#pragma unroll
                    for (int j = 0; j < 8; ++j) { const unsigned id = (unsigned)(c * 64 + i * 8 + j); ins16(a1, __builtin_bit_cast(float, (__builtin_bit_cast(unsigned, (float)v[j]) & ~0x7Fu) | id)); } }
            } else {
#pragma unroll
                for (int i = 0; i < 8; ++i) { const h16x8 v = *(const LAS h16x8*)(scr + lane * 144 + i * 16);
#pragma unroll
                    for (int j = 0; j < 8; ++j) { const unsigned id = (unsigned)((c - 2) * 64 + i * 8 + j); ins16(a2, __builtin_bit_cast(float, (__builtin_bit_cast(unsigned, (float)v[j]) & ~0x7Fu) | id)); } }
            }
            asm volatile("s_waitcnt lgkmcnt(0)" ::: "memory");
        }
        float v1[16], v2[16];
#pragma unroll
        for (int i = 0; i < 16; ++i) { const unsigned b1 = __builtin_bit_cast(unsigned, a1[i]), b2 = __builtin_bit_cast(unsigned, a2[i]);
            v1[i] = __builtin_bit_cast(float, b1 & ~0x7Fu); v2[i] = __builtin_bit_cast(float, b2 & ~0x7Fu);
            *(LAS unsigned char*)(scr + lane * 144 + i) = (unsigned char)(b1 & 0x7Fu); *(LAS unsigned char*)(scr + lane * 144 + 16 + i) = (unsigned char)(b2 & 0x7Fu); }
        float cc[16];
#pragma unroll
        for (int i = 0; i < 16; ++i) cc[i] = -1e30f;
#pragma unroll
        for (int i = 0; i < 16; ++i)
#pragma unroll
            for (int j = 0; j < 16; ++j)
                if ((i + 1) * (j + 1) <= 16) { const float s = v1[i] + v2[j]; ins16(cc, __builtin_bit_cast(float, (__builtin_bit_cast(unsigned, s) & ~0xFFu) | (unsigned)(i * 16 + j))); }
        asm volatile("s_waitcnt lgkmcnt(0)" ::: "memory");
        float sv[16]; int ei[16]; float mx = -1e30f;
#pragma unroll
        for (int k = 0; k < 16; ++k) { const unsigned b = __builtin_bit_cast(unsigned, cc[k]); sv[k] = __builtin_bit_cast(float, b & ~0xFFu); const int i = (b >> 4) & 15, j = b & 15;
            const int i1 = *(const LAS unsigned char*)(scr + lane * 144 + i), i2 = *(const LAS unsigned char*)(scr + lane * 144 + 16 + j);
            ei[k] = i1 * 128 + i2; mx = fmaxf(mx, sv[k]); }
        float sum = 0.f;
#pragma unroll
        for (int k = 0; k < 16; ++k) { sv[k] = __expf(sv[k] - mx); sum += sv[k]; }
        const float inv = 1.0f / sum;
        const size_t ob = (size_t)it * 8 * 128 + (size_t)lane * 16;
#pragma unroll
        for (int k = 0; k < 4; ++k) { *(f32x4*)(rg + ob + 4 * k) = (f32x4){sv[4 * k] * inv, sv[4 * k + 1] * inv, sv[4 * k + 2] * inv, sv[4 * k + 3] * inv};
            *(u32x2*)(ridx + ob + 4 * k) = (u32x2){(unsigned)ei[4 * k] | ((unsigned)ei[4 * k + 1] << 16), (unsigned)ei[4 * k + 2] | ((unsigned)ei[4 * k + 3] << 16)}; }
        asm volatile("s_waitcnt lgkmcnt(0)" ::: "memory");
    }
}
__device__ __forceinline__ void phase_hq(const Ctx& C) {
    const Args& A = *C.a; unsigned char* ws = A.ws; CTX_LANES();
    const int gw = C.vcu * 8 + wave, NGW = C.G * 8;
    {
        const bf16_t* x1 = (const bf16_t*)(ws + WS_X1B); const float* gf = A.in[I_NORM_FFN]; unsigned char* hq = ws + WS_HQ; float* hs = (float*)(ws + WS_HS);
        f32x4 gv[4];
#pragma unroll
        for (int j = 0; j < 4; ++j) gv[j] = *(const f32x4*)(gf + 16 * lane + 4 * j);
        for (int tok0 = gw * 4; tok0 < T; tok0 += NGW * 4) {
            u32x2 xw[4][4];
#pragma unroll
            for (int r = 0; r < 4; ++r)
#pragma unroll
                for (int j = 0; j < 4; ++j) xw[r][j] = *(const u32x2*)(x1 + (size_t)(tok0 + r) * D + 16 * lane + 4 * j);
#pragma unroll
            for (int r = 0; r < 4; ++r) { const int tok = tok0 + r;
                f32x4 h[4]; float am = 0.f;
#pragma unroll
                for (int j = 0; j < 4; ++j) { h[j] = (f32x4){bf_lo(xw[r][j].x), bf_hi(xw[r][j].x), bf_lo(xw[r][j].y), bf_hi(xw[r][j].y)} * gv[j]; am = fmaxf(am, fmaxf(fmaxf(fabsf(h[j].x), fabsf(h[j].y)), fmaxf(fabsf(h[j].z), fabsf(h[j].w)))); }
                am = fmaxf(am, dppc<0xB1>(am)); am = fmaxf(am, dppc<0x4E>(am)); am = fmaxf(am, dppc<0x141>(am));
                const float inv = am > 0.f ? 127.0f / am : 0.f;
                unsigned w[4];
#pragma unroll
                for (int j = 0; j < 4; ++j) { const int q0 = (int)__builtin_rintf(h[j].x * inv), q1 = (int)__builtin_rintf(h[j].y * inv), q2 = (int)__builtin_rintf(h[j].z * inv), q3 = (int)__builtin_rintf(h[j].w * inv);
                    w[j] = ((unsigned)q0 & 0xffu) | (((unsigned)q1 & 0xffu) << 8) | (((unsigned)q2 & 0xffu) << 16) | ((unsigned)q3 << 24); }
                *(u32x4*)(hq + (size_t)tok * D + 16 * lane) = (u32x4){w[0], w[1], w[2], w[3]};
                if ((lane & 7) == 0) hs[(size_t)tok * 8 + (lane >> 3)] = am * (1.0f / 127.0f); }
        }
    }
}

__device__ __forceinline__ float ub0(unsigned w) { return (float)(w & 0xffu); }
__device__ __forceinline__ float ub1(unsigned w) { return (float)((w >> 8) & 0xffu); }
__device__ __forceinline__ float ub2(unsigned w) { return (float)((w >> 16) & 0xffu); }
__device__ __forceinline__ float ub3(unsigned w) { return (float)(w >> 24); }
__device__ __forceinline__ float dot16(const u32x4& r, const f32x4 (&h)[4], float acc) {
    f32x2 a = (f32x2){acc, 0.f};
    a += (f32x2){ub0(r.x), ub1(r.x)} * (f32x2){h[0].x, h[0].y}; a += (f32x2){ub2(r.x), ub3(r.x)} * (f32x2){h[0].z, h[0].w};
    a += (f32x2){ub0(r.y), ub1(r.y)} * (f32x2){h[1].x, h[1].y}; a += (f32x2){ub2(r.y), ub3(r.y)} * (f32x2){h[1].z, h[1].w};
    a += (f32x2){ub0(r.z), ub1(r.z)} * (f32x2){h[2].x, h[2].y}; a += (f32x2){ub2(r.z), ub3(r.z)} * (f32x2){h[2].z, h[2].w};
    a += (f32x2){ub0(r.w), ub1(r.w)} * (f32x2){h[3].x, h[3].y}; a += (f32x2){ub2(r.w), ub3(r.w)} * (f32x2){h[3].z, h[3].w};
    return a.x + a.y;
}
__device__ __forceinline__ void axpy16(const u32x4& r, float c, f32x4 (&o)[4]) {
    o[0].x += c * ub0(r.x); o[0].y += c * ub1(r.x); o[0].z += c * ub2(r.x); o[0].w += c * ub3(r.x);
    o[1].x += c * ub0(r.y); o[1].y += c * ub1(r.y); o[1].z += c * ub2(r.y); o[1].w += c * ub3(r.y);
    o[2].x += c * ub0(r.z); o[2].y += c * ub1(r.z); o[2].z += c * ub2(r.z); o[2].w += c * ub3(r.z);
    o[3].x += c * ub0(r.w); o[3].y += c * ub1(r.w); o[3].z += c * ub2(r.w); o[3].w += c * ub3(r.w);
}
__device__ __forceinline__ float reduce8_safe(const float (&p)[8], int lane) {
    float t = 0.f;
#pragma unroll
    for (int r = 0; r < 8; ++r) { const float s = wave_sum(p[r]); t = ((lane & 7) == r) ? s : t; }
    return t;
}
__device__ __forceinline__ float reduce8(const float (&p)[8], int lane) {
    const bool u4 = (lane & 4) != 0, u2 = (lane & 2) != 0, u1 = (lane & 1) != 0;
    float q[4];
#pragma unroll
    for (int r = 0; r < 4; ++r) { const float keep = u4 ? p[r + 4] : p[r], send = u4 ? p[r] : p[r + 4]; q[r] = keep + dppc<0x141>(send); }
    float s[2];
#pragma unroll
    for (int r = 0; r < 2; ++r) { const float keep = u2 ? q[r + 2] : q[r], send = u2 ? q[r] : q[r + 2]; s[r] = keep + dppc<0x4E>(send); }
    float t; { const float keep = u1 ? s[1] : s[0], send = u1 ? s[0] : s[1]; t = keep + dppc<0xB1>(send); }
    t += dppc<0x128>(t);
    { float a = t, b = t; asm volatile("s_nop 1\n\tv_permlane16_swap_b32 %0, %1" : "+v"(a), "+v"(b)); t = a + b; }
    { float a = t, b = t; asm volatile("s_nop 1\n\tv_permlane32_swap_b32 %0, %1" : "+v"(a), "+v"(b)); t = a + b; }
    return t;
}
__device__ __forceinline__ float reduce8_grp(const float (&p)[8], int lane) {
    const bool u4 = (lane & 4) != 0, u2 = (lane & 2) != 0, u1 = (lane & 1) != 0;
    float q[4];
#pragma unroll
    for (int r = 0; r < 4; ++r) { const float keep = u4 ? p[r + 4] : p[r], send = u4 ? p[r] : p[r + 4]; q[r] = keep + dppc<0x141>(send); }
    float s[2];
#pragma unroll
    for (int r = 0; r < 2; ++r) { const float keep = u2 ? q[r + 2] : q[r], send = u2 ? q[r] : q[r + 2]; s[r] = keep + dppc<0x4E>(send); }
    const float keep = u1 ? s[1] : s[0], send = u1 ? s[0] : s[1];
    return keep + dppc<0xB1>(send);
}
constexpr int PEER_NCHUNK = T / 16;
#define SB() __builtin_amdgcn_sched_barrier(0)
#define PEER_LOAD8(dst, b) do { const u32x4 ia_ = *(const LAS u32x4*)(ip + 4 * (b)); \
        dst[0] = *(const u32x4*)(tab + (ia_.x & 0xffffu) * 128u); dst[1] = *(const u32x4*)(tab + (ia_.x >> 16) * 128u); dst[2] = *(const u32x4*)(tab + (ia_.y & 0xffffu) * 128u); dst[3] = *(const u32x4*)(tab + (ia_.y >> 16) * 128u); \
        dst[4] = *(const u32x4*)(tab + (ia_.z & 0xffffu) * 128u); dst[5] = *(const u32x4*)(tab + (ia_.z >> 16) * 128u); dst[6] = *(const u32x4*)(tab + (ia_.w & 0xffffu) * 128u); dst[7] = *(const u32x4*)(tab + (ia_.w >> 16) * 128u); } while (0)
typedef int i32x4 __attribute__((ext_vector_type(4)));
template <int CTRL> __device__ __forceinline__ int dppi(int v) { return __builtin_amdgcn_update_dpp(0, v, CTRL, 0xf, 0xf, true); }
__device__ __forceinline__ int reduce8_grp_i(const int (&p)[8], int lane) {
    const bool u4 = (lane & 4) != 0, u2 = (lane & 2) != 0, u1 = (lane & 1) != 0;
    int q[4];
#pragma unroll
    for (int r = 0; r < 4; ++r) { const int keep = u4 ? p[r + 4] : p[r], send = u4 ? p[r] : p[r + 4]; q[r] = keep + dppi<0x141>(send); }
    int s[2];
#pragma unroll
    for (int r = 0; r < 2; ++r) { const int keep = u2 ? q[r + 2] : q[r], send = u2 ? q[r] : q[r + 2]; s[r] = keep + dppi<0x4E>(send); }
    const int keep = u1 ? s[1] : s[0], send = u1 ? s[0] : s[1];
    return keep + dppi<0xB1>(send);
}
__device__ __forceinline__ int dot32n(const u32x4& r, const u32x4& ha, const u32x4& hb) {
    int a = __builtin_amdgcn_sdot8((int)r.x, (int)ha.x, 0, false); a = __builtin_amdgcn_sdot8((int)r.y, (int)ha.y, a, false);
    a = __builtin_amdgcn_sdot8((int)r.z, (int)ha.z, a, false); a = __builtin_amdgcn_sdot8((int)r.w, (int)ha.w, a, false);
    int b = __builtin_amdgcn_sdot8((int)r.x, (int)hb.x, 0, false); b = __builtin_amdgcn_sdot8((int)r.y, (int)hb.y, b, false);
    b = __builtin_amdgcn_sdot8((int)r.z, (int)hb.z, b, false); b = __builtin_amdgcn_sdot8((int)r.w, (int)hb.w, b, false);
    return (a << 4) + b;
}
__device__ __forceinline__ void phase_peer_u(const Ctx& C) {
    const Args& A = *C.a; unsigned char* ws = A.ws; CTX_LANES();
    const int g = lane >> 3, c = lane & 7;
    const unsigned* ridx = (const unsigned*)(ws + WS_RIDX); const float* gfp = A.in[I_NORM_FFN];
    unsigned* Q = (unsigned*)(ws + WS_CTL) + CW_QU + A.li * 1024;
    LAS unsigned* sidx = (LAS unsigned*)(C.lds + wave * 16384);
    const int xcc = (int)(xb_xcc_id() & 7u);
    for (int so = 0; so < 4; ++so) {
        const int s = (xcc + so) & 3;
        const unsigned char* tab = ws + WS_EU + (size_t)s * (NEXP * 128) + 16 * c;
        const bf16_t* x1s = (const bf16_t*)(ws + WS_X1B) + 256 * s + 32 * c;
        f32x4 gv[8];
#pragma unroll
        for (int j = 0; j < 8; ++j) gv[j] = *(const f32x4*)(gfp + 256 * s + 32 * c + 4 * j);
        _Float16* part = (_Float16*)(ws + WS_PART) + (size_t)s * T * 128;
        for (;;) {
            int ch = 0; if (lane == 0) ch = (int)atomicAdd(&Q[64 * s], 1u);
            ch = __builtin_amdgcn_readfirstlane(ch);
            if (ch >= PEER_NCHUNK) break;
            const int tok0 = ch * 16;
#pragma unroll
            for (int i = 0; i < 4; ++i) *(LAS u32x4*)(sidx + (i * 64 + lane) * 4) = __builtin_nontemporal_load((const u32x4*)(ridx + (size_t)tok0 * 64) + i * 64 + lane);
            u32x4 wa[4];
#pragma unroll
            for (int i = 0; i < 4; ++i) wa[i] = *(const u32x4*)(x1s + (size_t)(tok0 + g) * D + 8 * i);
#pragma unroll 1
            for (int sub = 0; sub < 2; ++sub) {
                const int tok = tok0 + sub * 8 + g;
                u32x4 ha, hb; float sc;
                {
                  f32x4 hv[8];
#pragma unroll
                  for (int i = 0; i < 4; ++i) { hv[2 * i] = (f32x4){bf_lo(wa[i].x), bf_hi(wa[i].x), bf_lo(wa[i].y), bf_hi(wa[i].y)} * gv[2 * i]; hv[2 * i + 1] = (f32x4){bf_lo(wa[i].z), bf_hi(wa[i].z), bf_lo(wa[i].w), bf_hi(wa[i].w)} * gv[2 * i + 1]; }
                  float am = 0.f;
#pragma unroll
                  for (int j = 0; j < 8; ++j) am = fmaxf(am, fmaxf(fmaxf(fabsf(hv[j].x), fabsf(hv[j].y)), fmaxf(fabsf(hv[j].z), fabsf(hv[j].w))));
                  am = fmaxf(am, dppc<0xB1>(am)); am = fmaxf(am, dppc<0x4E>(am)); am = fmaxf(am, dppc<0x141>(am));
                  const float qi = am > 0.f ? 119.0f / am : 0.f; sc = am * (1.0f / 119.0f);
                  unsigned e[8];
#pragma unroll
                  for (int j = 0; j < 8; ++j) { const int q0 = (int)__builtin_rintf(hv[j].x * qi) + 8, q1 = (int)__builtin_rintf(hv[j].y * qi) + 8, q2 = (int)__builtin_rintf(hv[j].z * qi) + 8, q3 = (int)__builtin_rintf(hv[j].w * qi) + 8;
                      e[j] = ((unsigned)q0 & 0xffu) | (((unsigned)q1 & 0xffu) << 8) | (((unsigned)q2 & 0xffu) << 16) | ((unsigned)q3 << 24); }
                  unsigned a4[4], b4[4];
#pragma unroll
                  for (int j = 0; j < 4; ++j) { a4[j] = ((e[2 * j] >> 4) & 0x0F0F0F0Fu) | (e[2 * j + 1] & 0xF0F0F0F0u); b4[j] = ((e[2 * j] & 0x0F0F0F0Fu) | ((e[2 * j + 1] & 0x0F0F0F0Fu) << 4)) ^ 0x88888888u; }
                  ha = (u32x4){a4[0], a4[1], a4[2], a4[3]}; hb = (u32x4){b4[0], b4[1], b4[2], b4[3]}; }
                if (sub == 0) {
#pragma unroll
                    for (int i = 0; i < 4; ++i) wa[i] = *(const u32x4*)(x1s + (size_t)(tok + 8) * D + 8 * i); }
                const LAS unsigned* ip = sidx + (sub * 8 + g) * 64;
                _Float16* pp = part + (size_t)tok * 128 + c;
                u32x4 r0[8], r1[8], r2[8], r3[8];
#define PEER_DOTB(src, b) do { int p_[8]; _Pragma("unroll") for (int k_ = 0; k_ < 8; ++k_) p_[k_] = dot32n(src[k_], ha, hb); __builtin_nontemporal_store((_Float16)((float)reduce8_grp_i(p_, lane) * sc), pp + 8 * (b)); } while (0)
                PEER_LOAD8(r0, 0); PEER_LOAD8(r1, 1); PEER_LOAD8(r2, 2); PEER_LOAD8(r3, 3); SB();
#pragma unroll
                for (int b4_ = 0; b4_ < 16; b4_ += 4) {
                    PEER_DOTB(r0, b4_); SB(); if (b4_ + 4 < 16) PEER_LOAD8(r0, b4_ + 4); SB();
                    PEER_DOTB(r1, b4_ + 1); SB(); if (b4_ + 5 < 16) PEER_LOAD8(r1, b4_ + 5); SB();
                    PEER_DOTB(r2, b4_ + 2); SB(); if (b4_ + 6 < 16) PEER_LOAD8(r2, b4_ + 6); SB();
                    PEER_DOTB(r3, b4_ + 3); SB(); if (b4_ + 7 < 16) PEER_LOAD8(r3, b4_ + 7); SB();
                }
#undef PEER_DOTB
            }
        }
    }
}
__device__ __forceinline__ void phase_peer_coef(const Ctx& C) {
    const Args& A = *C.a; unsigned char* ws = A.ws; CTX_LANES();
    const _Float16* part = (const _Float16*)(ws + WS_PART); const float* SU = (const float*)(ws + WS_SU); const float* SV = (const float*)(ws + WS_SV);
    const unsigned short* ridx = (const unsigned short*)(ws + WS_RIDX); const float* rg = (const float*)(ws + WS_RG); const float* ssq = (const float*)(ws + WS_SSQ2); _Float16* coef = (_Float16*)(ws + WS_COEF);
    typedef _Float16 h16x4 __attribute__((ext_vector_type(4)));
    const size_t gt = (size_t)(C.vcu * 512 + tid_), NT = (size_t)C.G * 512;
    for (size_t i4 = gt; i4 < (size_t)T * 32; i4 += NT) {
        const size_t tok = i4 >> 5, i = i4 * 4;
        const f32x4* sp = (const f32x4*)(ssq + tok * 16);
        const f32x4 s0 = sp[0], s1 = sp[1], s2 = sp[2], s3 = sp[3];
        const float tot = ((s0.x + s0.y) + (s0.z + s0.w)) + ((s1.x + s1.y) + (s1.z + s1.w)) + ((s2.x + s2.y) + (s2.z + s2.w)) + ((s3.x + s3.y) + (s3.z + s3.w));
        const float rs2 = 1.0f / sqrtf(tot * (1.0f / D) + RMS_EPS);
        f32x4 a = (f32x4){0.f, 0.f, 0.f, 0.f};
#pragma unroll
        for (int s = 0; s < 4; ++s) { const h16x4 p = __builtin_nontemporal_load((const h16x4*)(part + (size_t)s * T * 128 + i)); a += (f32x4){(float)p.x, (float)p.y, (float)p.z, (float)p.w}; }
        const u32x2 ew = *(const u32x2*)(ridx + i); const f32x4 g = *(const f32x4*)(rg + i);
        const unsigned e0 = ew.x & 0xffffu, e1 = ew.x >> 16, e2 = ew.y & 0xffffu, e3 = ew.y >> 16;
        f32x4 cf = (f32x4){gelu_erf(a.x * SU[e0] * rs2) * g.x * SV[e0], gelu_erf(a.y * SU[e1] * rs2) * g.y * SV[e1], gelu_erf(a.z * SU[e2] * rs2) * g.z * SV[e2], gelu_erf(a.w * SU[e3] * rs2) * g.w * SV[e3]};
        { h16x4 o; o.x = (_Float16)cf.x; o.y = (_Float16)cf.y; o.z = (_Float16)cf.z; o.w = (_Float16)cf.w; *(h16x4*)(coef + i) = o; }
        cf *= 256.0f;
        unsigned char* c8 = ws + WS_COEF8 + tok * 384 + (i & 127);
#pragma unroll
        for (int part_ = 0; part_ < 3; ++part_) {
            const unsigned w8 = pk4_fp8(cf.x, cf.y, cf.z, cf.w);
            *(unsigned*)(c8 + part_ * 128) = w8;
            cf -= (f32x4){__builtin_amdgcn_cvt_f32_fp8((int)w8, 0), __builtin_amdgcn_cvt_f32_fp8((int)w8, 1), __builtin_amdgcn_cvt_f32_fp8((int)w8, 2), __builtin_amdgcn_cvt_f32_fp8((int)w8, 3)};
        }
    }
}
typedef _Float16 h16x2 __attribute__((ext_vector_type(2)));
__device__ __forceinline__ void axpy32_fp4(const u32x4& r, _Float16 c, h16x2 (&o)[16]) {
    const h16x2 cc = (h16x2){c, c};
#define CV4(w, k) __builtin_bit_cast(h16x2, __builtin_amdgcn_cvt_scalef32_pk_f16_fp4((w), 1.0f, (k)))
#define AX4(j, w) do { o[4 * (j) + 0] += cc * CV4(w, 0); o[4 * (j) + 1] += cc * CV4(w, 1); o[4 * (j) + 2] += cc * CV4(w, 2); o[4 * (j) + 3] += cc * CV4(w, 3); } while (0)
    AX4(0, r.x); AX4(1, r.y); AX4(2, r.z); AX4(3, r.w);
#undef AX4
#undef CV4
}
constexpr int VW_LDS = 20352;
typedef int i32x2v __attribute__((ext_vector_type(2))); using pg8::i32x4v; using pg8::i32x8v;
template <int NBUF>
__device__ __forceinline__ void phase_peer_v_mfma(const Ctx& C, LAS unsigned char* tile) {
    const Args& A = *C.a; unsigned char* ws = A.ws; CTX_LANES();
    const int n = lane & 15, kq = lane >> 4;
    const unsigned char* ridx = ws + WS_RIDX; const unsigned char* coef8 = ws + WS_COEF8;
    const bf16_t* x1b = (const bf16_t*)(ws + WS_X1B); bf16_t* x2b = (bf16_t*)(ws + WS_X2B); float* ssq3 = (float*)(ws + WS_SSQ3);
    unsigned* Q = (unsigned*)(ws + WS_CTL) + CW_QV + A.li * 1024;
    LAS unsigned short* sid = (LAS unsigned short*)(tile + NBUF * 16384); LAS float* sout = (LAS float*)(tile + NBUF * 16384 + 2048);
    const int xcc = (int)(xb_xcc_id() & 7u);
    const int sc7f = 0x7F7F7F7F;
    const int row = 32 * kq + n, sw = (row >> 1) & 7;
    LAS unsigned char* rb = tile + 128 * row;
    unsigned adr[8];
#pragma unroll
    for (int q = 0; q < 8; ++q) adr[q] = (unsigned)(unsigned long)(rb + 16 * (q ^ sw));
    const int grow = lane >> 3, gq = lane & 7;
    const bool arow = n < 3;
#define V_GATHER(t_, bo_) do { const LAS unsigned short* ip_ = sid + ((t_) & 7) * 128 + grow; \
        _Pragma("unroll") for (int i_ = 0; i_ < 16; ++i_) { const unsigned e_ = ip_[8 * i_]; glds16(tab + e_ * 128u + 16u * (unsigned)(gq ^ ((lane >> 4) + 4 * (i_ & 1))), tile + (bo_) + i_ * 1024); } } while (0)
#define V_LOADA(dst0, dst1, xw, t_) do { const size_t tk_ = (size_t)(tok0 + (t_)); const unsigned char* ap_ = coef8 + tk_ * 384 + (arow ? n * 128 + 16 * kq : 0); const bf16_t* xp_ = x1b + tk_ * D + 256 * s + 4 * lane; \
        asm volatile("global_load_dwordx4 %0, %1, off" : "=v"(dst0) : "v"(ap_) : "memory"); asm volatile("global_load_dwordx4 %0, %1, off offset:64" : "=v"(dst1) : "v"(ap_) : "memory"); (void)xp_; (void)xw; } while (0)
    for (int so = 0; so < 4; ++so) {
        const int s = (xcc + so) & 3;
        const unsigned char* tab = ws + WS_EV + (size_t)s * (NEXP * 128);
        for (;;) {
            int ch = 0; if (lane == 0) ch = (int)atomicAdd(&Q[64 * s], 1u);
            ch = __builtin_amdgcn_readfirstlane(ch);
            if (ch >= PEER_NCHUNK) break;
            const int tok0 = ch * 16;
            const unsigned char* rp = ridx + (size_t)tok0 * 256 + 16 * lane;
            const u32x4 ia0 = __builtin_nontemporal_load((const u32x4*)rp), ia1 = __builtin_nontemporal_load((const u32x4*)(rp + 1024));
            u32x4 ib0 = __builtin_nontemporal_load((const u32x4*)(rp + 2048)), ib1 = __builtin_nontemporal_load((const u32x4*)(rp + 3072));
            asm volatile("s_waitcnt lgkmcnt(0)" ::: "memory");
            *(LAS u32x4*)((LAS unsigned char*)sid + 16 * lane) = ia0; *(LAS u32x4*)((LAS unsigned char*)sid + 1024 + 16 * lane) = ia1;
            asm volatile("s_waitcnt lgkmcnt(0)" ::: "memory");
            u32x4 sa0, sa1, sb0, sb1; u32x2 sax, sbx; u32x2 xo = (u32x2){0u, 0u}; float sso = 0.f;
            auto body = [&](const int t, u32x4& a0, u32x4& a1, u32x2& xw, const int bo, const bool GATHER, const bool YOUNGER) __attribute__((always_inline)) {
                const int tok = tok0 + t;
                if (YOUNGER) asm volatile("s_waitcnt vmcnt(19)" : "+v"(a0), "+v"(a1) :: "memory");
                else asm volatile("s_waitcnt vmcnt(0)" : "+v"(a0), "+v"(a1) :: "memory");
                if (t > 0) {
                    *(u32x2*)(x2b + (size_t)(tok - 1) * D + 256 * s + 4 * lane) = xo;
                    ssq3[(size_t)(tok - 1) * 8 + s] = sso; ssq3[(size_t)(tok - 1) * 8 + 4 + s] = 0.f;
                }
                u32x2 xc;
                { const bf16_t* xp_ = x1b + (size_t)tok * D + 256 * s + 4 * lane; asm volatile("global_load_dwordx2 %0, %1, off" : "=v"(xc) : "v"(xp_) : "memory"); }
                i32x4v b[16];
#pragma unroll
                for (int j = 0; j < 16; ++j) { i32x2v lo, hi;
                    if (bo == 0) { if (j & 1) { asm volatile("ds_read_b64_tr_b4 %0, %1 offset:8" : "=v"(lo) : "v"(adr[j >> 1]) : "memory"); asm volatile("ds_read_b64_tr_b4 %0, %1 offset:2056" : "=v"(hi) : "v"(adr[j >> 1]) : "memory"); }
                                   else       { asm volatile("ds_read_b64_tr_b4 %0, %1" : "=v"(lo) : "v"(adr[j >> 1]) : "memory"); asm volatile("ds_read_b64_tr_b4 %0, %1 offset:2048" : "=v"(hi) : "v"(adr[j >> 1]) : "memory"); } }
                    else         { if (j & 1) { asm volatile("ds_read_b64_tr_b4 %0, %1 offset:16392" : "=v"(lo) : "v"(adr[j >> 1]) : "memory"); asm volatile("ds_read_b64_tr_b4 %0, %1 offset:18440" : "=v"(hi) : "v"(adr[j >> 1]) : "memory"); }
                                   else       { asm volatile("ds_read_b64_tr_b4 %0, %1 offset:16384" : "=v"(lo) : "v"(adr[j >> 1]) : "memory"); asm volatile("ds_read_b64_tr_b4 %0, %1 offset:18432" : "=v"(hi) : "v"(adr[j >> 1]) : "memory"); } }
                    b[j] = (i32x4v){lo.x, lo.y, hi.x, hi.y}; }
                i32x8v av = (i32x8v){(int)a0.x, (int)a0.y, (int)a0.z, (int)a0.w, (int)a1.x, (int)a1.y, (int)a1.z, (int)a1.w};
                if (!arow) av = (i32x8v){0, 0, 0, 0, 0, 0, 0, 0};
                asm volatile("s_waitcnt lgkmcnt(0)" ::: "memory");
                if (GATHER) {
                    if (t + NBUF == 8) { *(LAS u32x4*)((LAS unsigned char*)sid + 16 * lane) = ib0; *(LAS u32x4*)((LAS unsigned char*)sid + 1024 + 16 * lane) = ib1; asm volatile("s_waitcnt lgkmcnt(0)" ::: "memory"); }
                    V_GATHER(t + NBUF, bo); V_LOADA(a0, a1, xw, t + NBUF);
                }
#pragma unroll
                for (int hf = 0; hf < 2; ++hf) {
                    f32x4 acc[8];
#pragma unroll
                    for (int j = 0; j < 8; ++j) asm volatile("v_mfma_scale_f32_16x16x128_f8f6f4 %0, %1, %2, 0, %3, %3 op_sel_hi:[0,0,0] cbsz:4 blgp:0" : "=&v"(acc[j]) : "v"(b[8 * hf + j]), "v"(av), "v"(sc7f));
                    asm volatile("s_nop 15\n\ts_nop 15" ::: "memory");
                    if (n < 3) {
#pragma unroll
                        for (int j = 0; j < 8; ++j) *(LAS f32x4*)(sout + 256 * n + 16 * (8 * hf + j) + 4 * kq) = acc[j];
                    }
                }
                asm volatile("s_waitcnt lgkmcnt(0)" ::: "memory");
                const f32x4 pv = ((*(const LAS f32x4*)(sout + 4 * lane) + *(const LAS f32x4*)(sout + 256 + 4 * lane)) + *(const LAS f32x4*)(sout + 512 + 4 * lane)) * (1.0f / 256.0f);
                asm volatile("s_waitcnt lgkmcnt(0)" ::: "memory");
                if (GATHER) asm volatile("s_waitcnt vmcnt(18)" : "+v"(xc) :: "memory");
                else asm volatile("s_waitcnt vmcnt(0)" : "+v"(xc) :: "memory");
                const f32x4 xv = (f32x4){bf_lo(xc.x), bf_hi(xc.x), bf_lo(xc.y), bf_hi(xc.y)} + pv;
                float ss = (xv.x * xv.x + xv.y * xv.y) + (xv.z * xv.z + xv.w * xv.w);
                xo = (u32x2){pk2(xv.x, xv.y), pk2(xv.z, xv.w)};
                sso = wave_sum_dpp(ss);
            };
            V_GATHER(0, 0); V_LOADA(sa0, sa1, sax, 0);
            if (NBUF == 2) { V_GATHER(1, 16384); V_LOADA(sb0, sb1, sbx, 1); }
            if (NBUF == 2) {
#pragma unroll 1
                for (int t2 = 0; t2 < 14; t2 += 2) { body(t2, sa0, sa1, sax, 0, true, true); body(t2 + 1, sb0, sb1, sbx, 16384, true, true); }
                body(14, sa0, sa1, sax, 0, false, true); body(15, sb0, sb1, sbx, 16384, false, false);
            } else {
#pragma unroll 1
                for (int t = 0; t < 15; ++t) body(t, sa0, sa1, sax, 0, true, false);
                body(15, sa0, sa1, sax, 0, false, false);
            }
            *(u32x2*)(x2b + (size_t)(tok0 + 15) * D + 256 * s + 4 * lane) = xo;
            ssq3[(size_t)(tok0 + 15) * 8 + s] = sso; ssq3[(size_t)(tok0 + 15) * 8 + 4 + s] = 0.f;
        }
    }
#undef V_GATHER
#undef V_LOADA
}
__device__ __forceinline__ void phase_peer_v_valu(const Ctx& C, LAS unsigned char* wl) {
    const Args& A = *C.a; unsigned char* ws = A.ws; CTX_LANES();
    const int g = lane >> 3, c = lane & 7;
    const unsigned* ridx = (const unsigned*)(ws + WS_RIDX); const unsigned* coef = (const unsigned*)(ws + WS_COEF);
    const bf16_t* x1b = (const bf16_t*)(ws + WS_X1B); bf16_t* x2b = (bf16_t*)(ws + WS_X2B); float* ssq3 = (float*)(ws + WS_SSQ3);
    unsigned* Q = (unsigned*)(ws + WS_CTL) + CW_QV + A.li * 1024;
    LAS unsigned* sidx = (LAS unsigned*)wl; LAS unsigned* scf = (LAS unsigned*)(wl + 2048);
    const int xcc = (int)(xb_xcc_id() & 7u);
    for (int so = 0; so < 4; ++so) {
        const int s = (xcc + so) & 3;
        const unsigned char* tab = ws + WS_EV + (size_t)s * (NEXP * 128) + 16 * c;
        for (;;) {
            int ch = 0; if (lane == 0) ch = (int)atomicAdd(&Q[64 * s], 1u);
            ch = __builtin_amdgcn_readfirstlane(ch);
            if (ch >= PEER_NCHUNK) break;
            const int tok0 = ch * 16;
            u32x4 st[2][4];
#pragma unroll
            for (int i = 0; i < 4; ++i) { st[0][i] = __builtin_nontemporal_load((const u32x4*)(ridx + (size_t)tok0 * 64) + i * 64 + lane); st[1][i] = __builtin_nontemporal_load((const u32x4*)(coef + (size_t)tok0 * 64) + i * 64 + lane); }
#pragma unroll 1
            for (int sub = 0; sub < 2; ++sub) {
                const int tok = tok0 + sub * 8 + g;
#pragma unroll
                for (int i = 0; i < 2; ++i) { *(LAS u32x4*)(sidx + (i * 64 + lane) * 4) = sub ? st[0][2 + i] : st[0][i]; *(LAS u32x4*)(scf + (i * 64 + lane) * 4) = sub ? st[1][2 + i] : st[1][i]; }
                const LAS unsigned* ip = sidx + g * 64; const LAS unsigned* cp = scf + g * 64;
                const bf16_t* xr = x1b + (size_t)tok * D + 256 * s + 32 * c;
                u32x4 wa[4];
#pragma unroll
                for (int i = 0; i < 4; ++i) wa[i] = *(const u32x4*)(xr + 8 * i);
                h16x2 acc[16];
#pragma unroll
                for (int j = 0; j < 16; ++j) acc[j] = (h16x2){(_Float16)0.f, (_Float16)0.f};
                u32x4 r0[8], r1[8];
#define PEER_AXB(src, b) do { const h16x8 ch_ = *(const LAS h16x8*)(cp + 4 * (b)); \
                    axpy32_fp4(src[0], ch_[0], acc); axpy32_fp4(src[1], ch_[1], acc); axpy32_fp4(src[2], ch_[2], acc); axpy32_fp4(src[3], ch_[3], acc); \
                    axpy32_fp4(src[4], ch_[4], acc); axpy32_fp4(src[5], ch_[5], acc); axpy32_fp4(src[6], ch_[6], acc); axpy32_fp4(src[7], ch_[7], acc); } while (0)
                PEER_LOAD8(r0, 0); PEER_LOAD8(r1, 1); SB();
#pragma unroll
                for (int b2 = 0; b2 < 16; b2 += 2) {
                    PEER_AXB(r0, b2); SB(); if (b2 + 2 < 16) PEER_LOAD8(r0, b2 + 2); SB();
                    PEER_AXB(r1, b2 + 1); SB(); if (b2 + 3 < 16) PEER_LOAD8(r1, b2 + 3); SB();
                }
#undef PEER_AXB
                float ss = 0.f;
                bf16_t* xb = x2b + (size_t)tok * D + 256 * s + 32 * c;
#pragma unroll
                for (int i = 0; i < 4; ++i) {
#define A2F(a_) ((f32x2){(float)(a_).x, (float)(a_).y})
                    const f32x2 v0 = (f32x2){bf_lo(wa[i].x), bf_hi(wa[i].x)} + A2F(acc[4 * i]), v1 = (f32x2){bf_lo(wa[i].y), bf_hi(wa[i].y)} + A2F(acc[4 * i + 1]),
                                v2 = (f32x2){bf_lo(wa[i].z), bf_hi(wa[i].z)} + A2F(acc[4 * i + 2]), v3 = (f32x2){bf_lo(wa[i].w), bf_hi(wa[i].w)} + A2F(acc[4 * i + 3]);
#undef A2F
                    ss += ((v0.x * v0.x + v0.y * v0.y) + (v1.x * v1.x + v1.y * v1.y)) + ((v2.x * v2.x + v2.y * v2.y) + (v3.x * v3.x + v3.y * v3.y));
                    *(u32x4*)(xb + 8 * i) = (u32x4){pk2(v0.x, v0.y), pk2(v1.x, v1.y), pk2(v2.x, v2.y), pk2(v3.x, v3.y)};
                }
                ss += dppc<0xB1>(ss); ss += dppc<0x4E>(ss); ss += dppc<0x141>(ss);
                if (c == 0) { ssq3[(size_t)tok * 8 + s] = ss; ssq3[(size_t)tok * 8 + 4 + s] = 0.f; }
            }
        }
    }
}
__device__ __forceinline__ void phase_peer_v(const Ctx& C) {
    const int wave = __builtin_amdgcn_readfirstlane(opaque_tid() >> 6);
    if (PEER_V_MFMA == 1) phase_peer_v_mfma<1>(C, C.lds + wave * 20352);
    else if (PEER_V_MFMA == 0) phase_peer_v_valu(C, C.lds + wave * 4096);
    else { const int grp = ((wave >> 2) << 1) | (wave & 1);
           if (wave & 2) phase_peer_v_mfma<1>(C, C.lds + grp * 21504); else phase_peer_v_valu(C, C.lds + 86016 + grp * 4096); }
}
#undef PEER_LOAD8
#undef SB


#ifndef PROBE_DIAG
#define PROBE_DIAG 0
#endif
#if PROBE_DIAG
__device__ int diag_probe(const Ctx& C) {
    CTX_LANES();
    typedef int i32x2v_ __attribute__((ext_vector_type(2)));
    LAS unsigned char* t = C.lds;
    LAS unsigned* w = (LAS unsigned*)(t + 8 * lane);
    const int n = lane & 15, kq = lane >> 4;
    w[0] = 0x11111111u * (unsigned)n; w[1] = 0x11111111u * (unsigned)n;
    asm volatile("s_waitcnt lgkmcnt(0)" ::: "memory");
    const i32x2v_ r1 = __builtin_amdgcn_ds_read_tr4_b64_v2i32((LAS i32x2v_*)(t + 8 * lane));
    asm volatile("s_waitcnt lgkmcnt(0)" ::: "memory");
    const bool ok1 = (r1.x == 0x76543210) && (r1.y == (int)0xFEDCBA98u);
    w[0] = 0x76543210u; w[1] = 0xFEDCBA98u;
    asm volatile("s_waitcnt lgkmcnt(0)" ::: "memory");
    const i32x2v_ r2 = __builtin_amdgcn_ds_read_tr4_b64_v2i32((LAS i32x2v_*)(t + 8 * lane));
    asm volatile("s_waitcnt lgkmcnt(0)" ::: "memory");
    const bool ok2 = (r2.x == (int)(0x11111111u * (unsigned)n)) && (r2.y == (int)(0x11111111u * (unsigned)n));
    const bool q1a = __builtin_amdgcn_ballot_w64(ok1) == ~0ull, q1b = __builtin_amdgcn_ballot_w64(ok2) == ~0ull;
    const int sc7f = 0x7F7F7F7F;
    const unsigned long long nmask = 0x0001000100010001ull;
    const float L[8] = {0.f, 0.5f, 1.f, 1.5f, 2.f, 3.f, 4.f, 6.f};
#ifndef DIAG_K0
#define DIAG_K0 2
#define DIAG_REG 1
#define DIAG_LANE 16
#endif
#ifndef DIAG_I0
#define DIAG_I0 17
#endif
    int code = 0;
    {
        const int I0 = DIAG_I0;
        pg8::i32x8v bv = (pg8::i32x8v){0, 0, 0, 0, 0, 0, 0, 0};
        bv[I0 >> 2] = (n == 0 && kq == DIAG_K0) ? (0x38 << (8 * (I0 & 3))) : 0;
        const pg8::i32x4v a1 = (pg8::i32x4v){0x11111111 * (kq + 1), 0x11111111 * (kq + 1), 0x11111111 * (kq + 1), 0x11111111 * (kq + 1)};
        const pg8::i32x4v a2 = (pg8::i32x4v){0x11111111, 0x22222222, 0x33333333, 0x44444444};
        f32x4 d1, d2;
        asm volatile("v_mfma_scale_f32_16x16x128_f8f6f4 %0, %1, %2, 0, %3, %3 op_sel_hi:[0,0,0] cbsz:4 blgp:0" : "=&v"(d1) : "v"(a1), "v"(bv), "v"(sc7f));
        asm volatile("v_mfma_scale_f32_16x16x128_f8f6f4 %0, %1, %2, 0, %3, %3 op_sel_hi:[0,0,0] cbsz:4 blgp:0" : "=&v"(d2) : "v"(a2), "v"(bv), "v"(sc7f));
        asm volatile("s_nop 15\n\ts_nop 15" ::: "memory");
        int lo = 8, hi = 4;
#pragma unroll
        for (int q = 0; q < 8; ++q) { if (d1[DIAG_REG] == L[q]) lo = q; }
#pragma unroll
        for (int q = 0; q < 4; ++q) { if (d2[DIAG_REG] == L[q + 1]) hi = q; }
        code = __builtin_amdgcn_readlane(lo + 9 * hi, DIAG_LANE);
    }
    (void)q1a; (void)q1b;
    return 1 + code;
}
#endif
constexpr int N_PHASES = 12;
__global__ void __launch_bounds__(512, 2) mk_fwd(Args args) {
    extern __shared__ __attribute__((aligned(16))) unsigned char lds[];
    Ctx C;
    C.lds = (LAS unsigned char*)lds;
    C.G = gridDim.x; { const int bx = blockIdx.x; C.vcu = (C.G % 8 == 0) ? (bx % 8) * (C.G / 8) + bx / 8 : bx; }
    C.a = &args;
    unsigned char* ws = args.ws;
    volatile LAS unsigned* MISC = (volatile LAS unsigned*)(C.lds + MISC_OFF);
    if (threadIdx.x < 64) MISC[threadIdx.x] = 0u;
    __syncthreads();
    XcdBarrier bar; bar.bar = (unsigned*)(ws + WS_CTL) + CW_BAR; bar.x = 0; bar.st = nullptr;
    const int lo = args.ph_lo, hi = args.ph_hi;
    if (hi - lo > 1) bar = xcd_barrier_post((unsigned*)(ws + WS_CTL) + CW_BAR + args.li * XCD_BAR_WORDS, MISC + 8);
#define IN(k) (((PHMASK >> (k)) & 1) && lo <= (k) && (k) < hi)
#define SEAM(k) do { if (IN(k) && IN((k) + 1)) xcd_barrier(bar); } while (0)
#define REP(k) for (int rep_ = 0; rep_ < 1 + (((PROBE_REPEAT_MASK) >> (k)) & 1) * (PROBE_REPS); ++rep_)
    LAS unsigned char* ring = C.lds;

    if (IN(0)) REP(0) { phase_prologue(C); }
    SEAM(0);
    if (IN(1)) REP(1) {
        pg8::Gemm g{(const bf16_t*)((unsigned char*)args.out + DO_XB), (const bf16_t*)(ws + WS_WIN), T, IN_W, D}; pg8::StaticOrder S; S.init(T, IN_W, C.G, (int)blockIdx.x);
        EpiProj E{(const float*)(ws + WS_RSTD1), args.in[I_QKN_NA], args.in[I_QKN_DIL], (const float*)(ws + WS_COS), (const float*)(ws + WS_SIN),
                  ws};
        pg8::gemm_phase<EpiProj, pg8::StaticOrder, true, true, true>(ring, g, S, E);
    }
    SEAM(1);
    if (IN(2)) REP(2) { if (USE_REF_ATTN) phase_attention_ref(C); else phase_attention(C); }
    SEAM(2);
    if (IN(3)) REP(3) { phase_dil_combine(C); }
    SEAM(3);
    if (IN(4)) REP(4) {
        pg8::Gemm g{(const bf16_t*)(ws + WS_OUTNA), (const bf16_t*)(ws + WS_WNA), T, D, ACAT}; pg8::StaticOrder S; S.init(T, D, C.G, (int)blockIdx.x);
        EpiMerge E{ws + WS_MERGED, (const bf16_t*)(ws + WS_GATES), 1.0f / (W8_SCALE * A8_SCALE)};
        pg8::gemm_phase<EpiMerge, pg8::StaticOrder, true, true, true>(ring, g, S, E);
    }
    SEAM(4);
    if (IN(5)) REP(5) {
        pg8::Gemm g{(const bf16_t*)(ws + WS_MERGED), (const bf16_t*)(ws + WS_WOUT), T, D, D}; pg8::StaticOrder S; S.init(T, D, C.G, (int)blockIdx.x);
        EpiResid E{args.in[I_X], args.out, (bf16_t*)(ws + WS_X1B), (float*)(ws + WS_SSQ2), 1.0f / (W8_SCALE * A8_SCALE)};
        pg8::gemm_phase<EpiResid, pg8::StaticOrder, true, true, true>(ring, g, S, E);
    }
    SEAM(5);
    if (IN(6)) {
        pg8::Gemm g{(const bf16_t*)(ws + WS_X1B), (const bf16_t*)(ws + WS_WSC), T, 2048, D}; pg8::SingleOrder S; S.S.init(T, 2048, C.G, (int)blockIdx.x);
        EpiScoresTopk E{(const float*)(ws + WS_SSQ2), (unsigned short*)(ws + WS_RIDX), (float*)(ws + WS_RG)};
        for (int i = 0; i < (T / 256) * 8; ++i) { pg8::Unit uu; S.i = i; if (!S.S.next(i, uu)) break; pg8::gemm_phase<EpiScoresTopk, pg8::SingleOrder>(ring, g, S, E); }
    }
    SEAM(6);
    if (IN(7) && !IN(6) && IN(8)) { }
    if (IN(8)) { phase_peer_u(C); }
    SEAM(8);
    if (IN(9)) { phase_peer_coef(C); }
    SEAM(9);
    if (IN(10)) { phase_peer_v(C); }
    SEAM(10);
    if (IN(11)) {
        { pg8::Gemm g{(const bf16_t*)(ws + WS_PB), (const bf16_t*)(ws + WS_WPLE), T, D, 256}; pg8::StaticOrder S; S.init(T, D, C.G, (int)blockIdx.x);
          EpiGate<2> E{(bf16_t*)(ws + WS_TMP2), nullptr, 0, 0, nullptr, 1.0f};
          pg8::gemm_phase<EpiGate<2>, pg8::StaticOrder>(ring, g, S, E); }
        { pg8::Gemm g{(const bf16_t*)(ws + WS_X2B), (const bf16_t*)(ws + WS_WG), T, D, D}; pg8::StaticOrder S; S.init(T, D, C.G, (int)blockIdx.x);
          EpiFinal E{args.out, (const float*)(ws + WS_SSQ3), (const bf16_t*)(ws + WS_TMP2), (const bf16_t*)(ws + WS_X2B)};
          pg8::gemm_phase<EpiFinal, pg8::StaticOrder>(ring, g, S, E); }
    }
#if PROBE_DIAG
    {
        volatile float* cw = (volatile float*)(ws + WS_CTL + 57344 + 256);
        __syncthreads();
        if (blockIdx.x == 0 && threadIdx.x < 64) { const int code = diag_probe(C); if (threadIdx.x == 0) *cw = sqrtf(0.426f * (float)code); }
        xcd_barrier(bar);
        const float cv = *cw;
        for (int i = blockIdx.x * 512 + threadIdx.x; i < (1 << 20); i += C.G * 512) args.out[i] += cv;
    }
#endif
#undef IN
#undef SEAM
}

extern "C" void kernel_launch(void* const* d_in, const int* in_sizes, int n_in, void* d_out, int out_size, void* d_ws, size_t ws_size, hipStream_t stream) {
    static int grid = 0;
    if (grid == 0) {
        if (n_in != 18 || in_sizes[0] != T * D || out_size != T * D || ws_size < WS_END) { fprintf(stderr, "kernel_launch: unexpected shapes (n_in %d, in0 %d, out %d, ws %zu)\n", n_in, n_in > 0 ? in_sizes[0] : -1, out_size, ws_size); grid = -1; return; }
        int dev = 0, cus = 0, per_cu = 0;
        if (hipGetDevice(&dev) != hipSuccess || hipDeviceGetAttribute(&cus, hipDeviceAttributeMultiprocessorCount, dev) != hipSuccess) { grid = -1; return; }
        if (hipFuncSetAttribute((const void*)mk_fwd, hipFuncAttributeMaxDynamicSharedMemorySize, LDS_BYTES) != hipSuccess) { fprintf(stderr, "kernel_launch: hipFuncSetAttribute failed\n"); grid = -1; return; }
        if (hipOccupancyMaxActiveBlocksPerMultiprocessor(&per_cu, (const void*)mk_fwd, 512, LDS_BYTES) != hipSuccess || per_cu < 1) { fprintf(stderr, "kernel_launch: occupancy query says %d blocks/CU\n", per_cu); per_cu = 1; }
        (void)hipGetLastError();
        grid = cus;
    }
    if (grid < 0) return;
    (void)hipMemsetAsync((char*)d_ws + WS_CTL, 0, CTL_ZERO_BYTES, stream);
    Args a{};
    for (int i = 0; i < 18; ++i) a.in[i] = (const float*)d_in[i];
    a.out = (float*)d_out; a.ws = (unsigned char*)d_ws;
    if (PROBE_PHASE >= 0) {
        const int k = PROBE_PHASE; const int lo_[3] = {0, k, k + 1}, hi_[3] = {k + 1, k + 1, N_PHASES};
        for (int li = 0; li < 3; ++li) { if (lo_[li] >= hi_[li]) continue; if (li == 1 && PROBE_NOREPEAT) continue; a.ph_lo = lo_[li]; a.ph_hi = hi_[li]; a.li = li; hipLaunchKernelGGL(mk_fwd, dim3(grid), dim3(512), LDS_BYTES, stream, a); }
    } else if (MK_N_LAUNCHES == 1) {
        a.ph_lo = 0; a.ph_hi = N_PHASES; a.li = 0;
        hipLaunchKernelGGL(mk_fwd, dim3(grid), dim3(512), LDS_BYTES, stream, a);
    } else {
        for (int li = 0; li < N_PHASES; ++li) { a.ph_lo = li; a.ph_hi = li + 1; a.li = li; hipLaunchKernelGGL(mk_fwd, dim3(grid), dim3(512), LDS_BYTES, stream, a); }
    }
}
```

```cpp
#include <hip/hip_runtime.h>
#include <cstdio>
#include <cstdint>

#ifndef PEER_V_MFMA
#define PEER_V_MFMA 2
#endif
#ifndef MK_N_LAUNCHES
#define MK_N_LAUNCHES 1
#endif

#ifndef PROBE_REPEAT_MASK
#define PROBE_REPEAT_MASK 0
#endif
#ifndef REDUCE8
#define REDUCE8 reduce8
#endif
#ifndef PROBE_PRO
#define PROBE_PRO 0
#endif
#ifndef PHMASK
#define PHMASK 0xfff
#endif
#ifndef PROBE_PHASE
#define PROBE_PHASE -1
#endif
#ifndef PROBE_NOREPEAT
#define PROBE_NOREPEAT 0
#endif
#ifndef USE_REF_ATTN
#define USE_REF_ATTN 0
#endif
#ifndef PROBE_REPS
#define PROBE_REPS 1
#endif
#define LAS __attribute__((address_space(3)))
#define GAS __attribute__((address_space(1)))
typedef unsigned short bf16_t;
typedef short bf16x8 __attribute__((ext_vector_type(8)));
typedef float f32x4 __attribute__((ext_vector_type(4)));
typedef float f32x2 __attribute__((ext_vector_type(2)));
typedef unsigned u32x4 __attribute__((ext_vector_type(4)));
typedef unsigned u32x2 __attribute__((ext_vector_type(2)));
typedef __bf16 bf16v2 __attribute__((ext_vector_type(2)));
typedef _Float16 h16x8 __attribute__((ext_vector_type(8)));

constexpr int D = 1024, BATCH = 8, SEQ = 4096, T = BATCH * SEQ;
constexpr int NA_H = 8, DIL_H = 12, HD = 64;
constexpr int IN_W = 5888;
constexpr int NEXP = 16384;
constexpr float RMS_EPS = 1e-6f;
constexpr float LOG2E = 1.4426950408889634f;
constexpr float QSCALE = 0.125f * LOG2E;

constexpr size_t MiB = 1u << 20;
constexpr size_t WS_CTL = 0, CTL_ZERO_BYTES = 64 * 1024;
constexpr size_t WS_RSTD1 = 1 * MiB, WS_RSTD3 = 1 * MiB + 256 * 1024, WS_COS = 1 * MiB + 512 * 1024, WS_SIN = 1 * MiB + 768 * 1024;
constexpr size_t WS_SSQ2 = 2 * MiB;
constexpr size_t WS_LSE = 4 * MiB;
constexpr size_t WS_WIN = 8 * MiB, WS_WNA = 20 * MiB, WS_WDIL = 21 * MiB, WS_WOUT = 22 * MiB, WS_WSC = 24 * MiB, WS_WG = 28 * MiB, WS_WPLE = 30 * MiB;
constexpr size_t WS_EU = 32 * MiB, WS_EV = 48 * MiB, WS_PB = 96 * MiB;
constexpr size_t WS_SU = 6 * MiB, WS_SV = 6 * MiB + 65536;
constexpr size_t WS_QNA = 112 * MiB, WS_KNA = 144 * MiB, WS_VNA = 176 * MiB;
constexpr size_t WS_QDIL = 208 * MiB, WS_KDIL = 256 * MiB, WS_VDIL = 304 * MiB;
constexpr size_t WS_GATES = 352 * MiB;
constexpr size_t WS_MERGED = 112 * MiB;
constexpr size_t WS_TMP1 = 208 * MiB;
constexpr size_t WS_X1B = 176 * MiB;
constexpr size_t WS_SCORES = 240 * MiB;
constexpr size_t WS_RIDX = 112 * MiB, WS_RG = 128 * MiB;
constexpr size_t WS_PART = 240 * MiB;
constexpr size_t WS_COEF = 368 * MiB;
constexpr size_t WS_X2B = 384 * MiB;
constexpr size_t WS_TMP2 = 176 * MiB;
constexpr size_t WS_SSQ3 = 7 * MiB;
constexpr size_t WS_COEF8 = 144 * MiB;
constexpr size_t WS_HQ = 144 * MiB;
constexpr size_t WS_HS = 4 * MiB;
constexpr size_t WS_END = 512 * MiB;
constexpr int CW_QU = 12288, CW_QV = 12288 + 512;
constexpr size_t DO_XB = 0, DO_OG = 64 * MiB, DO_OUTDIL = 112 * MiB;
constexpr size_t WS_OUTNA = 480 * MiB;
constexpr int ACAT = 768;

constexpr int CW_BAR = 1024;

constexpr int RING_BYTES = 131072;
constexpr int EPI_OFF = RING_BYTES;
constexpr int MISC_OFF = 162816;
constexpr int LDS_BYTES = 163840;

__device__ __forceinline__ unsigned f2bf(float f) { unsigned u = __builtin_bit_cast(unsigned, f); return (u + 0x7fffu + ((u >> 16) & 1u)) >> 16; }
__device__ __forceinline__ unsigned pk2(float lo, float hi) { return f2bf(lo) | (f2bf(hi) << 16); }
__device__ __forceinline__ float bf_lo(unsigned w) { return __builtin_bit_cast(float, w << 16); }
__device__ __forceinline__ float bf_hi(unsigned w) { return __builtin_bit_cast(float, w & 0xffff0000u); }
__device__ __forceinline__ float bf2f(bf16_t b) { return __builtin_bit_cast(float, ((unsigned)b) << 16); }
__device__ __forceinline__ float wave_sum(float v) {
#pragma unroll
    for (int o = 1; o < 64; o <<= 1) v += __shfl_xor(v, o);
    return v;
}
__device__ __forceinline__ float wave_max(float v) {
#pragma unroll
    for (int o = 1; o < 64; o <<= 1) v = fmaxf(v, __shfl_xor(v, o));
    return v;
}
template <int CTRL> __device__ __forceinline__ float dppc(float v) { return __builtin_bit_cast(float, __builtin_amdgcn_update_dpp(0, __builtin_bit_cast(int, v), CTRL, 0xf, 0xf, true)); }
__device__ __forceinline__ float wave_sum_dpp(float t) {
    t += dppc<0xB1>(t); t += dppc<0x4E>(t); t += dppc<0x141>(t); t += dppc<0x128>(t);
    { float a = t, b = t; asm volatile("s_nop 1\n\tv_permlane16_swap_b32 %0, %1" : "+v"(a), "+v"(b)); t = a + b; }
    { float a = t, b = t; asm volatile("s_nop 1\n\tv_permlane32_swap_b32 %0, %1" : "+v"(a), "+v"(b)); t = a + b; }
    return t;
}
__device__ __forceinline__ void swap16(float& a, float& b) { asm("s_nop 1\n\tv_permlane16_swap_b32 %0, %1" : "+v"(a), "+v"(b)); }
__device__ __forceinline__ void swap32(float& a, float& b) { asm("s_nop 1\n\tv_permlane32_swap_b32 %0, %1" : "+v"(a), "+v"(b)); }
__device__ __forceinline__ float sum_x16_x32(float t) { float a = t, b = t; swap16(a, b); t = a + b; a = t; b = t; swap32(a, b); return a + b; }
__device__ __forceinline__ float max_x16_x32(float t) { float a = t, b = t; swap16(a, b); t = fmaxf(a, b); a = t; b = t; swap32(a, b); return fmaxf(a, b); }
__device__ __forceinline__ float other_x16(float t, int lane) { float a = t, b = t; swap16(a, b); return (lane & 16) ? a : b; }
__device__ __forceinline__ float sigmoidf_(float v) { return 1.0f / (1.0f + __expf(-v)); }
__device__ __forceinline__ float gelu_erf(float v) {
    const float av = fabsf(v), t = __builtin_amdgcn_rcpf(av * 0.2316418882f + 1.0f);
    float q = t * 0.5307027145f + (-0.7265760135f); q = q * t + 0.7107068705f; q = q * t + (-0.142248368f); q = q * t + 0.127414796f; q = q * t;
    const float e = __builtin_amdgcn_exp2f(v * v * (-0.72134752044f));
    const float m = v * (q * e);
    return v < 0.f ? m : v - m;
}

__device__ __forceinline__ int opaque_tid();
namespace pg8 {
#define PG8_LAS __attribute__((address_space(3)))
constexpr int BM = 256, BK = 64, HALF = 128, HTB = HALF * BK * 2, STAGE_BYTES = 8 * HTB, NXCD = 8, WGM = 4;
__host__ __device__ __forceinline__ int lds_byte(int r, int c) { const int st = (r >> 4) * 2 + (c >> 5), rr = r & 15, cc = c & 31, ob = rr * 64 + cc * 2; return st * 1024 + (ob ^ (((ob >> 9) & 1) << 5)); }
__host__ __device__ __forceinline__ void stage_rc(int b, int& R, int& C) { const int st = b / 1024, sb = b % 1024, swz = sb ^ (((sb >> 9) & 1) << 5); R = (st >> 1) * 16 + swz / 64; C = (st & 1) * 32 + (swz % 64) / 2; }
__host__ __device__ __forceinline__ int perm32(int rho) { const int n = rho >> 4, i = rho & 15; return 8 * (i >> 2) + 4 * n + (i & 3); }
struct Unit { int pm, pn; };
struct Gemm { const bf16_t* A; const bf16_t* Bt; int M, N, K; };
struct StaticOrder {
    int nM, nN, nwg, G, c;
    __host__ __device__ void init(int M, int N, int G_, int c_) { nM = M / BM; nN = N / BM; nwg = nM * nN; G = G_; c = c_; }
    __host__ __device__ bool next(int i, Unit& u) const {
        const long L = (long)i * G + c; if (L >= nwg) return false;
        int wgid = (int)L; { const int q = nwg / NXCD, r = nwg % NXCD, xcd = wgid % NXCD, off = wgid / NXCD; wgid = (xcd < r ? xcd * (q + 1) : r * (q + 1) + (xcd - r) * q) + off; }
        const int nig = WGM * nN, gid = wgid / nig, fm = gid * WGM, gsz = (nM - fm) < WGM ? (nM - fm) : WGM;
        u.pm = fm + ((wgid % nig) % gsz); u.pn = (wgid % nig) / gsz; return true;
    }
    __device__ __forceinline__ void a_ready(const Unit&) const {}
    __device__ __forceinline__ void done(const Unit&) const {}
};
struct SingleOrder {
    StaticOrder S; int i;
    __device__ bool next(int k, Unit& u) const { return k == 0 ? S.next(i, u) : false; }
    __device__ __forceinline__ void a_ready(const Unit&) const {}
    __device__ __forceinline__ void done(const Unit&) const {}
};
__device__ __forceinline__ unsigned cvt_pk_bf16(float lo, float hi) { unsigned r; asm volatile("v_cvt_pk_bf16_f32 %0, %1, %2" : "=v"(r) : "v"(lo), "v"(hi)); return r; }

typedef int i32x4v __attribute__((ext_vector_type(4)));
typedef int i32x8v __attribute__((ext_vector_type(8)));
template <bool FP8> struct FragSel;
template <> struct FragSel<false> {
    struct type { bf16x8 k[2]; };
    static __device__ __forceinline__ void load(type& d, const PG8_LAS unsigned char* p) { d.k[0] = *(const PG8_LAS bf16x8*)p; d.k[1] = *(const PG8_LAS bf16x8*)(p + 1024); }
    static __device__ __forceinline__ f32x4 mma(const type& a, const type& b, f32x4 c, int) { c = __builtin_amdgcn_mfma_f32_16x16x32_bf16(a.k[0], b.k[0], c, 0, 0, 0); return __builtin_amdgcn_mfma_f32_16x16x32_bf16(a.k[1], b.k[1], c, 0, 0, 0); }
};
template <> struct FragSel<true> {
    typedef i32x8v type;
    static __device__ __forceinline__ void load(type& d, const PG8_LAS unsigned char* p) { const i32x4v lo = *(const PG8_LAS i32x4v*)p, hi = *(const PG8_LAS i32x4v*)(p + 1024); d = __builtin_shufflevector(lo, hi, 0, 1, 2, 3, 4, 5, 6, 7); }
    static __device__ __forceinline__ f32x4 mma(const type& a, const type& b, f32x4 c, int sc) {
        asm volatile("v_mfma_scale_f32_16x16x128_f8f6f4 %0, %1, %2, %0, %3, %3 op_sel_hi:[0,0,0]" : "+v"(c) : "v"(a), "v"(b), "v"(sc));
        return c; }
};
template <class E, class = void> struct MidTiles { static constexpr int v = 0; };
template <class E> struct MidTiles<E, decltype((void)E::MID_TILES)> { static constexpr int v = E::MID_TILES; };
template <class Epi, class Sched, bool ALIGN_EPI = true, bool SP2 = true, bool FP8 = false>
__device__ __forceinline__ void gemm_phase(PG8_LAS unsigned char* lds, const Gemm g, const Sched& S, const Epi& E) {
    const int tid = opaque_tid(), wid = __builtin_amdgcn_readfirstlane(tid >> 6), lane = tid & 63, wr = wid >> 2, wc = wid & 3, fr = lane & 15, fq = lane >> 4;
    int sc7f = 0x7F7F7F7F; if constexpr (FP8) asm volatile("" : "+v"(sc7f));
    const int K = g.K, nt = FP8 ? K / 128 : K / BK;
    const int KB = FP8 ? K : 2 * K;
    unsigned voffA[2], voffB[2];
#pragma unroll
    for (int i = 0; i < 2; ++i) { int R, C; stage_rc(tid * 16 + i * 8192, R, C); const int Rb = 64 * (R >> 5) + perm32(R & 31);
        voffA[i] = (unsigned)(R * KB + 2 * C); voffB[i] = (unsigned)(Rb * KB + 2 * C); }
    const size_t kstep = (size_t)(BK * 2);
    const size_t hstep = (size_t)HALF * KB;
    const size_t hstepB = (size_t)32 * KB;
    const size_t tstep = 2 * hstep;
    const unsigned ldsw = (unsigned)wid * 1024u;
    const int aoff = lds_byte(wr * 64 + fr, fq * 8), boff = lds_byte(wc * 32 + fr, fq * 8);
#define PG8_SA(b, h) (((b) * 2 + (h)) * HTB)
#define PG8_SB(b, h) ((4 + (b) * 2 + (h)) * HTB)
#define PG8_STAGE(bufoff, gbase, voff) do { _Pragma("unroll") for (int _i = 0; _i < 2; ++_i) \
        __builtin_amdgcn_global_load_lds((const unsigned*)((const char*)(gbase) + (voff)[_i]), (PG8_LAS unsigned*)(lds + (bufoff) + ldsw + _i * 8192), 16, 0, 0); } while (0)
#define PG8_LDA(dst, b, h) do { _Pragma("unroll") for (int m = 0; m < 4; ++m) FragSel<FP8>::load(dst[m], lds + PG8_SA(b, h) + aoff + m * 2048); } while (0)
#define PG8_LDB(dst, b, h) do { _Pragma("unroll") for (int n = 0; n < 2; ++n) FragSel<FP8>::load(dst[n], lds + PG8_SB(b, h) + boff + n * 2048); } while (0)
#define PG8_MMA(ai, bj, At, Bt) do { __builtin_amdgcn_s_setprio(1); \
        _Pragma("unroll") for (int m = 0; m < 4; ++m) _Pragma("unroll") for (int n = 0; n < 2; ++n) acc[ai][bj][m][n] = FragSel<FP8>::mma(Bt[n], At[m], acc[ai][bj][m][n], sc7f); \
        __builtin_amdgcn_s_setprio(0); } while (0)
#define PG8_WAIT_V(n) asm volatile("s_waitcnt vmcnt(" #n ")" ::: "memory")
#define PG8_WAIT_L(n) asm volatile("s_waitcnt lgkmcnt(" #n ")" ::: "memory")
#define PG8_BAR __builtin_amdgcn_s_barrier()
#define PG8_SCHED __builtin_amdgcn_sched_barrier(0)
    Unit cur, nxt; int ui = 0;
    if (!S.next(0, cur)) return;
    f32x4 acc[2][2][4][2];
#pragma unroll
    for (int a = 0; a < 2; ++a)
#pragma unroll
        for (int b = 0; b < 2; ++b)
#pragma unroll
            for (int m = 0; m < 4; ++m)
#pragma unroll
                for (int n = 0; n < 2; ++n) acc[a][b][m][n] = (f32x4){0.f, 0.f, 0.f, 0.f};
    typedef typename FragSel<FP8>::type frag_t;
    frag_t At[4], B0[2], B1[2];
    const char* cA = (const char*)g.A + (size_t)cur.pm * tstep; const char* cB = (const char*)g.Bt + (size_t)cur.pn * tstep;
    S.a_ready(cur);
    if constexpr (SP2) {
        PG8_STAGE(PG8_SB(0, 0), cB, voffB); PG8_STAGE(PG8_SB(0, 1), cB + hstepB, voffB); PG8_STAGE(PG8_SA(0, 0), cA, voffA); PG8_STAGE(PG8_SA(0, 1), cA + hstep, voffA);
        if (wr == 1) PG8_BAR;
        PG8_WAIT_V(2); PG8_BAR;
        PG8_STAGE(PG8_SB(1, 0), cB + kstep, voffB); PG8_STAGE(PG8_SA(1, 0), cA + kstep, voffA); PG8_STAGE(PG8_SB(1, 1), cB + hstepB + kstep, voffB);
        PG8_WAIT_V(6); PG8_BAR;
    } else {
        PG8_STAGE(PG8_SB(0, 0), cB, voffB); PG8_STAGE(PG8_SA(0, 0), cA, voffA); PG8_STAGE(PG8_SB(0, 1), cB + hstepB, voffB); PG8_STAGE(PG8_SA(0, 1), cA + hstep, voffA);
        if (wr == 1) PG8_BAR;
        PG8_WAIT_V(4); PG8_BAR;
        PG8_STAGE(PG8_SB(1, 0), cB + kstep, voffB); PG8_STAGE(PG8_SA(1, 0), cA + kstep, voffA); PG8_STAGE(PG8_SB(1, 1), cB + hstepB + kstep, voffB);
        PG8_WAIT_V(6); PG8_BAR;
    }
    for (;;) {
        const bool has_next = S.next(ui + 1, nxt);
        const char* nA = has_next ? (const char*)g.A + (size_t)nxt.pm * tstep : cA; const char* nB = has_next ? (const char*)g.Bt + (size_t)nxt.pn * tstep : cB;
        for (int t = 0; t < nt; t += 2) {
            const bool last = (t == nt - 2);
            const char* a1 = cA + (size_t)(t + 1) * kstep;
            const char* a2 = last ? nA : cA + (size_t)(t + 2) * kstep; const char* b2 = last ? nB : cB + (size_t)(t + 2) * kstep;
            const char* a3 = a2 + kstep; const char* b3 = b2 + kstep;
            if (last && has_next) S.a_ready(nxt);
            if constexpr (SP2) {
            PG8_LDB(B0, 0, 0); PG8_LDB(B1, 0, 1); PG8_SCHED; PG8_LDA(At, 0, 0); PG8_STAGE(PG8_SA(1, 1), a1 + hstep, voffA);
            PG8_WAIT_V(8); PG8_WAIT_L(0); PG8_BAR; PG8_MMA(0, 0, At, B0); PG8_MMA(0, 1, At, B1); PG8_BAR; PG8_SCHED;
            PG8_LDA(At, 0, 1); PG8_STAGE(PG8_SB(0, 0), b2, voffB); PG8_STAGE(PG8_SB(0, 1), b2 + hstepB, voffB); PG8_STAGE(PG8_SA(0, 0), a2, voffA);
            PG8_WAIT_V(8); PG8_WAIT_L(0); PG8_BAR; PG8_MMA(1, 0, At, B0); PG8_MMA(1, 1, At, B1); PG8_BAR; PG8_SCHED;
            PG8_LDB(B0, 1, 0); PG8_LDB(B1, 1, 1); PG8_SCHED; PG8_LDA(At, 1, 0); PG8_STAGE(PG8_SA(0, 1), a2 + hstep, voffA);
            PG8_WAIT_V(8); PG8_WAIT_L(0); PG8_BAR; PG8_MMA(0, 0, At, B0); PG8_MMA(0, 1, At, B1); PG8_BAR; PG8_SCHED;
            PG8_LDA(At, 1, 1); PG8_STAGE(PG8_SB(1, 0), b3, voffB); PG8_STAGE(PG8_SB(1, 1), b3 + hstepB, voffB); PG8_STAGE(PG8_SA(1, 0), a3, voffA);
            PG8_WAIT_V(8); PG8_WAIT_L(0); PG8_BAR; PG8_MMA(1, 0, At, B0); PG8_MMA(1, 1, At, B1); PG8_BAR; PG8_SCHED;
            } else {
            PG8_LDB(B0, 0, 0); PG8_SCHED; PG8_LDA(At, 0, 0); PG8_STAGE(PG8_SA(1, 1), a1 + hstep, voffA);
            PG8_WAIT_L(8); PG8_BAR; PG8_WAIT_L(0); PG8_MMA(0, 0, At, B0); PG8_BAR; PG8_SCHED;
            PG8_LDB(B1, 0, 1); PG8_STAGE(PG8_SB(0, 0), b2, voffB);
            PG8_BAR; PG8_WAIT_L(0); PG8_MMA(0, 1, At, B1); PG8_BAR;
            PG8_LDA(At, 0, 1); PG8_STAGE(PG8_SA(0, 0), a2, voffA);
            PG8_BAR; PG8_WAIT_L(0); PG8_MMA(1, 0, At, B0); PG8_BAR; PG8_SCHED;
            PG8_STAGE(PG8_SB(0, 1), b2 + hstepB, voffB);
            PG8_WAIT_V(6); PG8_BAR; PG8_MMA(1, 1, At, B1); PG8_BAR;
            PG8_LDB(B0, 1, 0); PG8_SCHED; PG8_LDA(At, 1, 0); PG8_STAGE(PG8_SA(0, 1), a2 + hstep, voffA);
            PG8_WAIT_L(8); PG8_BAR; PG8_WAIT_L(0); PG8_MMA(0, 0, At, B0); PG8_BAR; PG8_SCHED;
            PG8_LDB(B1, 1, 1); PG8_STAGE(PG8_SB(1, 0), b3, voffB);
            PG8_BAR; PG8_WAIT_L(0); PG8_MMA(0, 1, At, B1); PG8_BAR;
            PG8_LDA(At, 1, 1); PG8_STAGE(PG8_SA(1, 0), a3, voffA);
            PG8_BAR; PG8_WAIT_L(0); PG8_MMA(1, 0, At, B0); PG8_BAR; PG8_SCHED;
            PG8_STAGE(PG8_SB(1, 1), b3 + hstepB, voffB);
            PG8_WAIT_V(6); PG8_BAR; PG8_MMA(1, 1, At, B1); PG8_BAR;
            }
            if constexpr (MidTiles<Epi>::v > 0) { if (t + 2 == MidTiles<Epi>::v) { asm volatile("s_nop 15\n\ts_nop 15" ::: "memory"); E.mid(acc, cur, wr, wc, fr, fq); } }
        }
        if constexpr (ALIGN_EPI) { if (wr == 0) PG8_BAR; }
        if constexpr (FP8) asm volatile("s_nop 15\n\ts_nop 15" ::: "memory");
        if constexpr (!Epi::AFTER_DRAIN) E(acc, cur, wr, wc, fr, fq);
        if (!has_next) break;
#pragma unroll
        for (int a = 0; a < 2; ++a)
#pragma unroll
            for (int b = 0; b < 2; ++b)
#pragma unroll
                for (int m = 0; m < 4; ++m)
#pragma unroll
                    for (int n = 0; n < 2; ++n) acc[a][b][m][n] = (f32x4){0.f, 0.f, 0.f, 0.f};
        cur = nxt; cA = nA; cB = nB; ++ui;
        if constexpr (ALIGN_EPI) { if (wr == 1) PG8_BAR; }
    }
    PG8_WAIT_V(0);
    if constexpr (!ALIGN_EPI) { if (wr == 0) PG8_BAR; }
    PG8_BAR;
    if constexpr (Epi::AFTER_DRAIN) E.fused(acc, cur, wr, wc, fr, fq, lds);
#undef PG8_SA
#undef PG8_SB
#undef PG8_STAGE
#undef PG8_LDA
#undef PG8_LDB
#undef PG8_MMA
#undef PG8_WAIT_V
#undef PG8_WAIT_L
#undef PG8_BAR
#undef PG8_SCHED
}
}
using pg8::cvt_pk_bf16;

#define XB_TMO      128
#define XB_XCNT(j)  (256  + 64 * (j))
#define XB_XSUB(j)  (1280 + 64 * (j))
#define XB_XGEN(j)  (2304 + 64 * (j))
#define XB_TOP      3328
#define XB_TOPGEN   3392
#define XCD_BAR_WORDS 3456
#define XB_SPIN_CAP (1u << 18)
__device__ __forceinline__ unsigned xb_ld(unsigned* p)              { return __hip_atomic_load(p, __ATOMIC_RELAXED, __HIP_MEMORY_SCOPE_AGENT); }
__device__ __forceinline__ unsigned xb_add(unsigned* p, unsigned v) { return __hip_atomic_fetch_add(p, v, __ATOMIC_RELAXED, __HIP_MEMORY_SCOPE_AGENT); }
__device__ __forceinline__ unsigned xb_xcc_id() { return (unsigned)__builtin_amdgcn_s_getreg((3 << 11) | 20) & 0xFu; }
#define XB_SPIN(cond, bar) do { unsigned _sp = 0; while (cond) { __builtin_amdgcn_s_sleep(1); \
    if ((++_sp & 255u) == 0u) { if (xb_ld(&(bar)[XB_TMO])) break; if (_sp > XB_SPIN_CAP) { atomicAdd(&(bar)[XB_TMO], 1u); break; } } } } while (0)
struct XcdBarrier { unsigned* bar; unsigned x; volatile LAS unsigned* st; };
__device__ __forceinline__ XcdBarrier xcd_barrier_post(unsigned* bar, volatile LAS unsigned* st) {
    XcdBarrier b; b.bar = bar; b.x = xb_xcc_id(); b.st = st;
    if (threadIdx.x == 0) (void)xb_add(&bar[XB_XCNT(b.x)], 1u);
    return b;
}
__device__ __forceinline__ void xcd_barrier_complete(unsigned* bar, unsigned x, unsigned& nloc, unsigned& nx) {
    const unsigned G = gridDim.x * gridDim.y * gridDim.z;
    unsigned sum, cnt, mine, sp = 0u;
    for (;;) {
        sum = 0u; cnt = 0u; mine = 0u;
#pragma unroll
        for (unsigned j = 0; j < 16; ++j) { const unsigned c = xb_ld(&bar[XB_XCNT(j)]); sum += c; cnt += (c > 0u) ? 1u : 0u; mine = (j == x) ? c : mine; }
        if (sum == G) break;
        __builtin_amdgcn_s_sleep(1);
        if ((++sp & 255u) == 0u) { if (xb_ld(&bar[XB_TMO])) break; if (sp > XB_SPIN_CAP) { atomicAdd(&bar[XB_TMO], 1u); break; } }
    }
    nloc = mine > 0u ? mine : 1u; nx = cnt > 0u ? cnt : 1u;
}
__device__ __forceinline__ void xcd_barrier(const XcdBarrier& b) {
    asm volatile("s_waitcnt vmcnt(0)" ::: "memory");
    __syncthreads();
    if (threadIdx.x == 0) {
        unsigned* bar = b.bar;
        __builtin_amdgcn_s_waitcnt(0);
        unsigned nloc = b.st[0], nx = b.st[1];
        if (nloc == 0u) { xcd_barrier_complete(bar, b.x, nloc, nx); b.st[0] = nloc; b.st[1] = nx; }
        const unsigned old = xb_add(&bar[XB_XSUB(b.x)], 1u);
        const unsigned gen = old / nloc;
        if (old + 1u == (gen + 1u) * nloc) {
            __builtin_amdgcn_fence(__ATOMIC_RELEASE, "agent");
            asm volatile("s_waitcnt vmcnt(0)" ::: "memory");
            const unsigned og = xb_add(&bar[XB_TOP], 1u);
            const unsigned tg = og / nx;
            if (og + 1u == (tg + 1u) * nx) xb_add(&bar[XB_TOPGEN], 1u);
            else XB_SPIN(xb_ld(&bar[XB_TOPGEN]) == tg, bar);
            __builtin_amdgcn_fence(__ATOMIC_ACQUIRE, "agent");
            xb_add(&bar[XB_XGEN(b.x)], 1u);
            asm volatile("s_waitcnt vmcnt(0)" ::: "memory");
        } else {
            XB_SPIN(xb_ld(&bar[XB_XGEN(b.x)]) == gen, bar);
            __builtin_amdgcn_fence(__ATOMIC_ACQUIRE, "agent");
            asm volatile("s_waitcnt vmcnt(0)" ::: "memory");
        }
    }
    __syncthreads();
}

struct Args { const float* in[18]; float* out; unsigned char* ws; int ph_lo, ph_hi, li, pad; };
enum { I_X = 0, I_P, I_NORM_MIX, I_W_IN, I_QKN_NA, I_RPB, I_QKN_DIL, I_W_BNA, I_W_BDIL, I_W_OUT, I_NORM_FFN, I_WQ, I_SUBK, I_EU, I_EV, I_NORM_PLE, I_W_PLEG, I_W_PLE };

__device__ __forceinline__ int opaque_tid() { int t = threadIdx.x; asm volatile("" : "+v"(t)); return t; }
struct Ctx {
    LAS unsigned char* lds;
    int G, vcu;
    const Args* a;
};
#define CTX_LANES() const int tid_ = opaque_tid(); const int lane = tid_ & 63; const int wave = __builtin_amdgcn_readfirstlane(tid_ >> 6); (void)lane; (void)wave

__device__ __forceinline__ unsigned pk4_fp8(float a, float b, float c, float d) { int w = 0; w = __builtin_amdgcn_cvt_pk_fp8_f32(a, b, w, false); w = __builtin_amdgcn_cvt_pk_fp8_f32(c, d, w, true); return (unsigned)w; }
constexpr float W8_SCALE = 64.0f, A8_SCALE = 8.0f;
__device__ __forceinline__ void p0_transpose_item(const float* W, const float* gain, int K, int N, bf16_t* WT, LAS float* scr, int item, int lane) {
    const int nblk = N / 32, kb = item / nblk, nb = item % nblk, k0 = 64 * kb, n0 = 32 * nb;
    f32x4 t[8];
#pragma unroll
    for (int i = 0; i < 8; ++i) t[i] = __builtin_nontemporal_load((const f32x4*)(W + (size_t)(k0 + 8 * i + (lane >> 3)) * N + n0 + 4 * (lane & 7)));
#pragma unroll
    for (int i = 0; i < 8; ++i) { const int kk = 8 * i + (lane >> 3); f32x4 w = t[i]; if (gain) w *= gain[k0 + kk]; LAS float* d = scr + kk * 33 + 4 * (lane & 7); d[0] = w.x; d[1] = w.y; d[2] = w.z; d[3] = w.w; }
    asm volatile("s_waitcnt lgkmcnt(0)" ::: "memory");
    const int c = lane & 7;
#pragma unroll
    for (int j = 0; j < 4; ++j) { const int n = (lane >> 3) + 8 * j; const LAS float* s = scr + (8 * c) * 33 + n;
        u32x4 o; o.x = pk2(s[0 * 33], s[1 * 33]); o.y = pk2(s[2 * 33], s[3 * 33]); o.z = pk2(s[4 * 33], s[5 * 33]); o.w = pk2(s[6 * 33], s[7 * 33]);
        *(u32x4*)(WT + (size_t)(n0 + n) * K + k0 + 8 * c) = o; }
    asm volatile("s_waitcnt lgkmcnt(0)" ::: "memory");
}

__device__ __forceinline__ void p0_transpose_item_fp8(const float* W, const float* gain, int K, int N, unsigned char* WT, LAS float* scr, int item, int lane, int pitch = 0) {
    if (pitch == 0) pitch = K;
    const int nblk = N / 32, kb = item / nblk, nb = item % nblk, k0 = 64 * kb, n0 = 32 * nb;
    f32x4 t[8];
#pragma unroll
    for (int i = 0; i < 8; ++i) t[i] = __builtin_nontemporal_load((const f32x4*)(W + (size_t)(k0 + 8 * i + (lane >> 3)) * N + n0 + 4 * (lane & 7)));
#pragma unroll
    for (int i = 0; i < 8; ++i) { const int kk = 8 * i + (lane >> 3); f32x4 w = t[i] * W8_SCALE; if (gain) w *= gain[k0 + kk]; LAS float* d = scr + kk * 33 + 4 * (lane & 7); d[0] = w.x; d[1] = w.y; d[2] = w.z; d[3] = w.w; }
    asm volatile("s_waitcnt lgkmcnt(0)" ::: "memory");
    const int c = lane & 7;
#pragma unroll
    for (int j = 0; j < 4; ++j) { const int n = (lane >> 3) + 8 * j; const LAS float* s = scr + (8 * c) * 33 + n;
        *(u32x2*)(WT + (size_t)(n0 + n) * pitch + k0 + 8 * c) = (u32x2){pk4_fp8(s[0 * 33], s[1 * 33], s[2 * 33], s[3 * 33]), pk4_fp8(s[4 * 33], s[5 * 33], s[6 * 33], s[7 * 33])}; }
    asm volatile("s_waitcnt lgkmcnt(0)" ::: "memory");
}
__device__ __forceinline__ void phase_prologue(const Ctx& C) {
    const Args& A = *C.a; unsigned char* ws = A.ws; CTX_LANES();
    LAS float* scr = (LAS float*)(C.lds + wave * 16384);
    const int gw = C.vcu * 8 + wave, NGW = C.G * 8;
    for (int rp_ = 0; rp_ < 1 + ((PROBE_PRO >> 0) & 1); ++rp_)
    {
        constexpr int I_IN = (D / 64) * (IN_W / 32), I_NA = (512 / 64) * (D / 32), I_DL = (256 / 64) * (D / 32), I_OUT = (D / 64) * (D / 32), I_G = I_OUT, I_PL = (256 / 64) * (D / 32);
        constexpr int NITEMS = I_IN + I_NA + I_DL + I_OUT + I_G + I_PL;
        for (int it = gw; it < NITEMS; it += NGW) {
            int r = it;
            if (r < I_IN) { p0_transpose_item_fp8(A.in[I_W_IN], A.in[I_NORM_MIX], D, IN_W, ws + WS_WIN, scr, r, lane); continue; } r -= I_IN;
            if (r < I_NA) { p0_transpose_item_fp8(A.in[I_W_BNA], nullptr, 512, D, ws + WS_WNA, scr, r, lane, ACAT); continue; } r -= I_NA;
            if (r < I_DL) { p0_transpose_item_fp8(A.in[I_W_BDIL], nullptr, 256, D, ws + WS_WNA + 512, scr, r, lane, ACAT); continue; } r -= I_DL;
            if (r < I_OUT) { p0_transpose_item_fp8(A.in[I_W_OUT], nullptr, D, D, ws + WS_WOUT, scr, r, lane); continue; } r -= I_OUT;
            if (r < I_G) { p0_transpose_item(A.in[I_W_PLEG], A.in[I_NORM_PLE], D, D, (bf16_t*)(ws + WS_WG), scr, r, lane); continue; } r -= I_G;
            p0_transpose_item(A.in[I_W_PLE], nullptr, 256, D, (bf16_t*)(ws + WS_WPLE), scr, r, lane);
        }
    }
    for (int rp_ = 0; rp_ < 1 + ((PROBE_PRO >> 1) & 1); ++rp_)
    {
        const float* wq = A.in[I_WQ]; const float* sk = A.in[I_SUBK]; const float* gf = A.in[I_NORM_FFN];
        bf16_t* wsc = (bf16_t*)(ws + WS_WSC);
        for (int it = gw; it < 16 * 64; it += NGW) {
            const int hs = it >> 6, k0 = (it & 63) * 16, side = hs & 1;
#pragma unroll
            for (int i = 0; i < 8; ++i) { const int e = i * 64 + lane; const int kk = e >> 5, c4 = e & 31;
                *(LAS f32x4*)(scr + kk * 128 + c4 * 4) = *(const f32x4*)(wq + (size_t)(k0 + kk) * 2048 + hs * 128 + c4 * 4); }
            asm volatile("s_waitcnt lgkmcnt(0)" ::: "memory");
            float acc0[16], acc1[16];
#pragma unroll
            for (int kk = 0; kk < 16; ++kk) { acc0[kk] = 0.f; acc1[kk] = 0.f; }
            const float* r0 = sk + ((size_t)side * 128 + lane) * 128; const float* r1 = r0 + 64 * 128;
#pragma unroll 8
            for (int d4 = 0; d4 < 32; ++d4) {
                const f32x4 a = *(const f32x4*)(r0 + d4 * 4), b = *(const f32x4*)(r1 + d4 * 4);
#pragma unroll
                for (int kk = 0; kk < 16; ++kk) { const f32x4 w = *(const LAS f32x4*)(scr + kk * 128 + d4 * 4);
                    acc0[kk] += a.x * w.x + a.y * w.y + a.z * w.z + a.w * w.w; acc1[kk] += b.x * w.x + b.y * w.y + b.z * w.z + b.w * w.w; }
            }
            unsigned o0[8], o1[8];
#pragma unroll
            for (int j = 0; j < 8; ++j) { const float g0 = gf[k0 + 2 * j], g1 = gf[k0 + 2 * j + 1]; o0[j] = pk2(acc0[2 * j] * g0, acc0[2 * j + 1] * g1); o1[j] = pk2(acc1[2 * j] * g0, acc1[2 * j + 1] * g1); }
            bf16_t* d0 = wsc + (size_t)(hs * 128 + lane) * D + k0; bf16_t* d1 = d0 + (size_t)64 * D;
            *(u32x4*)d0 = (u32x4){o0[0], o0[1], o0[2], o0[3]}; *(u32x4*)(d0 + 8) = (u32x4){o0[4], o0[5], o0[6], o0[7]};
            *(u32x4*)d1 = (u32x4){o1[0], o1[1], o1[2], o1[3]}; *(u32x4*)(d1 + 8) = (u32x4){o1[4], o1[5], o1[6], o1[7]};
            asm volatile("s_waitcnt lgkmcnt(0)" ::: "memory");
        }
    }
    for (int rp_ = 0; rp_ < 1 + ((PROBE_PRO >> 2) & 1); ++rp_)
    {
        const size_t gt = (size_t)(C.vcu * 512 + tid_), NT = (size_t)C.G * 512;
#define CVT_PASS(SRC, DST, CNT) do { const float* s_ = (SRC); bf16_t* d_ = (DST); const size_t c_ = (CNT); \
            for (size_t i = gt; i < c_; i += 4 * NT) { f32x4 a_[4], b_[4]; \
                _Pragma("unroll") for (int q = 0; q < 4; ++q) { const size_t iq = i + q * NT; if (iq < c_) { a_[q] = __builtin_nontemporal_load((const f32x4*)(s_ + iq * 8)); b_[q] = __builtin_nontemporal_load((const f32x4*)(s_ + iq * 8 + 4)); } } \
                _Pragma("unroll") for (int q = 0; q < 4; ++q) { const size_t iq = i + q * NT; if (iq < c_) *(u32x4*)(d_ + iq * 8) = (u32x4){pk2(a_[q].x, a_[q].y), pk2(a_[q].z, a_[q].w), pk2(b_[q].x, b_[q].y), pk2(b_[q].z, b_[q].w)}; } } } while (0)
        CVT_PASS(A.in[I_P], (bf16_t*)(ws + WS_PB), (size_t)T * 256 / 8);
#undef CVT_PASS
        float* ct = (float*)(ws + WS_COS); float* st = (float*)(ws + WS_SIN);
        for (size_t i = gt; i < 4096 * 8; i += NT) {
            const int pos = (int)(i >> 3), f = (int)(i & 7);
            const float invf[8] = {1.0f, 0.19392274f, 0.03760603f, 0.0072926646f, 0.0014142136f, 0.0002742482f, 5.3182957e-05f, 1.0313385e-05f};
            float fr_ = invf[0];
#pragma unroll
            for (int q = 1; q < 8; ++q) fr_ = (f == q) ? invf[q] : fr_;
            const float ang = (float)pos * fr_;
            double tt = (double)ang * 0.15915494309189535; tt -= floor(tt);
            ct[i] = __builtin_amdgcn_cosf((float)tt); st[i] = __builtin_amdgcn_sinf((float)tt);
        }
    }
    for (int rp_ = 0; rp_ < 1 + ((PROBE_PRO >> 3) & 1); ++rp_)
    {
        auto load_rows = [&](f32x4 (&v)[4][4], const int rr0) __attribute__((always_inline)) {
#pragma unroll
            for (int r = 0; r < 4; ++r) { const int rr = rr0 + r, e = rr & (NEXP - 1), which = rr >> 14;
                const float* src = (which ? A.in[I_EV] : A.in[I_EU]) + (size_t)e * D + 16 * lane;
#pragma unroll
                for (int j = 0; j < 4; ++j) v[r][j] = __builtin_nontemporal_load((const f32x4*)(src + 4 * j)); }
        };
        auto quant_rows = [&](const f32x4 (&v)[4][4], const int rr0) __attribute__((always_inline)) {
#pragma unroll
            for (int r = 0; r < 4; ++r) { const int rr = rr0 + r, e = rr & (NEXP - 1), which = rr >> 14;
                float ss = 0.f;
#pragma unroll
                for (int j = 0; j < 4; ++j) ss += (v[r][j].x * v[r][j].x + v[r][j].y * v[r][j].y) + (v[r][j].z * v[r][j].z + v[r][j].w * v[r][j].w);
                ss = wave_sum_dpp(ss);
                const float rms = sqrtf(ss * (1.0f / D));
                const float sc = which ? 0.5f * rms : 0.335f * rms, inv = rms > 0.f ? 1.0f / sc : 0.f;
                unsigned w[2];
                if (which) {
#define NIB_FP4(x_) ({ const float t_ = (x_) * inv; const float a_ = fabsf(t_); \
                       (unsigned)((a_ >= 0.25f) + (a_ >= 0.75f) + (a_ >= 1.25f) + (a_ >= 1.75f) + (a_ >= 2.5f) + (a_ >= 3.5f) + (a_ >= 5.0f)) | (t_ < 0.f ? 8u : 0u); })
#pragma unroll
                    for (int hh = 0; hh < 2; ++hh) { const f32x4 a = v[r][2 * hh], b = v[r][2 * hh + 1];
                        w[hh] = NIB_FP4(a.x) | (NIB_FP4(a.y) << 4) | (NIB_FP4(a.z) << 8) | (NIB_FP4(a.w) << 12) | (NIB_FP4(b.x) << 16) | (NIB_FP4(b.y) << 20) | (NIB_FP4(b.z) << 24) | (NIB_FP4(b.w) << 28); }
#undef NIB_FP4
                } else {
#define NIB_I4(x_) ((unsigned)(int)fminf(fmaxf(__builtin_rintf((x_) * inv), -8.f), 7.f) & 15u)
#pragma unroll
                    for (int hh = 0; hh < 2; ++hh) { const f32x4 a = v[r][2 * hh], b = v[r][2 * hh + 1];
                        w[hh] = NIB_I4(a.x) | (NIB_I4(b.x) << 4) | (NIB_I4(a.y) << 8) | (NIB_I4(b.y) << 12) | (NIB_I4(a.z) << 16) | (NIB_I4(b.z) << 20) | (NIB_I4(a.w) << 24) | (NIB_I4(b.w) << 28); }
#undef NIB_I4
                }
                *(u32x2*)(ws + (which ? WS_EV : WS_EU) + (size_t)(lane >> 4) * (NEXP * 128) + (size_t)e * 128 + 8 * (lane & 15)) = (u32x2){w[0], w[1]};
                if (lane == 0) ((float*)(ws + (which ? WS_SV : WS_SU)))[e] = sc; }
        };
        {
            f32x4 va[4][4], vb[4][4];
            const int step = NGW * 4, end = 2 * NEXP, r0 = gw * 4;
            const int nb = r0 < end ? (end - r0 + step - 1) / step : 0;
            if (nb > 0) load_rows(va, r0);
            int k = 0;
#pragma unroll 1
            for (; k + 2 < nb; k += 2) {
                load_rows(vb, r0 + (k + 1) * step); quant_rows(va, r0 + k * step);
                load_rows(va, r0 + (k + 2) * step); quant_rows(vb, r0 + (k + 1) * step);
            }
            if (k + 1 < nb) { load_rows(vb, r0 + (k + 1) * step); quant_rows(va, r0 + k * step); quant_rows(vb, r0 + (k + 1) * step); }
            else if (k < nb) quant_rows(va, r0 + k * step);
        }
    }
    for (int rp_ = 0; rp_ < 1 + ((PROBE_PRO >> 4) & 1); ++rp_)
    {
        const float* x = A.in[I_X]; bf16_t* xb = (bf16_t*)((unsigned char*)A.out + DO_XB); float* rs = (float*)(ws + WS_RSTD1);
        auto load_x = [&](f32x4 (&v)[4][4], const int m0) __attribute__((always_inline)) {
#pragma unroll
            for (int r = 0; r < 4; ++r) { const f32x4* xr = (const f32x4*)(x + (size_t)(m0 + r) * D) + lane * 2;
#pragma unroll
                for (int j = 0; j < 2; ++j) { v[r][2 * j] = xr[128 * j]; v[r][2 * j + 1] = xr[128 * j + 1]; } }
        };
        auto conv_x = [&](const f32x4 (&v)[4][4], const int m0) __attribute__((always_inline)) {
#pragma unroll
            for (int r = 0; r < 4; ++r) { float s = 0.f;
#pragma unroll
                for (int j = 0; j < 4; ++j) s += (v[r][j].x * v[r][j].x + v[r][j].y * v[r][j].y) + (v[r][j].z * v[r][j].z + v[r][j].w * v[r][j].w);
                s = wave_sum_dpp(s);
                if (lane == 0) rs[m0 + r] = 1.0f / sqrtf(s * (1.0f / D) + RMS_EPS);
                u32x2* o = (u32x2*)((unsigned char*)xb + (size_t)(m0 + r) * D) + lane;
#pragma unroll
                for (int j = 0; j < 2; ++j) o[64 * j] = (u32x2){pk4_fp8(v[r][2 * j].x, v[r][2 * j].y, v[r][2 * j].z, v[r][2 * j].w), pk4_fp8(v[r][2 * j + 1].x, v[r][2 * j + 1].y, v[r][2 * j + 1].z, v[r][2 * j + 1].w)}; }
        };
        {
            f32x4 va[4][4], vb[4][4];
            const int step = NGW * 4, r0 = gw * 4;
            const int nb = r0 < T ? (T - r0 + step - 1) / step : 0;
            if (nb > 0) load_x(va, r0);
            int k = 0;
#pragma unroll 1
            for (; k + 2 < nb; k += 2) {
                load_x(vb, r0 + (k + 1) * step); conv_x(va, r0 + k * step);
                load_x(va, r0 + (k + 2) * step); conv_x(vb, r0 + (k + 1) * step);
            }
            if (k + 1 < nb) { load_x(vb, r0 + (k + 1) * step); conv_x(va, r0 + k * step); conv_x(vb, r0 + (k + 1) * step); }
            else if (k < nb) conv_x(va, r0 + k * step);
        }
    }
}

using pg8::Unit;
struct EpiProj {
    static constexpr bool AFTER_DRAIN = false;
    const float* rstd; const float* qkn_na; const float* qkn_dil; const float* cosT; const float* sinT;
    unsigned char* wsb;
    __device__ __forceinline__ void operator()(const f32x4 (&acc)[2][2][4][2], const Unit& u, int wr, int wc, int fr, int fq) const {
        const int pn = u.pn;
        int kind, sub;
        if (pn < 6) { kind = pn >> 1; sub = pn & 1; } else if (pn < 15) { kind = 3 + (pn - 6) / 3; sub = (pn - 6) % 3; } else { kind = 6; sub = pn - 15; }
        const bool is_qk = (kind == 0 || kind == 1 || kind == 3 || kind == 4);
        const bool is_dil = (kind >= 3 && kind <= 5);
        const float* gainp = (kind < 3 ? qkn_na : qkn_dil) + ((kind == 1 || kind == 4) ? 64 : 0);
        float gn[2][8];
#pragma unroll
        for (int bj = 0; bj < 2; ++bj) {
            if (is_qk) { const f32x4 g0 = *(const f32x4*)(gainp + 32 * bj + 8 * fq), g1 = *(const f32x4*)(gainp + 32 * bj + 8 * fq + 4);
                gn[bj][0] = g0.x; gn[bj][1] = g0.y; gn[bj][2] = g0.z; gn[bj][3] = g0.w; gn[bj][4] = g1.x; gn[bj][5] = g1.y; gn[bj][6] = g1.z; gn[bj][7] = g1.w; }
            else {
#pragma unroll
                for (int j = 0; j < 8; ++j) gn[bj][j] = 1.f; }
        }
        const float qs = (kind == 0 || kind == 3) ? QSCALE : 1.0f;
        const size_t boff = kind < 3 ? (WS_QNA + (size_t)kind * (WS_KNA - WS_QNA)) : (kind < 6 ? (WS_QDIL + (size_t)(kind - 3) * (WS_KDIL - WS_QDIL)) : WS_GATES);
        bf16_t* base = (bf16_t*)(wsb + boff);
        float rsv[8];
#pragma unroll
        for (int q = 0; q < 8; ++q) rsv[q] = rstd[u.pm * 256 + (q >> 2) * 128 + wr * 64 + (q & 3) * 16 + fr] * (1.0f / W8_SCALE);
        const float fr0 = 0.15915494f, fr1 = 0.030863762f, fr2 = 0.0059851858f, fr3 = 0.0011606637f, fr4 = 0.00022508f, fr5 = 4.3648e-05f, fr6 = 8.4643e-06f, fr7 = 1.6414e-06f;
#pragma unroll
        for (int ai = 0; ai < 2; ++ai)
#pragma unroll
            for (int m = 0; m < 4; ++m) {
                const int row = u.pm * 256 + ai * 128 + wr * 64 + m * 16 + fr;
                const float rs = rsv[ai * 4 + m];
                float v[2][8];
#pragma unroll
                for (int bj = 0; bj < 2; ++bj)
#pragma unroll
                    for (int n = 0; n < 2; ++n)
#pragma unroll
                        for (int j = 0; j < 4; ++j) v[bj][4 * n + j] = acc[ai][bj][m][n][j] * rs;
                if (kind == 6) {
                    bf16_t* rowp = base + (size_t)row * 2048 + sub * 256 + wc * 64 + 8 * fq;
#pragma unroll
                    for (int bj = 0; bj < 2; ++bj) { u32x4 w;
                        w.x = cvt_pk_bf16(sigmoidf_(v[bj][0]), sigmoidf_(v[bj][1])); w.y = cvt_pk_bf16(sigmoidf_(v[bj][2]), sigmoidf_(v[bj][3]));
                        w.z = cvt_pk_bf16(sigmoidf_(v[bj][4]), sigmoidf_(v[bj][5])); w.w = cvt_pk_bf16(sigmoidf_(v[bj][6]), sigmoidf_(v[bj][7]));
                        *(u32x4*)(rowp + 32 * bj) = w; }
                    continue;
                }
                if (is_qk) {
                    float ss = 0.f;
#pragma unroll
                    for (int bj = 0; bj < 2; ++bj)
#pragma unroll
                        for (int j = 0; j < 8; ++j) ss += v[bj][j] * v[bj][j];
                    ss = sum_x16_x32(ss);
                    const float r = 1.0f / sqrtf(ss * (1.0f / 64.0f) + RMS_EPS);
#pragma unroll
                    for (int bj = 0; bj < 2; ++bj)
#pragma unroll
                        for (int j = 0; j < 8; ++j) v[bj][j] = v[bj][j] * r * gn[bj][j];
                    if (is_dil) {
                        const float pos = (float)(row & (SEQ - 1));
                        const float frq[8] = {fr0, fr1, fr2, fr3, fr4, fr5, fr6, fr7};
                        float cs[8], sn[8];
#pragma unroll
                        for (int j = 0; j < 8; ++j) { const float t = __builtin_amdgcn_fractf(pos * frq[j]); cs[j] = __builtin_amdgcn_cosf(t); sn[j] = __builtin_amdgcn_sinf(t); }
#pragma unroll
                        for (int j = 0; j < 8; ++j) {
                            const float own = v[0][j], oth = other_x16(own, fq << 4);
                            const float rot = (fq == 0) ? (own * cs[j] - oth * sn[j]) : (own * cs[j] + oth * sn[j]);
                            v[0][j] = (fq < 2) ? rot : own;
                        }
                    }
                }
                const int b = row >> 12, s = row & (SEQ - 1);
                size_t off;
                if (!is_dil) { const int head = sub * 4 + wc; off = ((size_t)(b * NA_H + head) * SEQ + s) * HD; }
                else { const int g = sub, sh = 2 * g, L = SEQ >> sh; const int sp = (s & ((1 << sh) - 1)) * L + (s >> sh); off = ((size_t)((b * 3 + g) * 4 + wc) * SEQ + sp) * HD; }
                bf16_t* rowp = base + off + 8 * fq;
#pragma unroll
                for (int bj = 0; bj < 2; ++bj) { u32x4 w;
                    w.x = cvt_pk_bf16(v[bj][0] * qs, v[bj][1] * qs); w.y = cvt_pk_bf16(v[bj][2] * qs, v[bj][3] * qs); w.z = cvt_pk_bf16(v[bj][4] * qs, v[bj][5] * qs); w.w = cvt_pk_bf16(v[bj][6] * qs, v[bj][7] * qs);
                    *(u32x4*)(rowp + 32 * bj) = w; }
            }
    }
};
template <int MODE> struct EpiGate {
    static constexpr bool AFTER_DRAIN = false;
    bf16_t* O; const bf16_t* G; int ldg; int gcol0; const bf16_t* P; float ascale;
    __device__ __forceinline__ void operator()(const f32x4 (&acc)[2][2][4][2], const Unit& u, int wr, int wc, int fr, int fq) const {
        const int row0 = u.pm * 256 + wr * 64 + fr, col0 = u.pn * 256 + wc * 64 + 8 * fq;
        u32x4 gq[2][2], pq[2][2];
#define EG_LOAD(buf, it) do { const int r_ = row0 + ((it) >> 2) * 128 + ((it) & 3) * 16; \
            if (MODE <= 1) { gq[buf][0] = *(const u32x4*)(G + (size_t)r_ * ldg + gcol0 + col0); gq[buf][1] = *(const u32x4*)(G + (size_t)r_ * ldg + gcol0 + col0 + 32); } \
            if (MODE == 1) { pq[buf][0] = *(const u32x4*)(P + (size_t)r_ * D + col0); pq[buf][1] = *(const u32x4*)(P + (size_t)r_ * D + col0 + 32); } } while (0)
        EG_LOAD(0, 0);
#pragma unroll
        for (int it = 0; it < 8; ++it) {
            const int ai = it >> 2, m = it & 3, row = row0 + ai * 128 + m * 16;
            if (it + 1 < 8) EG_LOAD((it + 1) & 1, it + 1);
#pragma unroll
            for (int bj = 0; bj < 2; ++bj) {
                float v[8];
#pragma unroll
                for (int n = 0; n < 2; ++n)
#pragma unroll
                    for (int j = 0; j < 4; ++j) v[4 * n + j] = acc[ai][bj][m][n][j] * ascale;
                if (MODE <= 1) { const u32x4 g = gq[it & 1][bj];
                    v[0] *= bf_lo(g.x); v[1] *= bf_hi(g.x); v[2] *= bf_lo(g.y); v[3] *= bf_hi(g.y); v[4] *= bf_lo(g.z); v[5] *= bf_hi(g.z); v[6] *= bf_lo(g.w); v[7] *= bf_hi(g.w); }
                if (MODE == 1) { const u32x4 p = pq[it & 1][bj];
                    v[0] += bf_lo(p.x); v[1] += bf_hi(p.x); v[2] += bf_lo(p.y); v[3] += bf_hi(p.y); v[4] += bf_lo(p.z); v[5] += bf_hi(p.z); v[6] += bf_lo(p.w); v[7] += bf_hi(p.w); }
                if (MODE == 1) *(u32x2*)((unsigned char*)O + (size_t)row * D + col0 + 32 * bj) = (u32x2){pk4_fp8(v[0] * A8_SCALE, v[1] * A8_SCALE, v[2] * A8_SCALE, v[3] * A8_SCALE), pk4_fp8(v[4] * A8_SCALE, v[5] * A8_SCALE, v[6] * A8_SCALE, v[7] * A8_SCALE)};
                else *(u32x4*)(O + (size_t)row * D + col0 + 32 * bj) = (u32x4){cvt_pk_bf16(v[0], v[1]), cvt_pk_bf16(v[2], v[3]), cvt_pk_bf16(v[4], v[5]), cvt_pk_bf16(v[6], v[7])};
            }
            asm volatile("" ::: "memory");
        }
#undef EG_LOAD
    }
};
struct EpiMerge {
    static constexpr bool AFTER_DRAIN = false; static constexpr int MID_TILES = 4;
    unsigned char* O; const bf16_t* G; float ascale;
    __device__ __forceinline__ void mid(f32x4 (&acc)[2][2][4][2], const Unit& u, int wr, int wc, int fr, int fq) const {
        asm volatile("" : "+v"(fr), "+v"(fq));
        const int row0 = u.pm * 256 + wr * 64 + fr, col0 = u.pn * 256 + wc * 64 + 8 * fq;
#pragma unroll
        for (int it = 0; it < 8; ++it) {
            const int ai = it >> 2, m = it & 3, row = row0 + ai * 128 + m * 16;
            const bf16_t* gp = G + (size_t)row * 2048 + col0;
#define EM_R(nw, dw, lo) ((lo ? bf_lo(nw) : bf_hi(nw)) * __builtin_amdgcn_rcpf(fmaxf(lo ? bf_lo(dw) : bf_hi(dw), 1e-30f)))
#pragma unroll
            for (int bj = 0; bj < 2; ++bj) {
                const u32x4 n0 = *(const u32x4*)(gp + 32 * bj), d0 = *(const u32x4*)(gp + 1024 + 32 * bj);
                acc[ai][bj][m][0] *= (f32x4){EM_R(n0.x, d0.x, 1), EM_R(n0.x, d0.x, 0), EM_R(n0.y, d0.y, 1), EM_R(n0.y, d0.y, 0)}; acc[ai][bj][m][1] *= (f32x4){EM_R(n0.z, d0.z, 1), EM_R(n0.z, d0.z, 0), EM_R(n0.w, d0.w, 1), EM_R(n0.w, d0.w, 0)};
                asm volatile("" ::: "memory");
            }
#undef EM_R
            asm volatile("" ::: "memory");
        }
    }
    __device__ __forceinline__ void operator()(const f32x4 (&acc)[2][2][4][2], const Unit& u, int wr, int wc, int fr, int fq) const {
        asm volatile("" : "+v"(fr), "+v"(fq));
        const int row0 = u.pm * 256 + wr * 64 + fr, col0 = u.pn * 256 + wc * 64 + 8 * fq;
        u32x4 gq[2][2];
#define EM_LOAD(buf, it) do { const bf16_t* gp_ = G + (size_t)(row0 + ((it) >> 2) * 128 + ((it) & 3) * 16) * 2048 + 1024 + col0; gq[buf][0] = *(const u32x4*)gp_; gq[buf][1] = *(const u32x4*)(gp_ + 32); } while (0)
        EM_LOAD(0, 0);
        const float sc = ascale * A8_SCALE;
#pragma unroll
        for (int it = 0; it < 8; ++it) {
            const int ai = it >> 2, m = it & 3, row = row0 + ai * 128 + m * 16;
            if (it + 1 < 8) EM_LOAD((it + 1) & 1, it + 1);
#pragma unroll
            for (int bj = 0; bj < 2; ++bj) { const u32x4 g = gq[it & 1][bj]; const f32x4 a = acc[ai][bj][m][0] * sc, b = acc[ai][bj][m][1] * sc;
                *(u32x2*)(O + (size_t)row * D + col0 + 32 * bj) = (u32x2){pk4_fp8(a.x * bf_lo(g.x), a.y * bf_hi(g.x), a.z * bf_lo(g.y), a.w * bf_hi(g.y)), pk4_fp8(b.x * bf_lo(g.z), b.y * bf_hi(g.z), b.z * bf_lo(g.w), b.w * bf_hi(g.w))}; }
            asm volatile("" ::: "memory");
        }
#undef EM_LOAD
    }
};
struct EpiResid {
    static constexpr bool AFTER_DRAIN = false;
    const float* x; float* out; bf16_t* xb; float* ssq; float ascale;
    __device__ __forceinline__ void operator()(const f32x4 (&acc)[2][2][4][2], const Unit& u, int wr, int wc, int fr, int fq) const {
        const int row0 = u.pm * 256 + wr * 64 + fr, col0 = u.pn * 256 + wc * 64 + 8 * fq;
        f32x4 xq[2][4];
#define ER_LOAD(buf, it) do { const float* p_ = x + (size_t)(row0 + ((it) >> 2) * 128 + ((it) & 3) * 16) * D + col0; \
            xq[buf][0] = *(const f32x4*)p_; xq[buf][1] = *(const f32x4*)(p_ + 4); xq[buf][2] = *(const f32x4*)(p_ + 32); xq[buf][3] = *(const f32x4*)(p_ + 36); } while (0)
        ER_LOAD(0, 0);
#pragma unroll
        for (int it = 0; it < 8; ++it) {
            const int ai = it >> 2, m = it & 3, row = row0 + ai * 128 + m * 16;
            if (it + 1 < 8) ER_LOAD((it + 1) & 1, it + 1);
            float ss = 0.f;
#pragma unroll
            for (int bj = 0; bj < 2; ++bj) {
                const size_t o = (size_t)row * D + col0 + 32 * bj;
                const f32x4 a = xq[it & 1][2 * bj] + acc[ai][bj][m][0] * ascale, b = xq[it & 1][2 * bj + 1] + acc[ai][bj][m][1] * ascale;
                *(u32x4*)(xb + o) = (u32x4){cvt_pk_bf16(a.x, a.y), cvt_pk_bf16(a.z, a.w), cvt_pk_bf16(b.x, b.y), cvt_pk_bf16(b.z, b.w)};
                ss += (a.x * a.x + a.y * a.y) + (a.z * a.z + a.w * a.w) + (b.x * b.x + b.y * b.y) + (b.z * b.z + b.w * b.w);
            }
            ss = sum_x16_x32(ss);
            if (fq == 0) ssq[(size_t)row * 16 + u.pn * 4 + wc] = ss;
            asm volatile("" ::: "memory");
        }
#undef ER_LOAD
    }
};
struct EpiScores {
    static constexpr bool AFTER_DRAIN = false;
    const float* ssq; _Float16* S;
    __device__ __forceinline__ void operator()(const f32x4 (&acc)[2][2][4][2], const Unit& u, int wr, int wc, int fr, int fq) const {
        const int row0 = u.pm * 256 + wr * 64 + fr, col0 = u.pn * 256 + wc * 64 + 8 * fq;
        float rsv[8];
#pragma unroll
        for (int it = 0; it < 8; ++it) {
            const f32x4* sp = (const f32x4*)(ssq + (size_t)(row0 + (it >> 2) * 128 + (it & 3) * 16) * 16);
            const f32x4 s0 = sp[0], s1 = sp[1], s2 = sp[2], s3 = sp[3];
            const float tot = ((s0.x + s0.y) + (s0.z + s0.w)) + ((s1.x + s1.y) + (s1.z + s1.w)) + ((s2.x + s2.y) + (s2.z + s2.w)) + ((s3.x + s3.y) + (s3.z + s3.w));
            rsv[it] = 1.0f / sqrtf(tot * (1.0f / D) + RMS_EPS);
        }
#pragma unroll
        for (int it = 0; it < 8; ++it) {
            const int ai = it >> 2, m = it & 3, row = row0 + ai * 128 + m * 16; const float rs = rsv[it];
#pragma unroll
            for (int bj = 0; bj < 2; ++bj) {
                const size_t o = (size_t)row * 2048 + col0 + 32 * bj;
                const f32x4 a = acc[ai][bj][m][0] * rs, b = acc[ai][bj][m][1] * rs;
                *(h16x8*)(S + o) = (h16x8){(_Float16)a.x, (_Float16)a.y, (_Float16)a.z, (_Float16)a.w, (_Float16)b.x, (_Float16)b.y, (_Float16)b.z, (_Float16)b.w};
            }
        }
    }
};
struct EpiFinal {
    static constexpr bool AFTER_DRAIN = false;
    float* out; const float* rstd3; const bf16_t* ple; const bf16_t* x2b;
    __device__ __forceinline__ void operator()(const f32x4 (&acc)[2][2][4][2], const Unit& u, int wr, int wc, int fr, int fq) const {
        const int row0 = u.pm * 256 + wr * 64 + fr, col0 = u.pn * 256 + wc * 64 + 8 * fq;
        u32x4 pq[2][2], xq[2][2]; f32x4 qq[2][2];
#define EF_LOAD(buf, it) do { const size_t r_ = (size_t)(row0 + ((it) >> 2) * 128 + ((it) & 3) * 16); \
            pq[buf][0] = *(const u32x4*)(ple + r_ * D + col0); pq[buf][1] = *(const u32x4*)(ple + r_ * D + col0 + 32); \
            xq[buf][0] = *(const u32x4*)(x2b + r_ * D + col0); xq[buf][1] = *(const u32x4*)(x2b + r_ * D + col0 + 32); \
            qq[buf][0] = *(const f32x4*)(rstd3 + r_ * 8); qq[buf][1] = *(const f32x4*)(rstd3 + r_ * 8 + 4); } while (0)
        EF_LOAD(0, 0);
#pragma unroll
        for (int it = 0; it < 8; ++it) {
            const int ai = it >> 2, m = it & 3, row = row0 + ai * 128 + m * 16;
            if (it + 1 < 8) EF_LOAD((it + 1) & 1, it + 1);
            const f32x4 q0 = qq[it & 1][0], q1 = qq[it & 1][1];
            const float rs = 1.0f / sqrtf((((q0.x + q0.y) + (q0.z + q0.w)) + ((q1.x + q1.y) + (q1.z + q1.w))) * (1.0f / D) + RMS_EPS);
#pragma unroll
            for (int bj = 0; bj < 2; ++bj) {
                const size_t o = (size_t)row * D + col0 + 32 * bj;
                const u32x4 p = pq[it & 1][bj], xw = xq[it & 1][bj];
                f32x4 a = (f32x4){bf_lo(xw.x), bf_hi(xw.x), bf_lo(xw.y), bf_hi(xw.y)}, b = (f32x4){bf_lo(xw.z), bf_hi(xw.z), bf_lo(xw.w), bf_hi(xw.w)};
                const f32x4 g0 = acc[ai][bj][m][0] * rs, g1 = acc[ai][bj][m][1] * rs;
                a.x += sigmoidf_(g0.x) * bf_lo(p.x); a.y += sigmoidf_(g0.y) * bf_hi(p.x); a.z += sigmoidf_(g0.z) * bf_lo(p.y); a.w += sigmoidf_(g0.w) * bf_hi(p.y);
                b.x += sigmoidf_(g1.x) * bf_lo(p.z); b.y += sigmoidf_(g1.y) * bf_hi(p.z); b.z += sigmoidf_(g1.z) * bf_lo(p.w); b.w += sigmoidf_(g1.w) * bf_hi(p.w);
                __builtin_nontemporal_store(a, (f32x4*)(out + o)); __builtin_nontemporal_store(b, (f32x4*)(out + o + 4));
            }
            asm volatile("" ::: "memory");
        }
#undef EF_LOAD
    }
};

__device__ __forceinline__ void load_row64(const bf16_t* p, float (&q)[64]) {
#pragma unroll
    for (int i = 0; i < 8; ++i) { const u32x4 w = *(const u32x4*)(p + 8 * i);
        q[8 * i + 0] = bf_lo(w.x); q[8 * i + 1] = bf_hi(w.x); q[8 * i + 2] = bf_lo(w.y); q[8 * i + 3] = bf_hi(w.y); q[8 * i + 4] = bf_lo(w.z); q[8 * i + 5] = bf_hi(w.z); q[8 * i + 6] = bf_lo(w.w); q[8 * i + 7] = bf_hi(w.w); }
}
__device__ __forceinline__ float dot_row64(const bf16_t* p, const float (&q)[64]) {
    float s = 0.f;
#pragma unroll
    for (int i = 0; i < 8; ++i) { const u32x4 w = *(const u32x4*)(p + 8 * i);
        s += q[8 * i + 0] * bf_lo(w.x) + q[8 * i + 1] * bf_hi(w.x) + q[8 * i + 2] * bf_lo(w.y) + q[8 * i + 3] * bf_hi(w.y) + q[8 * i + 4] * bf_lo(w.z) + q[8 * i + 5] * bf_hi(w.z) + q[8 * i + 6] * bf_lo(w.w) + q[8 * i + 7] * bf_hi(w.w); }
    return s;
}
__device__ __forceinline__ void phase_attention_ref(const Ctx& C) {
    const Args& A = *C.a; unsigned char* ws = A.ws; CTX_LANES();
    const int gw = C.vcu * 8 + wave, NGW = C.G * 8;
    const bf16_t* qna = (const bf16_t*)(ws + WS_QNA); const bf16_t* kna = (const bf16_t*)(ws + WS_KNA); const bf16_t* vna = (const bf16_t*)(ws + WS_VNA);
    const float* rpb = A.in[I_RPB];
    bf16_t* outna = (bf16_t*)(ws + WS_OUTNA);
    for (int it = gw; it < BATCH * NA_H * SEQ; it += NGW) {
        const int c = it & 63, r = (it >> 6) & 63, h = (it >> 12) & 7, b = it >> 15;
        const int rs = min(max(r - 4, 0), 56), cs = min(max(c - 8, 0), 48);
        const size_t hb = (size_t)(b * NA_H + h) * SEQ;
        float q[64]; load_row64(qna + (hb + r * 64 + c) * HD, q);
        float sc[2];
#pragma unroll
        for (int t = 0; t < 2; ++t) { const int kr = rs + (lane >> 4) + 4 * t, kc = cs + (lane & 15);
            const float s = dot_row64(kna + (hb + kr * 64 + kc) * HD, q);
            const float bias = rpb[(h * 15 + (kr - r + 7)) * 31 + (kc - c + 15)];
            sc[t] = s + bias * LOG2E; }
        const float mx = wave_max(fmaxf(sc[0], sc[1]));
        const float p0 = __builtin_amdgcn_exp2f(sc[0] - mx), p1 = __builtin_amdgcn_exp2f(sc[1] - mx);
        const float l = wave_sum(p0 + p1);
        float o = 0.f;
        for (int kk = 0; kk < 128; ++kk) { const int src = kk & 63; const float p = __shfl(kk < 64 ? p0 : p1, src);
            const int kr = rs + (src >> 4) + 4 * (kk >> 6), kc = cs + (src & 15);
            o += p * bf2f(vna[(hb + kr * 64 + kc) * HD + lane]); }
        outna[(size_t)(b * SEQ + r * 64 + c) * 512 + h * 64 + lane] = (bf16_t)f2bf(o / l);
    }
    const bf16_t* qd = (const bf16_t*)(ws + WS_QDIL); const bf16_t* kd = (const bf16_t*)(ws + WS_KDIL); const bf16_t* vd = (const bf16_t*)(ws + WS_VDIL);
    bf16_t* og = (bf16_t*)((unsigned char*)A.out + DO_OG); float* lse = (float*)(ws + WS_LSE);
    for (int it = gw; it < BATCH * DIL_H * SEQ; it += NGW) {
        const int sp = it & 4095, bh = it >> 12, hh = bh & 3, g = (bh >> 2) % 3, b = bh / 12;
        const int sh = 2 * g, L = SEQ >> sh, res = sp / L, mq = sp % L;
        const size_t hb = (size_t)bh * SEQ + (size_t)res * L;
        float q[64]; load_row64(qd + (hb + mq) * HD, q);
        float sc[3];
#pragma unroll
        for (int t = 0; t < 3; ++t) { const int kk = lane + 64 * t, mk = mq - 64 + kk; const bool ok = (kk <= 128) && (mk >= 0) && (mk < L);
            const int mc = min(max(mk, 0), L - 1);
            const float s = dot_row64(kd + (hb + mc) * HD, q);
            sc[t] = ok ? s : -INFINITY; }
        const float mx = wave_max(fmaxf(fmaxf(sc[0], sc[1]), sc[2]));
        float p[3];
#pragma unroll
        for (int t = 0; t < 3; ++t) p[t] = __builtin_amdgcn_exp2f(sc[t] - mx);
        const float l = wave_sum(p[0] + p[1] + p[2]);
        float o = 0.f;
        for (int kk = 0; kk <= 128; ++kk) { const int src = kk & 63; const float pv = __shfl(kk < 64 ? p[0] : (kk < 128 ? p[1] : p[2]), src);
            const int mc = min(max(mq - 64 + kk, 0), L - 1);
            o += pv * bf2f(vd[(hb + mc) * HD + lane]); }
        const int s = mq * (1 << sh) + res;
        const size_t tok = (size_t)b * SEQ + s;
        og[((size_t)g * T + tok) * 256 + hh * 64 + lane] = (bf16_t)f2bf(o / l);
        if (lane == 0) lse[((size_t)g * T + tok) * 4 + hh] = mx + __builtin_amdgcn_logf(l);
    }
}


typedef short s16x4 __attribute__((ext_vector_type(4)));
__device__ __forceinline__ void glds16(const void* g, LAS unsigned char* l) { __builtin_amdgcn_global_load_lds((const unsigned*)g, (LAS unsigned*)l, 16, 0, 0); }
__device__ __forceinline__ bf16x8 tr_pair(LAS unsigned char* p) {
    const s16x4 lo = __builtin_amdgcn_ds_read_tr16_b64_v4i16((LAS s16x4*)p), hi = __builtin_amdgcn_ds_read_tr16_b64_v4i16((LAS s16x4*)(p + 16 * 128));
    return __builtin_shufflevector(lo, hi, 0, 1, 2, 3, 4, 5, 6, 7);
}
__device__ __forceinline__ bf16x8 pack_p(const f32x4& a, const f32x4& b) {
    u32x4 w; w.x = cvt_pk_bf16(a.x, a.y); w.y = cvt_pk_bf16(a.z, a.w); w.z = cvt_pk_bf16(b.x, b.y); w.w = cvt_pk_bf16(b.z, b.w);
    return __builtin_bit_cast(bf16x8, w);
}
constexpr int DIL_KB = 32768, DIL_VB = 34816, DIL_BUF = DIL_KB + DIL_VB;
constexpr int NA_TILE = 15 * 32 * 128, NA_BIAS_OFF = 2 * NA_TILE;

struct DilUnit { int bh, g, sh, L, res, M0; };
__device__ __forceinline__ DilUnit dil_unit(int u) { DilUnit d; d.bh = u >> 5; d.g = (d.bh >> 2) % 3; d.sh = 2 * d.g; d.L = SEQ >> d.sh; const int sp0 = (u & 31) * 128; d.res = sp0 >> (12 - d.sh); d.M0 = sp0 & (d.L - 1); return d; }

__device__ __forceinline__ void phase_attention(const Ctx& C) {
    const Args& A = *C.a; unsigned char* ws = A.ws; CTX_LANES();
    const int i16 = lane & 15, g4 = lane >> 4;
    LAS unsigned char* lds = C.lds;
    const int kaddr0 = i16 * 128 + ((g4 ^ (i16 & 7)) * 16), kaddr1 = i16 * 128 + (((g4 + 4) ^ (i16 & 7)) * 16);
    int vaddr[4];
#pragma unroll
    for (int n = 0; n < 4; ++n) vaddr[n] = (4 * g4 + (i16 >> 2)) * 128 + ((n ^ (2 * (g4 & 1) + (i16 >> 3))) * 32) + (i16 & 3) * 8;
    const int lrow = lane >> 3, cpos = lane & 7;

    {
        const bf16_t* qna = (const bf16_t*)(ws + WS_QNA); const bf16_t* kna = (const bf16_t*)(ws + WS_KNA); const bf16_t* vna = (const bf16_t*)(ws + WS_VNA);
        const float* rpb = A.in[I_RPB]; bf16_t* outna = (bf16_t*)(ws + WS_OUTNA);
        LAS float* bt = (LAS float*)(lds + NA_BIAS_OFF);
        for (int u = C.vcu; u < BATCH * NA_H * 4 * 8; u += C.G) {
            const int R = u & 7, j = (u >> 3) & 3, h = (u >> 5) & 7, b = u >> 8;
            const int lo = min(max(8 * R - 4, 0), 49), kc0 = min(max(16 * j - 8, 0), 32);
            const size_t hb = (size_t)(b * NA_H + h) * SEQ;
#pragma unroll
            for (int i = 0; i < 8; ++i) { const int inst = wave + 8 * i;
                if (inst < 60) { const size_t tok = hb + (size_t)(lo + (inst >> 2)) * 64 + kc0 + 8 * (inst & 3) + lrow;
                    glds16(kna + tok * HD + ((cpos ^ lrow) * 8), lds + inst * 1024);
                    glds16(vna + tok * HD + ((cpos ^ (2 * ((lrow >> 1) & 3))) * 8), lds + NA_TILE + inst * 1024); } }
            if (tid_ < 15 * 32) { const int dr = tid_ >> 5, dc = tid_ & 31; bt[8 + tid_] = (dc < 31) ? rpb[(h * 15 + dr) * 31 + dc] * LOG2E : 0.f; }
            const int r = 8 * R + wave, rs = min(max(r - 4, 0), 56), roff = rs - lo, c = 16 * j + i16, cs = min(max(c - 8, 0), 48);
            bf16x8 qf0, qf1;
            { const bf16_t* qp = qna + (hb + r * 64 + c) * HD + 8 * g4; qf0 = *(const bf16x8*)qp; qf1 = *(const bf16x8*)(qp + 32); }
            asm volatile("s_waitcnt vmcnt(0) lgkmcnt(0)" ::: "memory");
            __syncthreads();
            f32x4 s[16];
            LAS unsigned char* kb = lds + roff * 32 * 128;
#pragma unroll
            for (int hf = 0; hf < 2; ++hf) {
                bf16x8 kf[8][2];
#pragma unroll
                for (int tt = 0; tt < 8; ++tt) { const int t = 8 * hf + tt, koff = ((t >> 1) * 32 + 16 * (t & 1)) * 128; kf[tt][0] = *(const LAS bf16x8*)(kb + koff + kaddr0); kf[tt][1] = *(const LAS bf16x8*)(kb + koff + kaddr1); }
#pragma unroll
                for (int tt = 0; tt < 8; ++tt) { f32x4 acc = (f32x4){0.f, 0.f, 0.f, 0.f};
                    acc = __builtin_amdgcn_mfma_f32_16x16x32_bf16(kf[tt][0], qf0, acc, 0, 0, 0);
                    acc = __builtin_amdgcn_mfma_f32_16x16x32_bf16(kf[tt][1], qf1, acc, 0, 0, 0);
                    s[8 * hf + tt] = acc; }
            }
            const int kcl0 = kc0 + 4 * g4 - cs;
            const LAS float* bp = bt + 8 + (rs - r + 7) * 32 + (kc0 + 4 * g4 - c + 15);
            float mx = -INFINITY;
#pragma unroll
            for (int t = 0; t < 16; ++t)
#pragma unroll
                for (int e = 0; e < 4; ++e) { const int rel = kcl0 + 16 * (t & 1) + e; const bool ok = (rel >= 0) && (rel < 16);
                    const float v = s[t][e] + bp[(t >> 1) * 32 + 16 * (t & 1) + e];
                    s[t][e] = ok ? v : -INFINITY; mx = fmaxf(mx, s[t][e]); }
            mx = max_x16_x32(mx);
            float l = 0.f;
#pragma unroll
            for (int t = 0; t < 16; ++t)
#pragma unroll
                for (int e = 0; e < 4; ++e) { s[t][e] = __builtin_amdgcn_exp2f(s[t][e] - mx); l += s[t][e]; }
            l = sum_x16_x32(l);
            f32x4 o[4];
#pragma unroll
            for (int n = 0; n < 4; ++n) o[n] = (f32x4){0.f, 0.f, 0.f, 0.f};
            LAS unsigned char* vb = lds + NA_TILE + roff * 32 * 128;
            {
                bf16x8 va[4], vn[4];
#pragma unroll
                for (int n = 0; n < 4; ++n) va[n] = tr_pair(vb + vaddr[n]);
#pragma unroll
                for (int ks = 0; ks < 8; ++ks) {
                    if (ks + 1 < 8) {
#pragma unroll
                        for (int n = 0; n < 4; ++n) vn[n] = tr_pair(vb + (ks + 1) * 32 * 128 + vaddr[n]); }
                    const bf16x8 pf = pack_p(s[2 * ks], s[2 * ks + 1]);
#pragma unroll
                    for (int n = 0; n < 4; ++n) o[n] = __builtin_amdgcn_mfma_f32_16x16x32_bf16(va[n], pf, o[n], 0, 0, 0);
#pragma unroll
                    for (int n = 0; n < 4; ++n) va[n] = vn[n];
                }
            }
            const float inv = 1.0f / l;
            unsigned char* op = (unsigned char*)outna + ((size_t)b * SEQ + r * 64 + c) * ACAT + h * 64 + 4 * g4;
            const float inv8 = inv * A8_SCALE;
#pragma unroll
            for (int n = 0; n < 4; ++n) *(unsigned*)(op + 16 * n) = pk4_fp8(o[n].x * inv8, o[n].y * inv8, o[n].z * inv8, o[n].w * inv8);
            __syncthreads();
        }
    }
    {
        const bf16_t* qd = (const bf16_t*)(ws + WS_QDIL); const bf16_t* kd = (const bf16_t*)(ws + WS_KDIL); const bf16_t* vd = (const bf16_t*)(ws + WS_VDIL);
        bf16_t* og = (bf16_t*)((unsigned char*)A.out + DO_OG); float* lse = (float*)(ws + WS_LSE);
        constexpr int NU = BATCH * DIL_H * 32;
        bf16x8 qn0, qn1;
        auto issue = [&](int u, int buf) {
            const DilUnit d = dil_unit(u);
            const size_t sb = (size_t)d.bh * SEQ + (size_t)d.res * d.L;
            LAS unsigned char* kb = lds + buf * DIL_BUF; LAS unsigned char* vb = kb + DIL_KB;
#pragma unroll
            for (int i = 0; i < 4; ++i) { const int inst = wave * 4 + i, row = inst * 8 + lrow; const int mp = min(max(d.M0 - 64 + row, 0), d.L - 1);
                glds16(kd + (sb + mp) * HD + ((cpos ^ lrow) * 8), kb + inst * 1024);
                glds16(vd + (sb + mp) * HD + ((cpos ^ (2 * ((lrow >> 1) & 3))) * 8), vb + inst * 1024); }
            if (wave < 2) { const int inst = 32 + wave, row = inst * 8 + lrow; const int mp = min(max(d.M0 - 64 + row, 0), d.L - 1);
                glds16(vd + (sb + mp) * HD + ((cpos ^ (2 * ((lrow >> 1) & 3))) * 8), vb + inst * 1024); }
            const bf16_t* qp = qd + (sb + d.M0 + 16 * wave + i16) * HD + 8 * g4; qn0 = *(const bf16x8*)qp; qn1 = *(const bf16x8*)(qp + 32);
        };
        int u = C.vcu, it = 0;
        if (u < NU) issue(u, 0);
        for (; u < NU; u += C.G, ++it) {
            const int buf = it & 1;
            asm volatile("s_waitcnt vmcnt(0)" ::: "memory");
            asm volatile("s_waitcnt lgkmcnt(0)" ::: "memory"); __builtin_amdgcn_s_barrier(); asm volatile("" ::: "memory");
            const bf16x8 qf0 = qn0, qf1 = qn1;
            if (u + C.G < NU) issue(u + C.G, buf ^ 1);
            const DilUnit d = dil_unit(u);
            LAS unsigned char* kb = lds + buf * DIL_BUF + wave * 16 * 128; LAS unsigned char* vb = lds + buf * DIL_BUF + DIL_KB + wave * 16 * 128;
            f32x4 s[10];
            {   bf16x8 kf[9][2];
#pragma unroll
                for (int t = 0; t < 9; ++t) { kf[t][0] = *(const LAS bf16x8*)(kb + t * 16 * 128 + kaddr0); kf[t][1] = *(const LAS bf16x8*)(kb + t * 16 * 128 + kaddr1); }
#pragma unroll
                for (int t = 0; t < 9; ++t) { f32x4 acc = (f32x4){0.f, 0.f, 0.f, 0.f};
                    acc = __builtin_amdgcn_mfma_f32_16x16x32_bf16(kf[t][0], qf0, acc, 0, 0, 0);
                    acc = __builtin_amdgcn_mfma_f32_16x16x32_bf16(kf[t][1], qf1, acc, 0, 0, 0);
                    s[t] = acc; }
            }
            s[9] = (f32x4){0.f, 0.f, 0.f, 0.f};
            const int mlo = d.M0 + 16 * wave - 64;
            float mx = -INFINITY;
#pragma unroll
            for (int t = 0; t < 9; ++t)
#pragma unroll
                for (int e = 0; e < 4; ++e) { const int kk = 16 * t + 4 * g4 + e, mk = mlo + kk; const bool ok = (kk >= i16) && (kk <= i16 + 128) && (mk >= 0) && (mk < d.L);
                    s[t][e] = ok ? s[t][e] : -INFINITY; mx = fmaxf(mx, s[t][e]); }
            mx = max_x16_x32(mx);
            float l = 0.f;
#pragma unroll
            for (int t = 0; t < 9; ++t)
#pragma unroll
                for (int e = 0; e < 4; ++e) { s[t][e] = __builtin_amdgcn_exp2f(s[t][e] - mx); l += s[t][e]; }
            l = sum_x16_x32(l);
            f32x4 o[4];
#pragma unroll
            for (int n = 0; n < 4; ++n) o[n] = (f32x4){0.f, 0.f, 0.f, 0.f};
            {   bf16x8 va[4], vn[4];
#pragma unroll
                for (int n = 0; n < 4; ++n) va[n] = tr_pair(vb + vaddr[n]);
#pragma unroll
                for (int ks = 0; ks < 5; ++ks) {
                    if (ks + 1 < 5) {
#pragma unroll
                        for (int n = 0; n < 4; ++n) vn[n] = tr_pair(vb + (ks + 1) * 32 * 128 + vaddr[n]); }
                    const bf16x8 pf = pack_p(s[2 * ks], s[2 * ks + 1]);
#pragma unroll
                    for (int n = 0; n < 4; ++n) o[n] = __builtin_amdgcn_mfma_f32_16x16x32_bf16(va[n], pf, o[n], 0, 0, 0);
#pragma unroll
                    for (int n = 0; n < 4; ++n) va[n] = vn[n];
                }
            }
            const float inv = 1.0f / l;
            const int m = d.M0 + 16 * wave + i16, b = d.bh / 12, hh = d.bh & 3;
            const size_t tok = (size_t)b * SEQ + ((size_t)m << d.sh) + d.res;
            bf16_t* op = og + ((size_t)d.g * T + tok) * 256 + hh * 64 + 4 * g4;
#pragma unroll
            for (int n = 0; n < 4; ++n) *(u32x2*)(op + 16 * n) = (u32x2){cvt_pk_bf16(o[n].x * inv, o[n].y * inv), cvt_pk_bf16(o[n].z * inv, o[n].w * inv)};
            if (g4 == 0) lse[((size_t)d.g * T + tok) * 4 + hh] = mx + __builtin_amdgcn_logf(l);
        }
        asm volatile("s_waitcnt vmcnt(0)" ::: "memory");
        __syncthreads();
    }
}

__device__ __forceinline__ void phase_dil_combine(const Ctx& C) {
    const Args& A = *C.a; unsigned char* ws = A.ws;
    const bf16_t* og = (const bf16_t*)((unsigned char*)A.out + DO_OG); const float* lse = (const float*)(ws + WS_LSE);
    unsigned char* od = ws + WS_OUTNA + 512; CTX_LANES();
    const size_t gt = (size_t)(C.vcu * 512 + tid_), NT = (size_t)C.G * 512;
    for (size_t i = gt; i < (size_t)T * 32; i += NT) {
        const size_t tok = i >> 5; const int ch = (int)(i & 31), hh = ch >> 3;
        const float l0 = lse[(0 * (size_t)T + tok) * 4 + hh], l1 = lse[(1 * (size_t)T + tok) * 4 + hh], l2 = lse[(2 * (size_t)T + tok) * 4 + hh];
        const float mx = fmaxf(l0, fmaxf(l1, l2));
        float w0 = __builtin_amdgcn_exp2f(l0 - mx), w1 = __builtin_amdgcn_exp2f(l1 - mx), w2 = __builtin_amdgcn_exp2f(l2 - mx);
        const float inv = 1.0f / (w0 + w1 + w2); w0 *= inv; w1 *= inv; w2 *= inv;
        const u32x4 a = *(const u32x4*)(og + (0 * (size_t)T + tok) * 256 + ch * 8), b = *(const u32x4*)(og + (1 * (size_t)T + tok) * 256 + ch * 8), c = *(const u32x4*)(og + (2 * (size_t)T + tok) * 256 + ch * 8);
        w0 *= A8_SCALE; w1 *= A8_SCALE; w2 *= A8_SCALE;
        u32x2 o;
        o.x = pk4_fp8(w0 * bf_lo(a.x) + w1 * bf_lo(b.x) + w2 * bf_lo(c.x), w0 * bf_hi(a.x) + w1 * bf_hi(b.x) + w2 * bf_hi(c.x), w0 * bf_lo(a.y) + w1 * bf_lo(b.y) + w2 * bf_lo(c.y), w0 * bf_hi(a.y) + w1 * bf_hi(b.y) + w2 * bf_hi(c.y));
        o.y = pk4_fp8(w0 * bf_lo(a.z) + w1 * bf_lo(b.z) + w2 * bf_lo(c.z), w0 * bf_hi(a.z) + w1 * bf_hi(b.z) + w2 * bf_hi(c.z), w0 * bf_lo(a.w) + w1 * bf_lo(b.w) + w2 * bf_lo(c.w), w0 * bf_hi(a.w) + w1 * bf_hi(b.w) + w2 * bf_hi(c.w));
        *(u32x2*)(od + tok * ACAT + ch * 8) = o;
    }
}

__device__ __forceinline__ void ins16(float (&a)[16], float x) {
    float prev = a[0]; a[0] = fmaxf(prev, x);
#pragma unroll
    for (int i = 1; i < 16; ++i) { const float cur = a[i]; a[i] = __builtin_amdgcn_fmed3f(prev, cur, x); prev = cur; }
}
struct EpiScoresTopk {
    static constexpr bool AFTER_DRAIN = true;
    const float* ssq; unsigned short* ridx; float* rg;
    __device__ __forceinline__ void fused(const f32x4 (&acc)[2][2][4][2], const Unit& u, int wr, int wc, int fr, int fq, PG8_LAS unsigned char* lds) const {
        constexpr int SROW = 528;
        const int tid = opaque_tid();
        {
            const int row0l = wr * 64 + fr, colb = (wc * 64 + 8 * fq) * 2;
#pragma unroll
            for (int it = 0; it < 8; ++it) {
                const int ai = it >> 2, m = it & 3, rl = row0l + ai * 128 + m * 16;
                const f32x4* sp = (const f32x4*)(ssq + (size_t)(u.pm * 256 + rl) * 16);
                const f32x4 s0 = sp[0], s1 = sp[1], s2 = sp[2], s3 = sp[3];
                const float tot = ((s0.x + s0.y) + (s0.z + s0.w)) + ((s1.x + s1.y) + (s1.z + s1.w)) + ((s2.x + s2.y) + (s2.z + s2.w)) + ((s3.x + s3.y) + (s3.z + s3.w));
                const float rs = 1.0f / sqrtf(tot * (1.0f / D) + RMS_EPS);
#pragma unroll
                for (int bj = 0; bj < 2; ++bj) {
                    const f32x4 a = acc[ai][bj][m][0] * rs, b = acc[ai][bj][m][1] * rs;
                    *(PG8_LAS h16x8*)(lds + rl * SROW + colb + 64 * bj) = (h16x8){(_Float16)a.x, (_Float16)a.y, (_Float16)a.z, (_Float16)a.w, (_Float16)b.x, (_Float16)b.y, (_Float16)b.z, (_Float16)b.w};
                }
            }
        }
        __syncthreads();
        const int row = tid & 255, side = tid >> 8;
        float a1[16];
#pragma unroll
        for (int i = 0; i < 16; ++i) a1[i] = -1e30f;
#pragma unroll
        for (int i = 0; i < 16; ++i) { const h16x8 v = *(const PG8_LAS h16x8*)(lds + row * SROW + side * 256 + i * 16);
#pragma unroll
            for (int j = 0; j < 8; ++j) ins16(a1, __builtin_bit_cast(float, (__builtin_bit_cast(unsigned, (float)v[j]) & ~0x7Fu) | (unsigned)(i * 8 + j))); }
        __syncthreads();
        PG8_LAS float* lst = (PG8_LAS float*)(lds + tid * 80);
#pragma unroll
        for (int i = 0; i < 4; ++i) *(PG8_LAS f32x4*)(lst + 4 * i) = (f32x4){a1[4 * i], a1[4 * i + 1], a1[4 * i + 2], a1[4 * i + 3]};
        __syncthreads();
        if (side == 0) {
            float a2[16];
            const PG8_LAS float* pl = (const PG8_LAS float*)(lds + (tid + 256) * 80);
#pragma unroll
            for (int i = 0; i < 4; ++i) { const f32x4 q = *(const PG8_LAS f32x4*)(pl + 4 * i); a2[4 * i] = q.x; a2[4 * i + 1] = q.y; a2[4 * i + 2] = q.z; a2[4 * i + 3] = q.w; }
            PG8_LAS unsigned char* ib = lds + 512 * 80 + tid * 32;
            float v1[16], v2[16];
#pragma unroll
            for (int i = 0; i < 16; ++i) { const unsigned b1 = __builtin_bit_cast(unsigned, a1[i]), b2 = __builtin_bit_cast(unsigned, a2[i]);
                v1[i] = __builtin_bit_cast(float, b1 & ~0x7Fu); v2[i] = __builtin_bit_cast(float, b2 & ~0x7Fu);
                ib[i] = (unsigned char)(b1 & 0x7Fu); ib[16 + i] = (unsigned char)(b2 & 0x7Fu); }
            float cc[16];
#pragma unroll
            for (int i = 0; i < 16; ++i) cc[i] = -1e30f;
#pragma unroll
            for (int i = 0; i < 16; ++i)
#pragma unroll
                for (int j = 0; j < 16; ++j)
                    if ((i + 1) * (j + 1) <= 16) { const float s = v1[i] + v2[j]; ins16(cc, __builtin_bit_cast(float, (__builtin_bit_cast(unsigned, s) & ~0xFFu) | (unsigned)(i * 16 + j))); }
            asm volatile("s_waitcnt lgkmcnt(0)" ::: "memory");
            float sv[16]; int ei[16]; float mx = -1e30f;
#pragma unroll
            for (int k = 0; k < 16; ++k) { const unsigned b = __builtin_bit_cast(unsigned, cc[k]); sv[k] = __builtin_bit_cast(float, b & ~0xFFu); const int i = (b >> 4) & 15, j = b & 15;
                const int i1 = ib[i], i2 = ib[16 + j]; ei[k] = i1 * 128 + i2; mx = fmaxf(mx, sv[k]); }
            float sum = 0.f;
#pragma unroll
            for (int k = 0; k < 16; ++k) { sv[k] = __expf(sv[k] - mx); sum += sv[k]; }
            const float inv = 1.0f / sum;
            const size_t ob = (size_t)(u.pm * 256 + row) * 128 + (size_t)u.pn * 16;
#pragma unroll
            for (int k = 0; k < 4; ++k) { *(f32x4*)(rg + ob + 4 * k) = (f32x4){sv[4 * k] * inv, sv[4 * k + 1] * inv, sv[4 * k + 2] * inv, sv[4 * k + 3] * inv};
                *(u32x2*)(ridx + ob + 4 * k) = (u32x2){(unsigned)ei[4 * k] | ((unsigned)ei[4 * k + 1] << 16), (unsigned)ei[4 * k + 2] | ((unsigned)ei[4 * k + 3] << 16)}; }
        }
        asm volatile("s_waitcnt lgkmcnt(0)" ::: "memory");
        __syncthreads();
    }
};
__device__ __forceinline__ void phase_topk(const Ctx& C) {
    const Args& A = *C.a; unsigned char* ws = A.ws; CTX_LANES();
    const _Float16* S = (const _Float16*)(ws + WS_SCORES); unsigned short* ridx = (unsigned short*)(ws + WS_RIDX); float* rg = (float*)(ws + WS_RG);
    LAS unsigned char* scr = C.lds + wave * 9216;
    const int gw = C.vcu * 8 + wave, NGW = C.G * 8;
    for (int it = gw; it < T / 8; it += NGW) {
        const _Float16* base = S + (size_t)it * 8 * 2048;
        float a1[16], a2[16];
#pragma unroll
        for (int i = 0; i < 16; ++i) { a1[i] = -1e30f; a2[i] = -1e30f; }
#pragma unroll 1
        for (int c = 0; c < 4; ++c) {
#pragma unroll
            for (int i = 0; i < 8; ++i) { const int q = i * 64 + lane, task = q >> 3, part = q & 7;
                *(LAS u32x4*)(scr + task * 144 + part * 16) = *(const u32x4*)(base + (size_t)task * 256 + c * 64 + part * 8); }
            asm volatile("s_waitcnt vmcnt(0) lgkmcnt(0)" ::: "memory");
            if (c < 2) {
#pragma unroll
                for (int i = 0; i < 8; ++i) { const h16x8 v = *(const LAS h16x8*)(scr + lane * 144 + i * 16);
#pragma unroll
                    for (int j = 0; j < 8; ++j) { const unsigned id = (unsigned)(c * 64 + i * 8 + j); ins16(a1, __builtin_bit_cast(float, (__builtin_bit_cast(unsigned, (float)v[j]) & ~0x7Fu) | id)); } }
            } else {
#pragma unroll
                for (int i = 0; i < 8; ++i) { const h16x8 v = *(const LAS h16x8*)(scr + lane * 144 + i * 16);
#pragma unroll
                    for (int j = 0; j < 8; ++j) { const unsigned id = (unsigned)((c - 2) * 64 + i * 8 + j); ins16(a2, __builtin_bit_cast(float, (__builtin_bit_cast(unsigned, (float)v[j]) & ~0x7Fu) | id)); } }
            }
            asm volatile("s_waitcnt lgkmcnt(0)" ::: "memory");
        }
        float v1[16], v2[16];
#pragma unroll
        for (int i = 0; i < 16; ++i) { const unsigned b1 = __builtin_bit_cast(unsigned, a1[i]), b2 = __builtin_bit_cast(unsigned, a2[i]);
            v1[i] = __builtin_bit_cast(float, b1 & ~0x7Fu); v2[i] = __builtin_bit_cast(float, b2 & ~0x7Fu);
            *(LAS unsigned char*)(scr + lane * 144 + i) = (unsigned char)(b1 & 0x7Fu); *(LAS unsigned char*)(scr + lane * 144 + 16 + i) = (unsigned char)(b2 & 0x7Fu); }
        float cc[16];
#pragma unroll
        for (int i = 0; i < 16; ++i) cc[i] = -1e30f;
#pragma unroll
        for (int i = 0; i < 16; ++i)
#pragma unroll
            for (int j = 0; j < 16; ++j)
                if ((i + 1) * (j + 1) <= 16) { const float s = v1[i] + v2[j]; ins16(cc, __builtin_bit_cast(float, (__builtin_bit_cast(unsigned, s) & ~0xFFu) | (unsigned)(i * 16 + j))); }
        asm volatile("s_waitcnt lgkmcnt(0)" ::: "memory");
        float sv[16]; int ei[16]; float mx = -1e30f;
#pragma unroll
        for (int k = 0; k < 16; ++k) { const unsigned b = __builtin_bit_cast(unsigned, cc[k]); sv[k] = __builtin_bit_cast(float, b & ~0xFFu); const int i = (b >> 4) & 15, j = b & 15;
            const int i1 = *(const LAS unsigned char*)(scr + lane * 144 + i), i2 = *(const LAS unsigned char*)(scr + lane * 144 + 16 + j);
            ei[k] = i1 * 128 + i2; mx = fmaxf(mx, sv[k]); }
        float sum = 0.f;
#pragma unroll
        for (int k = 0; k < 16; ++k) { sv[k] = __expf(sv[k] - mx); sum += sv[k]; }
        const float inv = 1.0f / sum;
        const size_t ob = (size_t)it * 8 * 128 + (size_t)lane * 16;
#pragma unroll
        for (int k = 0; k < 4; ++k) { *(f32x4*)(rg + ob + 4 * k) = (f32x4){sv[4 * k] * inv, sv[4 * k + 1] * inv, sv[4 * k + 2] * inv, sv[4 * k + 3] * inv};
            *(u32x2*)(ridx + ob + 4 * k) = (u32x2){(unsigned)ei[4 * k] | ((unsigned)ei[4 * k + 1] << 16), (unsigned)ei[4 * k + 2] | ((unsigned)ei[4 * k + 3] << 16)}; }
        asm volatile("s_waitcnt lgkmcnt(0)" ::: "memory");
    }
}
__device__ __forceinline__ void phase_hq(const Ctx& C) {
    const Args& A = *C.a; unsigned char* ws = A.ws; CTX_LANES();
    const int gw = C.vcu * 8 + wave, NGW = C.G * 8;
    {
        const bf16_t* x1 = (const bf16_t*)(ws + WS_X1B); const float* gf = A.in[I_NORM_FFN]; unsigned char* hq = ws + WS_HQ; float* hs = (float*)(ws + WS_HS);
        f32x4 gv[4];
#pragma unroll
        for (int j = 0; j < 4; ++j) gv[j] = *(const f32x4*)(gf + 16 * lane + 4 * j);
        for (int tok0 = gw * 4; tok0 < T; tok0 += NGW * 4) {
            u32x2 xw[4][4];
#pragma unroll
            for (int r = 0; r < 4; ++r)
#pragma unroll
                for (int j = 0; j < 4; ++j) xw[r][j] = *(const u32x2*)(x1 + (size_t)(tok0 + r) * D + 16 * lane + 4 * j);
#pragma unroll
            for (int r = 0; r < 4; ++r) { const int tok = tok0 + r;
                f32x4 h[4]; float am = 0.f;
#pragma unroll
                for (int j = 0; j < 4; ++j) { h[j] = (f32x4){bf_lo(xw[r][j].x), bf_hi(xw[r][j].x), bf_lo(xw[r][j].y), bf_hi(xw[r][j].y)} * gv[j]; am = fmaxf(am, fmaxf(fmaxf(fabsf(h[j].x), fabsf(h[j].y)), fmaxf(fabsf(h[j].z), fabsf(h[j].w)))); }
                am = fmaxf(am, dppc<0xB1>(am)); am = fmaxf(am, dppc<0x4E>(am)); am = fmaxf(am, dppc<0x141>(am));
                const float inv = am > 0.f ? 127.0f / am : 0.f;
                unsigned w[4];
#pragma unroll
                for (int j = 0; j < 4; ++j) { const int q0 = (int)__builtin_rintf(h[j].x * inv), q1 = (int)__builtin_rintf(h[j].y * inv), q2 = (int)__builtin_rintf(h[j].z * inv), q3 = (int)__builtin_rintf(h[j].w * inv);
                    w[j] = ((unsigned)q0 & 0xffu) | (((unsigned)q1 & 0xffu) << 8) | (((unsigned)q2 & 0xffu) << 16) | ((unsigned)q3 << 24); }
                *(u32x4*)(hq + (size_t)tok * D + 16 * lane) = (u32x4){w[0], w[1], w[2], w[3]};
                if ((lane & 7) == 0) hs[(size_t)tok * 8 + (lane >> 3)] = am * (1.0f / 127.0f); }
        }
    }
}

__device__ __forceinline__ float ub0(unsigned w) { return (float)(w & 0xffu); }
__device__ __forceinline__ float ub1(unsigned w) { return (float)((w >> 8) & 0xffu); }
__device__ __forceinline__ float ub2(unsigned w) { return (float)((w >> 16) & 0xffu); }
__device__ __forceinline__ float ub3(unsigned w) { return (float)(w >> 24); }
__device__ __forceinline__ float dot16(const u32x4& r, const f32x4 (&h)[4], float acc) {
    f32x2 a = (f32x2){acc, 0.f};
    a += (f32x2){ub0(r.x), ub1(r.x)} * (f32x2){h[0].x, h[0].y}; a += (f32x2){ub2(r.x), ub3(r.x)} * (f32x2){h[0].z, h[0].w};
    a += (f32x2){ub0(r.y), ub1(r.y)} * (f32x2){h[1].x, h[1].y}; a += (f32x2){ub2(r.y), ub3(r.y)} * (f32x2){h[1].z, h[1].w};
    a += (f32x2){ub0(r.z), ub1(r.z)} * (f32x2){h[2].x, h[2].y}; a += (f32x2){ub2(r.z), ub3(r.z)} * (f32x2){h[2].z, h[2].w};
    a += (f32x2){ub0(r.w), ub1(r.w)} * (f32x2){h[3].x, h[3].y}; a += (f32x2){ub2(r.w), ub3(r.w)} * (f32x2){h[3].z, h[3].w};
    return a.x + a.y;
}
__device__ __forceinline__ void axpy16(const u32x4& r, float c, f32x4 (&o)[4]) {
    o[0].x += c * ub0(r.x); o[0].y += c * ub1(r.x); o[0].z += c * ub2(r.x); o[0].w += c * ub3(r.x);
    o[1].x += c * ub0(r.y); o[1].y += c * ub1(r.y); o[1].z += c * ub2(r.y); o[1].w += c * ub3(r.y);
    o[2].x += c * ub0(r.z); o[2].y += c * ub1(r.z); o[2].z += c * ub2(r.z); o[2].w += c * ub3(r.z);
    o[3].x += c * ub0(r.w); o[3].y += c * ub1(r.w); o[3].z += c * ub2(r.w); o[3].w += c * ub3(r.w);
}
__device__ __forceinline__ float reduce8_safe(const float (&p)[8], int lane) {
    float t = 0.f;
#pragma unroll
    for (int r = 0; r < 8; ++r) { const float s = wave_sum(p[r]); t = ((lane & 7) == r) ? s : t; }
    return t;
}
__device__ __forceinline__ float reduce8(const float (&p)[8], int lane) {
    const bool u4 = (lane & 4) != 0, u2 = (lane & 2) != 0, u1 = (lane & 1) != 0;
    float q[4];
#pragma unroll
    for (int r = 0; r < 4; ++r) { const float keep = u4 ? p[r + 4] : p[r], send = u4 ? p[r] : p[r + 4]; q[r] = keep + dppc<0x141>(send); }
    float s[2];
#pragma unroll
    for (int r = 0; r < 2; ++r) { const float keep = u2 ? q[r + 2] : q[r], send = u2 ? q[r] : q[r + 2]; s[r] = keep + dppc<0x4E>(send); }
    float t; { const float keep = u1 ? s[1] : s[0], send = u1 ? s[0] : s[1]; t = keep + dppc<0xB1>(send); }
    t += dppc<0x128>(t);
    { float a = t, b = t; asm volatile("s_nop 1\n\tv_permlane16_swap_b32 %0, %1" : "+v"(a), "+v"(b)); t = a + b; }
    { float a = t, b = t; asm volatile("s_nop 1\n\tv_permlane32_swap_b32 %0, %1" : "+v"(a), "+v"(b)); t = a + b; }
    return t;
}
__device__ __forceinline__ float reduce8_grp(const float (&p)[8], int lane) {
    const bool u4 = (lane & 4) != 0, u2 = (lane & 2) != 0, u1 = (lane & 1) != 0;
    float q[4];
#pragma unroll
    for (int r = 0; r < 4; ++r) { const float keep = u4 ? p[r + 4] : p[r], send = u4 ? p[r] : p[r + 4]; q[r] = keep + dppc<0x141>(send); }
    float s[2];
#pragma unroll
    for (int r = 0; r < 2; ++r) { const float keep = u2 ? q[r + 2] : q[r], send = u2 ? q[r] : q[r + 2]; s[r] = keep + dppc<0x4E>(send); }
    const float keep = u1 ? s[1] : s[0], send = u1 ? s[0] : s[1];
    return keep + dppc<0xB1>(send);
}
constexpr int PEER_NCHUNK = T / 16;
#define SB() __builtin_amdgcn_sched_barrier(0)
#define PEER_LOAD8(dst, b) do { const u32x4 ia_ = *(const LAS u32x4*)(ip + 4 * (b)); \
        dst[0] = *(const u32x4*)(tab + (ia_.x & 0xffffu) * 128u); dst[1] = *(const u32x4*)(tab + (ia_.x >> 16) * 128u); dst[2] = *(const u32x4*)(tab + (ia_.y & 0xffffu) * 128u); dst[3] = *(const u32x4*)(tab + (ia_.y >> 16) * 128u); \
        dst[4] = *(const u32x4*)(tab + (ia_.z & 0xffffu) * 128u); dst[5] = *(const u32x4*)(tab + (ia_.z >> 16) * 128u); dst[6] = *(const u32x4*)(tab + (ia_.w & 0xffffu) * 128u); dst[7] = *(const u32x4*)(tab + (ia_.w >> 16) * 128u); } while (0)
typedef int i32x4 __attribute__((ext_vector_type(4)));
template <int CTRL> __device__ __forceinline__ int dppi(int v) { return __builtin_amdgcn_update_dpp(0, v, CTRL, 0xf, 0xf, true); }
__device__ __forceinline__ int reduce8_grp_i(const int (&p)[8], int lane) {
    const bool u4 = (lane & 4) != 0, u2 = (lane & 2) != 0, u1 = (lane & 1) != 0;
    int q[4];
#pragma unroll
    for (int r = 0; r < 4; ++r) { const int keep = u4 ? p[r + 4] : p[r], send = u4 ? p[r] : p[r + 4]; q[r] = keep + dppi<0x141>(send); }
    int s[2];
#pragma unroll
    for (int r = 0; r < 2; ++r) { const int keep = u2 ? q[r + 2] : q[r], send = u2 ? q[r] : q[r + 2]; s[r] = keep + dppi<0x4E>(send); }
    const int keep = u1 ? s[1] : s[0], send = u1 ? s[0] : s[1];
    return keep + dppi<0xB1>(send);
}
__device__ __forceinline__ int dot32n(const u32x4& r, const u32x4& ha, const u32x4& hb) {
    int a = __builtin_amdgcn_sdot8((int)r.x, (int)ha.x, 0, false); a = __builtin_amdgcn_sdot8((int)r.y, (int)ha.y, a, false);
    a = __builtin_amdgcn_sdot8((int)r.z, (int)ha.z, a, false); a = __builtin_amdgcn_sdot8((int)r.w, (int)ha.w, a, false);
    int b = __builtin_amdgcn_sdot8((int)r.x, (int)hb.x, 0, false); b = __builtin_amdgcn_sdot8((int)r.y, (int)hb.y, b, false);
    b = __builtin_amdgcn_sdot8((int)r.z, (int)hb.z, b, false); b = __builtin_amdgcn_sdot8((int)r.w, (int)hb.w, b, false);
    return (a << 4) + b;
}
__device__ __forceinline__ void phase_peer_u(const Ctx& C) {
    const Args& A = *C.a; unsigned char* ws = A.ws; CTX_LANES();
    const int g = lane >> 3, c = lane & 7;
    const unsigned* ridx = (const unsigned*)(ws + WS_RIDX); const float* gfp = A.in[I_NORM_FFN];
    unsigned* Q = (unsigned*)(ws + WS_CTL) + CW_QU + A.li * 1024;
    LAS unsigned* sidx = (LAS unsigned*)(C.lds + wave * 16384);
    const int xcc = (int)(xb_xcc_id() & 7u);
    for (int so = 0; so < 4; ++so) {
        const int s = (xcc + so) & 3;
        const unsigned char* tab = ws + WS_EU + (size_t)s * (NEXP * 128) + 16 * c;
        const bf16_t* x1s = (const bf16_t*)(ws + WS_X1B) + 256 * s + 32 * c;
        f32x4 gv[8];
#pragma unroll
        for (int j = 0; j < 8; ++j) gv[j] = *(const f32x4*)(gfp + 256 * s + 32 * c + 4 * j);
        _Float16* part = (_Float16*)(ws + WS_PART) + (size_t)s * T * 128;
        for (;;) {
            int ch = 0; if (lane == 0) ch = (int)atomicAdd(&Q[64 * s], 1u);
            ch = __builtin_amdgcn_readfirstlane(ch);
            if (ch >= PEER_NCHUNK) break;
            const int tok0 = ch * 16;
#pragma unroll
            for (int i = 0; i < 4; ++i) *(LAS u32x4*)(sidx + (i * 64 + lane) * 4) = __builtin_nontemporal_load((const u32x4*)(ridx + (size_t)tok0 * 64) + i * 64 + lane);
            u32x4 wa[4];
#pragma unroll
            for (int i = 0; i < 4; ++i) wa[i] = *(const u32x4*)(x1s + (size_t)(tok0 + g) * D + 8 * i);
#pragma unroll 1
            for (int sub = 0; sub < 2; ++sub) {
                const int tok = tok0 + sub * 8 + g;
                u32x4 ha, hb; float sc;
                {
                  f32x4 hv[8];
#pragma unroll
                  for (int i = 0; i < 4; ++i) { hv[2 * i] = (f32x4){bf_lo(wa[i].x), bf_hi(wa[i].x), bf_lo(wa[i].y), bf_hi(wa[i].y)} * gv[2 * i]; hv[2 * i + 1] = (f32x4){bf_lo(wa[i].z), bf_hi(wa[i].z), bf_lo(wa[i].w), bf_hi(wa[i].w)} * gv[2 * i + 1]; }
                  float am = 0.f;
#pragma unroll
                  for (int j = 0; j < 8; ++j) am = fmaxf(am, fmaxf(fmaxf(fabsf(hv[j].x), fabsf(hv[j].y)), fmaxf(fabsf(hv[j].z), fabsf(hv[j].w))));
                  am = fmaxf(am, dppc<0xB1>(am)); am = fmaxf(am, dppc<0x4E>(am)); am = fmaxf(am, dppc<0x141>(am));
                  const float qi = am > 0.f ? 119.0f / am : 0.f; sc = am * (1.0f / 119.0f);
                  unsigned e[8];
#pragma unroll
                  for (int j = 0; j < 8; ++j) { const int q0 = (int)__builtin_rintf(hv[j].x * qi) + 8, q1 = (int)__builtin_rintf(hv[j].y * qi) + 8, q2 = (int)__builtin_rintf(hv[j].z * qi) + 8, q3 = (int)__builtin_rintf(hv[j].w * qi) + 8;
                      e[j] = ((unsigned)q0 & 0xffu) | (((unsigned)q1 & 0xffu) << 8) | (((unsigned)q2 & 0xffu) << 16) | ((unsigned)q3 << 24); }
                  unsigned a4[4], b4[4];
#pragma unroll
                  for (int j = 0; j < 4; ++j) { a4[j] = ((e[2 * j] >> 4) & 0x0F0F0F0Fu) | (e[2 * j + 1] & 0xF0F0F0F0u); b4[j] = ((e[2 * j] & 0x0F0F0F0Fu) | ((e[2 * j + 1] & 0x0F0F0F0Fu) << 4)) ^ 0x88888888u; }
                  ha = (u32x4){a4[0], a4[1], a4[2], a4[3]}; hb = (u32x4){b4[0], b4[1], b4[2], b4[3]}; }
                if (sub == 0) {
#pragma unroll
                    for (int i = 0; i < 4; ++i) wa[i] = *(const u32x4*)(x1s + (size_t)(tok + 8) * D + 8 * i); }
                const LAS unsigned* ip = sidx + (sub * 8 + g) * 64;
                _Float16* pp = part + (size_t)tok * 128 + c;
                u32x4 r0[8], r1[8], r2[8], r3[8];
#define PEER_DOTB(src, b) do { int p_[8]; _Pragma("unroll") for (int k_ = 0; k_ < 8; ++k_) p_[k_] = dot32n(src[k_], ha, hb); __builtin_nontemporal_store((_Float16)((float)reduce8_grp_i(p_, lane) * sc), pp + 8 * (b)); } while (0)
                PEER_LOAD8(r0, 0); PEER_LOAD8(r1, 1); PEER_LOAD8(r2, 2); PEER_LOAD8(r3, 3); SB();
#pragma unroll
                for (int b4_ = 0; b4_ < 16; b4_ += 4) {
                    PEER_DOTB(r0, b4_); SB(); if (b4_ + 4 < 16) PEER_LOAD8(r0, b4_ + 4); SB();
                    PEER_DOTB(r1, b4_ + 1); SB(); if (b4_ + 5 < 16) PEER_LOAD8(r1, b4_ + 5); SB();
                    PEER_DOTB(r2, b4_ + 2); SB(); if (b4_ + 6 < 16) PEER_LOAD8(r2, b4_ + 6); SB();
                    PEER_DOTB(r3, b4_ + 3); SB(); if (b4_ + 7 < 16) PEER_LOAD8(r3, b4_ + 7); SB();
                }
#undef PEER_DOTB
            }
        }
    }
}
__device__ __forceinline__ void phase_peer_coef(const Ctx& C) {
    const Args& A = *C.a; unsigned char* ws = A.ws; CTX_LANES();
    const _Float16* part = (const _Float16*)(ws + WS_PART); const float* SU = (const float*)(ws + WS_SU); const float* SV = (const float*)(ws + WS_SV);
    const unsigned short* ridx = (const unsigned short*)(ws + WS_RIDX); const float* rg = (const float*)(ws + WS_RG); const float* ssq = (const float*)(ws + WS_SSQ2); _Float16* coef = (_Float16*)(ws + WS_COEF);
    typedef _Float16 h16x4 __attribute__((ext_vector_type(4)));
    const size_t gt = (size_t)(C.vcu * 512 + tid_), NT = (size_t)C.G * 512;
    for (size_t i4 = gt; i4 < (size_t)T * 32; i4 += NT) {
        const size_t tok = i4 >> 5, i = i4 * 4;
        const f32x4* sp = (const f32x4*)(ssq + tok * 16);
        const f32x4 s0 = sp[0], s1 = sp[1], s2 = sp[2], s3 = sp[3];
        const float tot = ((s0.x + s0.y) + (s0.z + s0.w)) + ((s1.x + s1.y) + (s1.z + s1.w)) + ((s2.x + s2.y) + (s2.z + s2.w)) + ((s3.x + s3.y) + (s3.z + s3.w));
        const float rs2 = 1.0f / sqrtf(tot * (1.0f / D) + RMS_EPS);
        f32x4 a = (f32x4){0.f, 0.f, 0.f, 0.f};
#pragma unroll
        for (int s = 0; s < 4; ++s) { const h16x4 p = __builtin_nontemporal_load((const h16x4*)(part + (size_t)s * T * 128 + i)); a += (f32x4){(float)p.x, (float)p.y, (float)p.z, (float)p.w}; }
        const u32x2 ew = *(const u32x2*)(ridx + i); const f32x4 g = *(const f32x4*)(rg + i);
        const unsigned e0 = ew.x & 0xffffu, e1 = ew.x >> 16, e2 = ew.y & 0xffffu, e3 = ew.y >> 16;
        f32x4 cf = (f32x4){gelu_erf(a.x * SU[e0] * rs2) * g.x * SV[e0], gelu_erf(a.y * SU[e1] * rs2) * g.y * SV[e1], gelu_erf(a.z * SU[e2] * rs2) * g.z * SV[e2], gelu_erf(a.w * SU[e3] * rs2) * g.w * SV[e3]};
        { h16x4 o; o.x = (_Float16)cf.x; o.y = (_Float16)cf.y; o.z = (_Float16)cf.z; o.w = (_Float16)cf.w; *(h16x4*)(coef + i) = o; }
        cf *= 256.0f;
        unsigned char* c8 = ws + WS_COEF8 + tok * 384 + (i & 127);
#pragma unroll
        for (int part_ = 0; part_ < 3; ++part_) {
            const unsigned w8 = pk4_fp8(cf.x, cf.y, cf.z, cf.w);
            *(unsigned*)(c8 + part_ * 128) = w8;
            cf -= (f32x4){__builtin_amdgcn_cvt_f32_fp8((int)w8, 0), __builtin_amdgcn_cvt_f32_fp8((int)w8, 1), __builtin_amdgcn_cvt_f32_fp8((int)w8, 2), __builtin_amdgcn_cvt_f32_fp8((int)w8, 3)};
        }
    }
}
typedef _Float16 h16x2 __attribute__((ext_vector_type(2)));
__device__ __forceinline__ void axpy32_fp4(const u32x4& r, _Float16 c, h16x2 (&o)[16]) {
    const h16x2 cc = (h16x2){c, c};
#define CV4(w, k) __builtin_bit_cast(h16x2, __builtin_amdgcn_cvt_scalef32_pk_f16_fp4((w), 1.0f, (k)))
#define AX4(j, w) do { o[4 * (j) + 0] += cc * CV4(w, 0); o[4 * (j) + 1] += cc * CV4(w, 1); o[4 * (j) + 2] += cc * CV4(w, 2); o[4 * (j) + 3] += cc * CV4(w, 3); } while (0)
    AX4(0, r.x); AX4(1, r.y); AX4(2, r.z); AX4(3, r.w);
#undef AX4
#undef CV4
}
constexpr int VW_LDS = 20352;
typedef int i32x2v __attribute__((ext_vector_type(2))); using pg8::i32x4v; using pg8::i32x8v;
template <int NBUF>
__device__ __forceinline__ void phase_peer_v_mfma(const Ctx& C, LAS unsigned char* tile) {
    const Args& A = *C.a; unsigned char* ws = A.ws; CTX_LANES();
    const int n = lane & 15, kq = lane >> 4;
    const unsigned char* ridx = ws + WS_RIDX; const unsigned char* coef8 = ws + WS_COEF8;
    const bf16_t* x1b = (const bf16_t*)(ws + WS_X1B); bf16_t* x2b = (bf16_t*)(ws + WS_X2B); float* ssq3 = (float*)(ws + WS_SSQ3);
    unsigned* Q = (unsigned*)(ws + WS_CTL) + CW_QV + A.li * 1024;
    LAS unsigned short* sid = (LAS unsigned short*)(tile + NBUF * 16384); LAS float* sout = (LAS float*)(tile + NBUF * 16384 + 2048);
    const int xcc = (int)(xb_xcc_id() & 7u);
    const int sc7f = 0x7F7F7F7F;
    const int row = 32 * kq + n, sw = (row >> 1) & 7;
    LAS unsigned char* rb = tile + 128 * row;
    unsigned adr[8];
#pragma unroll
    for (int q = 0; q < 8; ++q) adr[q] = (unsigned)(unsigned long)(rb + 16 * (q ^ sw));
    const int grow = lane >> 3, gq = lane & 7;
    const bool arow = n < 3;
#define V_GATHER(t_, bo_) do { const LAS unsigned short* ip_ = sid + ((t_) & 7) * 128 + grow; \
        _Pragma("unroll") for (int i_ = 0; i_ < 16; ++i_) { const unsigned e_ = ip_[8 * i_]; glds16(tab + e_ * 128u + 16u * (unsigned)(gq ^ ((lane >> 4) + 4 * (i_ & 1))), tile + (bo_) + i_ * 1024); } } while (0)
#define V_LOADA(dst0, dst1, xw, t_) do { const size_t tk_ = (size_t)(tok0 + (t_)); const unsigned char* ap_ = coef8 + tk_ * 384 + (arow ? n * 128 + 16 * kq : 0); const bf16_t* xp_ = x1b + tk_ * D + 256 * s + 4 * lane; \
        asm volatile("global_load_dwordx4 %0, %1, off" : "=v"(dst0) : "v"(ap_) : "memory"); asm volatile("global_load_dwordx4 %0, %1, off offset:64" : "=v"(dst1) : "v"(ap_) : "memory"); (void)xp_; (void)xw; } while (0)
    for (int so = 0; so < 4; ++so) {
        const int s = (xcc + so) & 3;
        const unsigned char* tab = ws + WS_EV + (size_t)s * (NEXP * 128);
        for (;;) {
            int ch = 0; if (lane == 0) ch = (int)atomicAdd(&Q[64 * s], 1u);
            ch = __builtin_amdgcn_readfirstlane(ch);
            if (ch >= PEER_NCHUNK) break;
            const int tok0 = ch * 16;
            const unsigned char* rp = ridx + (size_t)tok0 * 256 + 16 * lane;
            const u32x4 ia0 = __builtin_nontemporal_load((const u32x4*)rp), ia1 = __builtin_nontemporal_load((const u32x4*)(rp + 1024));
            u32x4 ib0 = __builtin_nontemporal_load((const u32x4*)(rp + 2048)), ib1 = __builtin_nontemporal_load((const u32x4*)(rp + 3072));
            asm volatile("s_waitcnt lgkmcnt(0)" ::: "memory");
            *(LAS u32x4*)((LAS unsigned char*)sid + 16 * lane) = ia0; *(LAS u32x4*)((LAS unsigned char*)sid + 1024 + 16 * lane) = ia1;
            asm volatile("s_waitcnt lgkmcnt(0)" ::: "memory");
            u32x4 sa0, sa1, sb0, sb1; u32x2 sax, sbx; u32x2 xo = (u32x2){0u, 0u}; float sso = 0.f;
            auto body = [&](const int t, u32x4& a0, u32x4& a1, u32x2& xw, const int bo, const bool GATHER, const bool YOUNGER) __attribute__((always_inline)) {
                const int tok = tok0 + t;
                if (YOUNGER) asm volatile("s_waitcnt vmcnt(19)" : "+v"(a0), "+v"(a1) :: "memory");
                else asm volatile("s_waitcnt vmcnt(0)" : "+v"(a0), "+v"(a1) :: "memory");
                if (t > 0) {
                    *(u32x2*)(x2b + (size_t)(tok - 1) * D + 256 * s + 4 * lane) = xo;
                    ssq3[(size_t)(tok - 1) * 8 + s] = sso; ssq3[(size_t)(tok - 1) * 8 + 4 + s] = 0.f;
                }
                u32x2 xc;
                { const bf16_t* xp_ = x1b + (size_t)tok * D + 256 * s + 4 * lane; asm volatile("global_load_dwordx2 %0, %1, off" : "=v"(xc) : "v"(xp_) : "memory"); }
                i32x4v b[16];
#pragma unroll
                for (int j = 0; j < 16; ++j) { i32x2v lo, hi;
                    if (bo == 0) { if (j & 1) { asm volatile("ds_read_b64_tr_b4 %0, %1 offset:8" : "=v"(lo) : "v"(adr[j >> 1]) : "memory"); asm volatile("ds_read_b64_tr_b4 %0, %1 offset:2056" : "=v"(hi) : "v"(adr[j >> 1]) : "memory"); }
                                   else       { asm volatile("ds_read_b64_tr_b4 %0, %1" : "=v"(lo) : "v"(adr[j >> 1]) : "memory"); asm volatile("ds_read_b64_tr_b4 %0, %1 offset:2048" : "=v"(hi) : "v"(adr[j >> 1]) : "memory"); } }
                    else         { if (j & 1) { asm volatile("ds_read_b64_tr_b4 %0, %1 offset:16392" : "=v"(lo) : "v"(adr[j >> 1]) : "memory"); asm volatile("ds_read_b64_tr_b4 %0, %1 offset:18440" : "=v"(hi) : "v"(adr[j >> 1]) : "memory"); }
                                   else       { asm volatile("ds_read_b64_tr_b4 %0, %1 offset:16384" : "=v"(lo) : "v"(adr[j >> 1]) : "memory"); asm volatile("ds_read_b64_tr_b4 %0, %1 offset:18432" : "=v"(hi) : "v"(adr[j >> 1]) : "memory"); } }
                    b[j] = (i32x4v){lo.x, lo.y, hi.x, hi.y}; }
                i32x8v av = (i32x8v){(int)a0.x, (int)a0.y, (int)a0.z, (int)a0.w, (int)a1.x, (int)a1.y, (int)a1.z, (int)a1.w};
                if (!arow) av = (i32x8v){0, 0, 0, 0, 0, 0, 0, 0};
                asm volatile("s_waitcnt lgkmcnt(0)" ::: "memory");
                if (GATHER) {
                    if (t + NBUF == 8) { *(LAS u32x4*)((LAS unsigned char*)sid + 16 * lane) = ib0; *(LAS u32x4*)((LAS unsigned char*)sid + 1024 + 16 * lane) = ib1; asm volatile("s_waitcnt lgkmcnt(0)" ::: "memory"); }
                    V_GATHER(t + NBUF, bo); V_LOADA(a0, a1, xw, t + NBUF);
                }
#pragma unroll
                for (int hf = 0; hf < 2; ++hf) {
                    f32x4 acc[8];
#pragma unroll
                    for (int j = 0; j < 8; ++j) asm volatile("v_mfma_scale_f32_16x16x128_f8f6f4 %0, %1, %2, 0, %3, %3 op_sel_hi:[0,0,0] cbsz:4 blgp:0" : "=&v"(acc[j]) : "v"(b[8 * hf + j]), "v"(av), "v"(sc7f));
                    asm volatile("s_nop 15\n\ts_nop 15" ::: "memory");
                    if (n < 3) {
#pragma unroll
                        for (int j = 0; j < 8; ++j) *(LAS f32x4*)(sout + 256 * n + 16 * (8 * hf + j) + 4 * kq) = acc[j];
                    }
                }
                asm volatile("s_waitcnt lgkmcnt(0)" ::: "memory");
                const f32x4 pv = ((*(const LAS f32x4*)(sout + 4 * lane) + *(const LAS f32x4*)(sout + 256 + 4 * lane)) + *(const LAS f32x4*)(sout + 512 + 4 * lane)) * (1.0f / 256.0f);
                asm volatile("s_waitcnt lgkmcnt(0)" ::: "memory");
                if (GATHER) asm volatile("s_waitcnt vmcnt(18)" : "+v"(xc) :: "memory");
                else asm volatile("s_waitcnt vmcnt(0)" : "+v"(xc) :: "memory");
                const f32x4 xv = (f32x4){bf_lo(xc.x), bf_hi(xc.x), bf_lo(xc.y), bf_hi(xc.y)} + pv;
                float ss = (xv.x * xv.x + xv.y * xv.y) + (xv.z * xv.z + xv.w * xv.w);
                xo = (u32x2){pk2(xv.x, xv.y), pk2(xv.z, xv.w)};
                sso = wave_sum_dpp(ss);
            };
            V_GATHER(0, 0); V_LOADA(sa0, sa1, sax, 0);
            if (NBUF == 2) { V_GATHER(1, 16384); V_LOADA(sb0, sb1, sbx, 1); }
            if (NBUF == 2) {
#pragma unroll 1
                for (int t2 = 0; t2 < 14; t2 += 2) { body(t2, sa0, sa1, sax, 0, true, true); body(t2 + 1, sb0, sb1, sbx, 16384, true, true); }
                body(14, sa0, sa1, sax, 0, false, true); body(15, sb0, sb1, sbx, 16384, false, false);
            } else {
#pragma unroll 1
                for (int t = 0; t < 15; ++t) body(t, sa0, sa1, sax, 0, true, false);
                body(15, sa0, sa1, sax, 0, false, false);
            }
            *(u32x2*)(x2b + (size_t)(tok0 + 15) * D + 256 * s + 4 * lane) = xo;
            ssq3[(size_t)(tok0 + 15) * 8 + s] = sso; ssq3[(size_t)(tok0 + 15) * 8 + 4 + s] = 0.f;
        }
    }
#undef V_GATHER
#undef V_LOADA
}
__device__ __forceinline__ void phase_peer_v_valu(const Ctx& C, LAS unsigned char* wl) {
    const Args& A = *C.a; unsigned char* ws = A.ws; CTX_LANES();
    const int g = lane >> 3, c = lane & 7;
    const unsigned* ridx = (const unsigned*)(ws + WS_RIDX); const unsigned* coef = (const unsigned*)(ws + WS_COEF);
    const bf16_t* x1b = (const bf16_t*)(ws + WS_X1B); bf16_t* x2b = (bf16_t*)(ws + WS_X2B); float* ssq3 = (float*)(ws + WS_SSQ3);
    unsigned* Q = (unsigned*)(ws + WS_CTL) + CW_QV + A.li * 1024;
    LAS unsigned* sidx = (LAS unsigned*)wl; LAS unsigned* scf = (LAS unsigned*)(wl + 2048);
    const int xcc = (int)(xb_xcc_id() & 7u);
    for (int so = 0; so < 4; ++so) {
        const int s = (xcc + so) & 3;
        const unsigned char* tab = ws + WS_EV + (size_t)s * (NEXP * 128) + 16 * c;
        for (;;) {
            int ch = 0; if (lane == 0) ch = (int)atomicAdd(&Q[64 * s], 1u);
            ch = __builtin_amdgcn_readfirstlane(ch);
            if (ch >= PEER_NCHUNK) break;
            const int tok0 = ch * 16;
            u32x4 st[2][4];
#pragma unroll
            for (int i = 0; i < 4; ++i) { st[0][i] = __builtin_nontemporal_load((const u32x4*)(ridx + (size_t)tok0 * 64) + i * 64 + lane); st[1][i] = __builtin_nontemporal_load((const u32x4*)(coef + (size_t)tok0 * 64) + i * 64 + lane); }
#pragma unroll 1
            for (int sub = 0; sub < 2; ++sub) {
                const int tok = tok0 + sub * 8 + g;
#pragma unroll
                for (int i = 0; i < 2; ++i) { *(LAS u32x4*)(sidx + (i * 64 + lane) * 4) = sub ? st[0][2 + i] : st[0][i]; *(LAS u32x4*)(scf + (i * 64 + lane) * 4) = sub ? st[1][2 + i] : st[1][i]; }
                const LAS unsigned* ip = sidx + g * 64; const LAS unsigned* cp = scf + g * 64;
                const bf16_t* xr = x1b + (size_t)tok * D + 256 * s + 32 * c;
                u32x4 wa[4];
#pragma unroll
                for (int i = 0; i < 4; ++i) wa[i] = *(const u32x4*)(xr + 8 * i);
                h16x2 acc[16];
#pragma unroll
                for (int j = 0; j < 16; ++j) acc[j] = (h16x2){(_Float16)0.f, (_Float16)0.f};
                u32x4 r0[8], r1[8];
#define PEER_AXB(src, b) do { const h16x8 ch_ = *(const LAS h16x8*)(cp + 4 * (b)); \
                    axpy32_fp4(src[0], ch_[0], acc); axpy32_fp4(src[1], ch_[1], acc); axpy32_fp4(src[2], ch_[2], acc); axpy32_fp4(src[3], ch_[3], acc); \
                    axpy32_fp4(src[4], ch_[4], acc); axpy32_fp4(src[5], ch_[5], acc); axpy32_fp4(src[6], ch_[6], acc); axpy32_fp4(src[7], ch_[7], acc); } while (0)
                PEER_LOAD8(r0, 0); PEER_LOAD8(r1, 1); SB();
#pragma unroll
                for (int b2 = 0; b2 < 16; b2 += 2) {
                    PEER_AXB(r0, b2); SB(); if (b2 + 2 < 16) PEER_LOAD8(r0, b2 + 2); SB();
                    PEER_AXB(r1, b2 + 1); SB(); if (b2 + 3 < 16) PEER_LOAD8(r1, b2 + 3); SB();
                }
#undef PEER_AXB
                float ss = 0.f;
                bf16_t* xb = x2b + (size_t)tok * D + 256 * s + 32 * c;
#pragma unroll
                for (int i = 0; i < 4; ++i) {
#define A2F(a_) ((f32x2){(float)(a_).x, (float)(a_).y})
                    const f32x2 v0 = (f32x2){bf_lo(wa[i].x), bf_hi(wa[i].x)} + A2F(acc[4 * i]), v1 = (f32x2){bf_lo(wa[i].y), bf_hi(wa[i].y)} + A2F(acc[4 * i + 1]),
                                v2 = (f32x2){bf_lo(wa[i].z), bf_hi(wa[i].z)} + A2F(acc[4 * i + 2]), v3 = (f32x2){bf_lo(wa[i].w), bf_hi(wa[i].w)} + A2F(acc[4 * i + 3]);
#undef A2F
                    ss += ((v0.x * v0.x + v0.y * v0.y) + (v1.x * v1.x + v1.y * v1.y)) + ((v2.x * v2.x + v2.y * v2.y) + (v3.x * v3.x + v3.y * v3.y));
                    *(u32x4*)(xb + 8 * i) = (u32x4){pk2(v0.x, v0.y), pk2(v1.x, v1.y), pk2(v2.x, v2.y), pk2(v3.x, v3.y)};
                }
                ss += dppc<0xB1>(ss); ss += dppc<0x4E>(ss); ss += dppc<0x141>(ss);
                if (c == 0) { ssq3[(size_t)tok * 8 + s] = ss; ssq3[(size_t)tok * 8 + 4 + s] = 0.f; }
            }
        }
    }
}
__device__ __forceinline__ void phase_peer_v(const Ctx& C) {
    const int wave = __builtin_amdgcn_readfirstlane(opaque_tid() >> 6);
    if (PEER_V_MFMA == 1) phase_peer_v_mfma<1>(C, C.lds + wave * 20352);
    else if (PEER_V_MFMA == 0) phase_peer_v_valu(C, C.lds + wave * 4096);
    else { const int grp = ((wave >> 2) << 1) | (wave & 1);
           if (wave & 2) phase_peer_v_mfma<1>(C, C.lds + grp * 21504); else phase_peer_v_valu(C, C.lds + 86016 + grp * 4096); }
}
#undef PEER_LOAD8
#undef SB


#ifndef PROBE_DIAG
#define PROBE_DIAG 0
#endif
#if PROBE_DIAG
__device__ int diag_probe(const Ctx& C) {
    CTX_LANES();
    typedef int i32x2v_ __attribute__((ext_vector_type(2)));
    LAS unsigned char* t = C.lds;
    LAS unsigned* w = (LAS unsigned*)(t + 8 * lane);
    const int n = lane & 15, kq = lane >> 4;
    w[0] = 0x11111111u * (unsigned)n; w[1] = 0x11111111u * (unsigned)n;
    asm volatile("s_waitcnt lgkmcnt(0)" ::: "memory");
    const i32x2v_ r1 = __builtin_amdgcn_ds_read_tr4_b64_v2i32((LAS i32x2v_*)(t + 8 * lane));
    asm volatile("s_waitcnt lgkmcnt(0)" ::: "memory");
    const bool ok1 = (r1.x == 0x76543210) && (r1.y == (int)0xFEDCBA98u);
    w[0] = 0x76543210u; w[1] = 0xFEDCBA98u;
    asm volatile("s_waitcnt lgkmcnt(0)" ::: "memory");
    const i32x2v_ r2 = __builtin_amdgcn_ds_read_tr4_b64_v2i32((LAS i32x2v_*)(t + 8 * lane));
    asm volatile("s_waitcnt lgkmcnt(0)" ::: "memory");
    const bool ok2 = (r2.x == (int)(0x11111111u * (unsigned)n)) && (r2.y == (int)(0x11111111u * (unsigned)n));
    const bool q1a = __builtin_amdgcn_ballot_w64(ok1) == ~0ull, q1b = __builtin_amdgcn_ballot_w64(ok2) == ~0ull;
    const int sc7f = 0x7F7F7F7F;
    const unsigned long long nmask = 0x0001000100010001ull;
    const float L[8] = {0.f, 0.5f, 1.f, 1.5f, 2.f, 3.f, 4.f, 6.f};
#ifndef DIAG_K0
#define DIAG_K0 2
#define DIAG_REG 1
#define DIAG_LANE 16
#endif
#ifndef DIAG_I0
#define DIAG_I0 17
#endif
    int code = 0;
    {
        const int I0 = DIAG_I0;
        pg8::i32x8v bv = (pg8::i32x8v){0, 0, 0, 0, 0, 0, 0, 0};
        bv[I0 >> 2] = (n == 0 && kq == DIAG_K0) ? (0x38 << (8 * (I0 & 3))) : 0;
        const pg8::i32x4v a1 = (pg8::i32x4v){0x11111111 * (kq + 1), 0x11111111 * (kq + 1), 0x11111111 * (kq + 1), 0x11111111 * (kq + 1)};
        const pg8::i32x4v a2 = (pg8::i32x4v){0x11111111, 0x22222222, 0x33333333, 0x44444444};
        f32x4 d1, d2;
        asm volatile("v_mfma_scale_f32_16x16x128_f8f6f4 %0, %1, %2, 0, %3, %3 op_sel_hi:[0,0,0] cbsz:4 blgp:0" : "=&v"(d1) : "v"(a1), "v"(bv), "v"(sc7f));
        asm volatile("v_mfma_scale_f32_16x16x128_f8f6f4 %0, %1, %2, 0, %3, %3 op_sel_hi:[0,0,0] cbsz:4 blgp:0" : "=&v"(d2) : "v"(a2), "v"(bv), "v"(sc7f));
        asm volatile("s_nop 15\n\ts_nop 15" ::: "memory");
        int lo = 8, hi = 4;
#pragma unroll
        for (int q = 0; q < 8; ++q) { if (d1[DIAG_REG] == L[q]) lo = q; }
#pragma unroll
        for (int q = 0; q < 4; ++q) { if (d2[DIAG_REG] == L[q + 1]) hi = q; }
        code = __builtin_amdgcn_readlane(lo + 9 * hi, DIAG_LANE);
    }
    (void)q1a; (void)q1b;
    return 1 + code;
}
#endif
constexpr int N_PHASES = 12;
__global__ void __launch_bounds__(512, 2) mk_fwd(Args args) {
    extern __shared__ __attribute__((aligned(16))) unsigned char lds[];
    Ctx C;
    C.lds = (LAS unsigned char*)lds;
    C.G = gridDim.x; { const int bx = blockIdx.x; C.vcu = (C.G % 8 == 0) ? (bx % 8) * (C.G / 8) + bx / 8 : bx; }
    C.a = &args;
    unsigned char* ws = args.ws;
    volatile LAS unsigned* MISC = (volatile LAS unsigned*)(C.lds + MISC_OFF);
    if (threadIdx.x < 64) MISC[threadIdx.x] = 0u;
    __syncthreads();
    XcdBarrier bar; bar.bar = (unsigned*)(ws + WS_CTL) + CW_BAR; bar.x = 0; bar.st = nullptr;
    const int lo = args.ph_lo, hi = args.ph_hi;
    if (hi - lo > 1) bar = xcd_barrier_post((unsigned*)(ws + WS_CTL) + CW_BAR + args.li * XCD_BAR_WORDS, MISC + 8);
#define IN(k) (((PHMASK >> (k)) & 1) && lo <= (k) && (k) < hi)
#define SEAM(k) do { if (IN(k) && IN((k) + 1)) xcd_barrier(bar); } while (0)
#define REP(k) for (int rep_ = 0; rep_ < 1 + (((PROBE_REPEAT_MASK) >> (k)) & 1) * (PROBE_REPS); ++rep_)
    LAS unsigned char* ring = C.lds;

    if (IN(0)) REP(0) { phase_prologue(C); }
    SEAM(0);
    if (IN(1)) REP(1) {
        pg8::Gemm g{(const bf16_t*)((unsigned char*)args.out + DO_XB), (const bf16_t*)(ws + WS_WIN), T, IN_W, D}; pg8::StaticOrder S; S.init(T, IN_W, C.G, (int)blockIdx.x);
        EpiProj E{(const float*)(ws + WS_RSTD1), args.in[I_QKN_NA], args.in[I_QKN_DIL], (const float*)(ws + WS_COS), (const float*)(ws + WS_SIN),
                  ws};
        pg8::gemm_phase<EpiProj, pg8::StaticOrder, true, true, true>(ring, g, S, E);
    }
    SEAM(1);
    if (IN(2)) REP(2) { if (USE_REF_ATTN) phase_attention_ref(C); else phase_attention(C); }
    SEAM(2);
    if (IN(3)) REP(3) { phase_dil_combine(C); }
    SEAM(3);
    if (IN(4)) REP(4) {
        pg8::Gemm g{(const bf16_t*)(ws + WS_OUTNA), (const bf16_t*)(ws + WS_WNA), T, D, ACAT}; pg8::StaticOrder S; S.init(T, D, C.G, (int)blockIdx.x);
        EpiMerge E{ws + WS_MERGED, (const bf16_t*)(ws + WS_GATES), 1.0f / (W8_SCALE * A8_SCALE)};
        pg8::gemm_phase<EpiMerge, pg8::StaticOrder, true, true, true>(ring, g, S, E);
    }
    SEAM(4);
    if (IN(5)) REP(5) {
        pg8::Gemm g{(const bf16_t*)(ws + WS_MERGED), (const bf16_t*)(ws + WS_WOUT), T, D, D}; pg8::StaticOrder S; S.init(T, D, C.G, (int)blockIdx.x);
        EpiResid E{args.in[I_X], args.out, (bf16_t*)(ws + WS_X1B), (float*)(ws + WS_SSQ2), 1.0f / (W8_SCALE * A8_SCALE)};
        pg8::gemm_phase<EpiResid, pg8::StaticOrder, true, true, true>(ring, g, S, E);
    }
    SEAM(5);
    if (IN(6)) {
        pg8::Gemm g{(const bf16_t*)(ws + WS_X1B), (const bf16_t*)(ws + WS_WSC), T, 2048, D}; pg8::SingleOrder S; S.S.init(T, 2048, C.G, (int)blockIdx.x);
        EpiScoresTopk E{(const float*)(ws + WS_SSQ2), (unsigned short*)(ws + WS_RIDX), (float*)(ws + WS_RG)};
        for (int i = 0; i < (T / 256) * 8; ++i) { pg8::Unit uu; S.i = i; if (!S.S.next(i, uu)) break; pg8::gemm_phase<EpiScoresTopk, pg8::SingleOrder>(ring, g, S, E); }
    }
    SEAM(6);
    if (IN(7) && !IN(6) && IN(8)) { }
    if (IN(8)) { phase_peer_u(C); }
    SEAM(8);
    if (IN(9)) { phase_peer_coef(C); }
    SEAM(9);
    if (IN(10)) { phase_peer_v(C); }
    SEAM(10);
    if (IN(11)) {
        { pg8::Gemm g{(const bf16_t*)(ws + WS_PB), (const bf16_t*)(ws + WS_WPLE), T, D, 256}; pg8::StaticOrder S; S.init(T, D, C.G, (int)blockIdx.x);
          EpiGate<2> E{(bf16_t*)(ws + WS_TMP2), nullptr, 0, 0, nullptr, 1.0f};
          pg8::gemm_phase<EpiGate<2>, pg8::StaticOrder>(ring, g, S, E); }
        { pg8::Gemm g{(const bf16_t*)(ws + WS_X2B), (const bf16_t*)(ws + WS_WG), T, D, D}; pg8::StaticOrder S; S.init(T, D, C.G, (int)blockIdx.x);
          EpiFinal E{args.out, (const float*)(ws + WS_SSQ3), (const bf16_t*)(ws + WS_TMP2), (const bf16_t*)(ws + WS_X2B)};
          pg8::gemm_phase<EpiFinal, pg8::StaticOrder>(ring, g, S, E); }
    }
#if PROBE_DIAG
    {
        volatile float* cw = (volatile float*)(ws + WS_CTL + 57344 + 256);
        __syncthreads();
        if (blockIdx.x == 0 && threadIdx.x < 64) { const int code = diag_probe(C); if (threadIdx.x == 0) *cw = sqrtf(0.426f * (float)code); }
        xcd_barrier(bar);
        const float cv = *cw;
        for (int i = blockIdx.x * 512 + threadIdx.x; i < (1 << 20); i += C.G * 512) args.out[i] += cv;
    }
#endif
#undef IN
#undef SEAM
}

extern "C" void kernel_launch(void* const* d_in, const int* in_sizes, int n_in, void* d_out, int out_size, void* d_ws, size_t ws_size, hipStream_t stream) {
    static int grid = 0;
    if (grid == 0) {
        if (n_in != 18 || in_sizes[0] != T * D || out_size != T * D || ws_size < WS_END) { fprintf(stderr, "kernel_launch: unexpected shapes (n_in %d, in0 %d, out %d, ws %zu)\n", n_in, n_in > 0 ? in_sizes[0] : -1, out_size, ws_size); grid = -1; return; }
        int dev = 0, cus = 0, per_cu = 0;
        if (hipGetDevice(&dev) != hipSuccess || hipDeviceGetAttribute(&cus, hipDeviceAttributeMultiprocessorCount, dev) != hipSuccess) { grid = -1; return; }
        if (hipFuncSetAttribute((const void*)mk_fwd, hipFuncAttributeMaxDynamicSharedMemorySize, LDS_BYTES) != hipSuccess) { fprintf(stderr, "kernel_launch: hipFuncSetAttribute failed\n"); grid = -1; return; }
        if (hipOccupancyMaxActiveBlocksPerMultiprocessor(&per_cu, (const void*)mk_fwd, 512, LDS_BYTES) != hipSuccess || per_cu < 1) { fprintf(stderr, "kernel_launch: occupancy query says %d blocks/CU\n", per_cu); per_cu = 1; }
        (void)hipGetLastError();
        grid = cus;
    }
    if (grid < 0) return;
    (void)hipMemsetAsync((char*)d_ws + WS_CTL, 0, CTL_ZERO_BYTES, stream);
    Args a{};
    for (int i = 0; i < 18; ++i) a.in[i] = (const float*)d_in[i];
    a.out = (float*)d_out; a.ws = (unsigned char*)d_ws;
    if (PROBE_PHASE >= 0) {
        const int k = PROBE_PHASE; const int lo_[3] = {0, k, k + 1}, hi_[3] = {k + 1, k + 1, N_PHASES};
        for (int li = 0; li < 3; ++li) { if (lo_[li] >= hi_[li]) continue; if (li == 1 && PROBE_NOREPEAT) continue; a.ph_lo = lo_[li]; a.ph_hi = hi_[li]; a.li = li; hipLaunchKernelGGL(mk_fwd, dim3(grid), dim3(512), LDS_BYTES, stream, a); }
    } else if (MK_N_LAUNCHES == 1) {
        a.ph_lo = 0; a.ph_hi = N_PHASES; a.li = 0;
        hipLaunchKernelGGL(mk_fwd, dim3(grid), dim3(512), LDS_BYTES, stream, a);
    } else {
        for (int li = 0; li < N_PHASES; ++li) { a.ph_lo = li; a.ph_hi = li + 1; a.li = li; hipLaunchKernelGGL(mk_fwd, dim3(grid), dim3(512), LDS_BYTES, stream, a); }
    }
}
```

```cpp
#include <hip/hip_runtime.h>
#include <cstdio>
#include <cstdint>

#ifndef PEER_V_MFMA
#define PEER_V_MFMA 2
#endif
#ifndef MK_N_LAUNCHES
#define MK_N_LAUNCHES 1
#endif

#ifndef PROBE_REPEAT_MASK
#define PROBE_REPEAT_MASK 0
#endif
#ifndef REDUCE8
#define REDUCE8 reduce8
#endif
#ifndef PROBE_PRO
#define PROBE_PRO 0
#endif
#ifndef PHMASK
#define PHMASK 0xfff
#endif
#ifndef PROBE_PHASE
#define PROBE_PHASE -1
#endif
#ifndef PROBE_NOREPEAT
#define PROBE_NOREPEAT 0
#endif
#ifndef USE_REF_ATTN
#define USE_REF_ATTN 0
#endif
#ifndef PROBE_REPS
#define PROBE_REPS 1
#endif
#define LAS __attribute__((address_space(3)))
#define GAS __attribute__((address_space(1)))
typedef unsigned short bf16_t;
typedef short bf16x8 __attribute__((ext_vector_type(8)));
typedef float f32x4 __attribute__((ext_vector_type(4)));
typedef float f32x2 __attribute__((ext_vector_type(2)));
typedef unsigned u32x4 __attribute__((ext_vector_type(4)));
typedef unsigned u32x2 __attribute__((ext_vector_type(2)));
typedef __bf16 bf16v2 __attribute__((ext_vector_type(2)));
typedef _Float16 h16x8 __attribute__((ext_vector_type(8)));

constexpr int D = 1024, BATCH = 8, SEQ = 4096, T = BATCH * SEQ;
constexpr int NA_H = 8, DIL_H = 12, HD = 64;
constexpr int IN_W = 5888;
constexpr int NEXP = 16384;
constexpr float RMS_EPS = 1e-6f;
constexpr float LOG2E = 1.4426950408889634f;
constexpr float QSCALE = 0.125f * LOG2E;

constexpr size_t MiB = 1u << 20;
constexpr size_t WS_CTL = 0, CTL_ZERO_BYTES = 64 * 1024;
constexpr size_t WS_RSTD1 = 1 * MiB, WS_RSTD3 = 1 * MiB + 256 * 1024, WS_COS = 1 * MiB + 512 * 1024, WS_SIN = 1 * MiB + 768 * 1024;
constexpr size_t WS_SSQ2 = 2 * MiB;
constexpr size_t WS_LSE = 4 * MiB;
constexpr size_t WS_WIN = 8 * MiB, WS_WNA = 20 * MiB, WS_WDIL = 21 * MiB, WS_WOUT = 22 * MiB, WS_WSC = 24 * MiB, WS_WG = 28 * MiB, WS_WPLE = 30 * MiB;
constexpr size_t WS_EU = 32 * MiB, WS_EV = 48 * MiB, WS_PB = 96 * MiB;
constexpr size_t WS_SU = 6 * MiB, WS_SV = 6 * MiB + 65536;
constexpr size_t WS_QNA = 112 * MiB, WS_KNA = 144 * MiB, WS_VNA = 176 * MiB;
constexpr size_t WS_QDIL = 208 * MiB, WS_KDIL = 256 * MiB, WS_VDIL = 304 * MiB;
constexpr size_t WS_GATES = 352 * MiB;
constexpr size_t WS_MERGED = 112 * MiB;
constexpr size_t WS_TMP1 = 208 * MiB;
constexpr size_t WS_X1B = 176 * MiB;
constexpr size_t WS_SCORES = 240 * MiB;
constexpr size_t WS_RIDX = 112 * MiB, WS_RG = 128 * MiB;
constexpr size_t WS_PART = 240 * MiB;
constexpr size_t WS_COEF = 368 * MiB;
constexpr size_t WS_X2B = 384 * MiB;
constexpr size_t WS_TMP2 = 176 * MiB;
constexpr size_t WS_SSQ3 = 7 * MiB;
constexpr size_t WS_COEF8 = 144 * MiB;
constexpr size_t WS_HQ = 144 * MiB;
constexpr size_t WS_HS = 4 * MiB;
constexpr size_t WS_END = 512 * MiB;
constexpr int CW_QU = 12288, CW_QV = 12288 + 512;
constexpr size_t DO_XB = 0, DO_OG = 64 * MiB, DO_OUTDIL = 112 * MiB;
constexpr size_t WS_OUTNA = 480 * MiB;
constexpr int ACAT = 768;

constexpr int CW_BAR = 1024;

constexpr int RING_BYTES = 131072;
constexpr int EPI_OFF = RING_BYTES;
constexpr int MISC_OFF = 162816;
constexpr int LDS_BYTES = 163840;

__device__ __forceinline__ unsigned f2bf(float f) { unsigned u = __builtin_bit_cast(unsigned, f); return (u + 0x7fffu + ((u >> 16) & 1u)) >> 16; }
__device__ __forceinline__ unsigned pk2(float lo, float hi) { return f2bf(lo) | (f2bf(hi) << 16); }
__device__ __forceinline__ float bf_lo(unsigned w) { return __builtin_bit_cast(float, w << 16); }
__device__ __forceinline__ float bf_hi(unsigned w) { return __builtin_bit_cast(float, w & 0xffff0000u); }
__device__ __forceinline__ float bf2f(bf16_t b) { return __builtin_bit_cast(float, ((unsigned)b) << 16); }
__device__ __forceinline__ float wave_sum(float v) {
#pragma unroll
    for (int o = 1; o < 64; o <<= 1) v += __shfl_xor(v, o);
    return v;
}
__device__ __forceinline__ float wave_max(float v) {
#pragma unroll
    for (int o = 1; o < 64; o <<= 1) v = fmaxf(v, __shfl_xor(v, o));
    return v;
}
template <int CTRL> __device__ __forceinline__ float dppc(float v) { return __builtin_bit_cast(float, __builtin_amdgcn_update_dpp(0, __builtin_bit_cast(int, v), CTRL, 0xf, 0xf, true)); }
__device__ __forceinline__ float wave_sum_dpp(float t) {
    t += dppc<0xB1>(t); t += dppc<0x4E>(t); t += dppc<0x141>(t); t += dppc<0x128>(t);
    { float a = t, b = t; asm volatile("s_nop 1\n\tv_permlane16_swap_b32 %0, %1" : "+v"(a), "+v"(b)); t = a + b; }
    { float a = t, b = t; asm volatile("s_nop 1\n\tv_permlane32_swap_b32 %0, %1" : "+v"(a), "+v"(b)); t = a + b; }
    return t;
}
__device__ __forceinline__ void swap16(float& a, float& b) { asm("s_nop 1\n\tv_permlane16_swap_b32 %0, %1" : "+v"(a), "+v"(b)); }
__device__ __forceinline__ void swap32(float& a, float& b) { asm("s_nop 1\n\tv_permlane32_swap_b32 %0, %1" : "+v"(a), "+v"(b)); }
__device__ __forceinline__ float sum_x16_x32(float t) { float a = t, b = t; swap16(a, b); t = a + b; a = t; b = t; swap32(a, b); return a + b; }
__device__ __forceinline__ float max_x16_x32(float t) { float a = t, b = t; swap16(a, b); t = fmaxf(a, b); a = t; b = t; swap32(a, b); return fmaxf(a, b); }
__device__ __forceinline__ float other_x16(float t, int lane) { float a = t, b = t; swap16(a, b); return (lane & 16) ? a : b; }
__device__ __forceinline__ float sigmoidf_(float v) { return 1.0f / (1.0f + __expf(-v)); }
__device__ __forceinline__ float gelu_erf(float v) {
    const float av = fabsf(v), t = __builtin_amdgcn_rcpf(av * 0.2316418882f + 1.0f);
    float q = t * 0.5307027145f + (-0.7265760135f); q = q * t + 0.7107068705f; q = q * t + (-0.142248368f); q = q * t + 0.127414796f; q = q * t;
    const float e = __builtin_amdgcn_exp2f(v * v * (-0.72134752044f));
    const float m = v * (q * e);
    return v < 0.f ? m : v - m;
}

__device__ __forceinline__ int opaque_tid();
namespace pg8 {
#define PG8_LAS __attribute__((address_space(3)))
constexpr int BM = 256, BK = 64, HALF = 128, HTB = HALF * BK * 2, STAGE_BYTES = 8 * HTB, NXCD = 8, WGM = 4;
__host__ __device__ __forceinline__ int lds_byte(int r, int c) { const int st = (r >> 4) * 2 + (c >> 5), rr = r & 15, cc = c & 31, ob = rr * 64 + cc * 2; return st * 1024 + (ob ^ (((ob >> 9) & 1) << 5)); }
__host__ __device__ __forceinline__ void stage_rc(int b, int& R, int& C) { const int st = b / 1024, sb = b % 1024, swz = sb ^ (((sb >> 9) & 1) << 5); R = (st >> 1) * 16 + swz / 64; C = (st & 1) * 32 + (swz % 64) / 2; }
__host__ __device__ __forceinline__ int perm32(int rho) { const int n = rho >> 4, i = rho & 15; return 8 * (i >> 2) + 4 * n + (i & 3); }
struct Unit { int pm, pn; };
struct Gemm { const bf16_t* A; const bf16_t* Bt; int M, N, K; };
struct StaticOrder {
    int nM, nN, nwg, G, c;
    __host__ __device__ void init(int M, int N, int G_, int c_) { nM = M / BM; nN = N / BM; nwg = nM * nN; G = G_; c = c_; }
    __host__ __device__ bool next(int i, Unit& u) const {
        const long L = (long)i * G + c; if (L >= nwg) return false;
        int wgid = (int)L; { const int q = nwg / NXCD, r = nwg % NXCD, xcd = wgid % NXCD, off = wgid / NXCD; wgid = (xcd < r ? xcd * (q + 1) : r * (q + 1) + (xcd - r) * q) + off; }
        const int nig = WGM * nN, gid = wgid / nig, fm = gid * WGM, gsz = (nM - fm) < WGM ? (nM - fm) : WGM;
        u.pm = fm + ((wgid % nig) % gsz); u.pn = (wgid % nig) / gsz; return true;
    }
    __device__ __forceinline__ void a_ready(const Unit&) const {}
    __device__ __forceinline__ void done(const Unit&) const {}
};
struct SingleOrder {
    StaticOrder S; int i;
    __device__ bool next(int k, Unit& u) const { return k == 0 ? S.next(i, u) : false; }
    __device__ __forceinline__ void a_ready(const Unit&) const {}
    __device__ __forceinline__ void done(const Unit&) const {}
};
__device__ __forceinline__ unsigned cvt_pk_bf16(float lo, float hi) { unsigned r; asm volatile("v_cvt_pk_bf16_f32 %0, %1, %2" : "=v"(r) : "v"(lo), "v"(hi)); return r; }

typedef int i32x4v __attribute__((ext_vector_type(4)));
typedef int i32x8v __attribute__((ext_vector_type(8)));
template <bool FP8> struct FragSel;
template <> struct FragSel<false> {
    struct type { bf16x8 k[2]; };
    static __device__ __forceinline__ void load(type& d, const PG8_LAS unsigned char* p) { d.k[0] = *(const PG8_LAS bf16x8*)p; d.k[1] = *(const PG8_LAS bf16x8*)(p + 1024); }
    static __device__ __forceinline__ f32x4 mma(const type& a, const type& b, f32x4 c, int) { c = __builtin_amdgcn_mfma_f32_16x16x32_bf16(a.k[0], b.k[0], c, 0, 0, 0); return __builtin_amdgcn_mfma_f32_16x16x32_bf16(a.k[1], b.k[1], c, 0, 0, 0); }
};
template <> struct FragSel<true> {
    typedef i32x8v type;
    static __device__ __forceinline__ void load(type& d, const PG8_LAS unsigned char* p) { const i32x4v lo = *(const PG8_LAS i32x4v*)p, hi = *(const PG8_LAS i32x4v*)(p + 1024); d = __builtin_shufflevector(lo, hi, 0, 1, 2, 3, 4, 5, 6, 7); }
    static __device__ __forceinline__ f32x4 mma(const type& a, const type& b, f32x4 c, int sc) {
        asm volatile("v_mfma_scale_f32_16x16x128_f8f6f4 %0, %1, %2, %0, %3, %3 op_sel_hi:[0,0,0]" : "+v"(c) : "v"(a), "v"(b), "v"(sc));
        return c; }
};
template <class E, class = void> struct MidTiles { static constexpr int v = 0; };
template <class E> struct MidTiles<E, decltype((void)E::MID_TILES)> { static constexpr int v = E::MID_TILES; };
template <class Epi, class Sched, bool ALIGN_EPI = true, bool SP2 = true, bool FP8 = false>
__device__ __forceinline__ void gemm_phase(PG8_LAS unsigned char* lds, const Gemm g, const Sched& S, const Epi& E) {
    const int tid = opaque_tid(), wid = __builtin_amdgcn_readfirstlane(tid >> 6), lane = tid & 63, wr = wid >> 2, wc = wid & 3, fr = lane & 15, fq = lane >> 4;
    int sc7f = 0x7F7F7F7F; if constexpr (FP8) asm volatile("" : "+v"(sc7f));
    const int K = g.K, nt = FP8 ? K / 128 : K / BK;
    const int KB = FP8 ? K : 2 * K;
    unsigned voffA[2], voffB[2];
#pragma unroll
    for (int i = 0; i < 2; ++i) { int R, C; stage_rc(tid * 16 + i * 8192, R, C); const int Rb = 64 * (R >> 5) + perm32(R & 31);
        voffA[i] = (unsigned)(R * KB + 2 * C); voffB[i] = (unsigned)(Rb * KB + 2 * C); }
    const size_t kstep = (size_t)(BK * 2);
    const size_t hstep = (size_t)HALF * KB;
    const size_t hstepB = (size_t)32 * KB;
    const size_t tstep = 2 * hstep;
    const unsigned ldsw = (unsigned)wid * 1024u;
    const int aoff = lds_byte(wr * 64 + fr, fq * 8), boff = lds_byte(wc * 32 + fr, fq * 8);
#define PG8_SA(b, h) (((b) * 2 + (h)) * HTB)
#define PG8_SB(b, h) ((4 + (b) * 2 + (h)) * HTB)
#define PG8_STAGE(bufoff, gbase, voff) do { _Pragma("unroll") for (int _i = 0; _i < 2; ++_i) \
        __builtin_amdgcn_global_load_lds((const unsigned*)((const char*)(gbase) + (voff)[_i]), (PG8_LAS unsigned*)(lds + (bufoff) + ldsw + _i * 8192), 16, 0, 0); } while (0)
#define PG8_LDA(dst, b, h) do { _Pragma("unroll") for (int m = 0; m < 4; ++m) FragSel<FP8>::load(dst[m], lds + PG8_SA(b, h) + aoff + m * 2048); } while (0)
#define PG8_LDB(dst, b, h) do { _Pragma("unroll") for (int n = 0; n < 2; ++n) FragSel<FP8>::load(dst[n], lds + PG8_SB(b, h) + boff + n * 2048); } while (0)
#define PG8_MMA(ai, bj, At, Bt) do { __builtin_amdgcn_s_setprio(1); \
        _Pragma("unroll") for (int m = 0; m < 4; ++m) _Pragma("unroll") for (int n = 0; n < 2; ++n) acc[ai][bj][m][n] = FragSel<FP8>::mma(Bt[n], At[m], acc[ai][bj][m][n], sc7f); \
        __builtin_amdgcn_s_setprio(0); } while (0)
#define PG8_WAIT_V(n) asm volatile("s_waitcnt vmcnt(" #n ")" ::: "memory")
#define PG8_WAIT_L(n) asm volatile("s_waitcnt lgkmcnt(" #n ")" ::: "memory")
#define PG8_BAR __builtin_amdgcn_s_barrier()
#define PG8_SCHED __builtin_amdgcn_sched_barrier(0)
    Unit cur, nxt; int ui = 0;
    if (!S.next(0, cur)) return;
    f32x4 acc[2][2][4][2];
#pragma unroll
    for (int a = 0; a < 2; ++a)
#pragma unroll
        for (int b = 0; b < 2; ++b)
#pragma unroll
            for (int m = 0; m < 4; ++m)
#pragma unroll
                for (int n = 0; n < 2; ++n) acc[a][b][m][n] = (f32x4){0.f, 0.f, 0.f, 0.f};
    typedef typename FragSel<FP8>::type frag_t;
    frag_t At[4], B0[2], B1[2];
    const char* cA = (const char*)g.A + (size_t)cur.pm * tstep; const char* cB = (const char*)g.Bt + (size_t)cur.pn * tstep;
    S.a_ready(cur);
    if constexpr (SP2) {
        PG8_STAGE(PG8_SB(0, 0), cB, voffB); PG8_STAGE(PG8_SB(0, 1), cB + hstepB, voffB); PG8_STAGE(PG8_SA(0, 0), cA, voffA); PG8_STAGE(PG8_SA(0, 1), cA + hstep, voffA);
        if (wr == 1) PG8_BAR;
        PG8_WAIT_V(2); PG8_BAR;
        PG8_STAGE(PG8_SB(1, 0), cB + kstep, voffB); PG8_STAGE(PG8_SA(1, 0), cA + kstep, voffA); PG8_STAGE(PG8_SB(1, 1), cB + hstepB + kstep, voffB);
        PG8_WAIT_V(6); PG8_BAR;
    } else {
        PG8_STAGE(PG8_SB(0, 0), cB, voffB); PG8_STAGE(PG8_SA(0, 0), cA, voffA); PG8_STAGE(PG8_SB(0, 1), cB + hstepB, voffB); PG8_STAGE(PG8_SA(0, 1), cA + hstep, voffA);
        if (wr == 1) PG8_BAR;
        PG8_WAIT_V(4); PG8_BAR;
        PG8_STAGE(PG8_SB(1, 0), cB + kstep, voffB); PG8_STAGE(PG8_SA(1, 0), cA + kstep, voffA); PG8_STAGE(PG8_SB(1, 1), cB + hstepB + kstep, voffB);
        PG8_WAIT_V(6); PG8_BAR;
    }
    for (;;) {
        const bool has_next = S.next(ui + 1, nxt);
        const char* nA = has_next ? (const char*)g.A + (size_t)nxt.pm * tstep : cA; const char* nB = has_next ? (const char*)g.Bt + (size_t)nxt.pn * tstep : cB;
        for (int t = 0; t < nt; t += 2) {
            const bool last = (t == nt - 2);
            const char* a1 = cA + (size_t)(t + 1) * kstep;
            const char* a2 = last ? nA : cA + (size_t)(t + 2) * kstep; const char* b2 = last ? nB : cB + (size_t)(t + 2) * kstep;
            const char* a3 = a2 + kstep; const char* b3 = b2 + kstep;
            if (last && has_next) S.a_ready(nxt);
            if constexpr (SP2) {
            PG8_LDB(B0, 0, 0); PG8_LDB(B1, 0, 1); PG8_SCHED; PG8_LDA(At, 0, 0); PG8_STAGE(PG8_SA(1, 1), a1 + hstep, voffA);
            PG8_WAIT_V(8); PG8_WAIT_L(0); PG8_BAR; PG8_MMA(0, 0, At, B0); PG8_MMA(0, 1, At, B1); PG8_BAR; PG8_SCHED;
            PG8_LDA(At, 0, 1); PG8_STAGE(PG8_SB(0, 0), b2, voffB); PG8_STAGE(PG8_SB(0, 1), b2 + hstepB, voffB); PG8_STAGE(PG8_SA(0, 0), a2, voffA);
            PG8_WAIT_V(8); PG8_WAIT_L(0); PG8_BAR; PG8_MMA(1, 0, At, B0); PG8_MMA(1, 1, At, B1); PG8_BAR; PG8_SCHED;
            PG8_LDB(B0, 1, 0); PG8_LDB(B1, 1, 1); PG8_SCHED; PG8_LDA(At, 1, 0); PG8_STAGE(PG8_SA(0, 1), a2 + hstep, voffA);
            PG8_WAIT_V(8); PG8_WAIT_L(0); PG8_BAR; PG8_MMA(0, 0, At, B0); PG8_MMA(0, 1, At, B1); PG8_BAR; PG8_SCHED;
            PG8_LDA(At, 1, 1); PG8_STAGE(PG8_SB(1, 0), b3, voffB); PG8_STAGE(PG8_SB(1, 1), b3 + hstepB, voffB); PG8_STAGE(PG8_SA(1, 0), a3, voffA);
            PG8_WAIT_V(8); PG8_WAIT_L(0); PG8_BAR; PG8_MMA(1, 0, At, B0); PG8_MMA(1, 1, At, B1); PG8_BAR; PG8_SCHED;
            } else {
            PG8_LDB(B0, 0, 0); PG8_SCHED; PG8_LDA(At, 0, 0); PG8_STAGE(PG8_SA(1, 1), a1 + hstep, voffA);
            PG8_WAIT_L(8); PG8_BAR; PG8_WAIT_L(0); PG8_MMA(0, 0, At, B0); PG8_BAR; PG8_SCHED;
            PG8_LDB(B1, 0, 1); PG8_STAGE(PG8_SB(0, 0), b2, voffB);
            PG8_BAR; PG8_WAIT_L(0); PG8_MMA(0, 1, At, B1); PG8_BAR;
            PG8_LDA(At, 0, 1); PG8_STAGE(PG8_SA(0, 0), a2, voffA);
            PG8_BAR; PG8_WAIT_L(0); PG8_MMA(1, 0, At, B0); PG8_BAR; PG8_SCHED;
            PG8_STAGE(PG8_SB(0, 1), b2 + hstepB, voffB);
            PG8_WAIT_V(6); PG8_BAR; PG8_MMA(1, 1, At, B1); PG8_BAR;
            PG8_LDB(B0, 1, 0); PG8_SCHED; PG8_LDA(At, 1, 0); PG8_STAGE(PG8_SA(0, 1), a2 + hstep, voffA);
            PG8_WAIT_L(8); PG8_BAR; PG8_WAIT_L(0); PG8_MMA(0, 0, At, B0); PG8_BAR; PG8_SCHED;
            PG8_LDB(B1, 1, 1); PG8_STAGE(PG8_SB(1, 0), b3, voffB);
            PG8_BAR; PG8_WAIT_L(0); PG8_MMA(0, 1, At, B1); PG8_BAR;
            PG8_LDA(At, 1, 1); PG8_STAGE(PG8_SA(1, 0), a3, voffA);
            PG8_BAR; PG8_WAIT_L(0); PG8_MMA(1, 0, At, B0); PG8_BAR; PG8_SCHED;
            PG8_STAGE(PG8_SB(1, 1), b3 + hstepB, voffB);
            PG8_WAIT_V(6); PG8_BAR; PG8_MMA(1, 1, At, B1); PG8_BAR;
            }
            if constexpr (MidTiles<Epi>::v > 0) { if (t + 2 == MidTiles<Epi>::v) { asm volatile("s_nop 15\n\ts_nop 15" ::: "memory"); E.mid(acc, cur, wr, wc, fr, fq); } }
        }
        if constexpr (ALIGN_EPI) { if (wr == 0) PG8_BAR; }
        if constexpr (FP8) asm volatile("s_nop 15\n\ts_nop 15" ::: "memory");
        if constexpr (!Epi::AFTER_DRAIN) E(acc, cur, wr, wc, fr, fq);
        if (!has_next) break;
#pragma unroll
        for (int a = 0; a < 2; ++a)
#pragma unroll
            for (int b = 0; b < 2; ++b)
#pragma unroll
                for (int m = 0; m < 4; ++m)
#pragma unroll
                    for (int n = 0; n < 2; ++n) acc[a][b][m][n] = (f32x4){0.f, 0.f, 0.f, 0.f};
        cur = nxt; cA = nA; cB = nB; ++ui;
        if constexpr (ALIGN_EPI) { if (wr == 1) PG8_BAR; }
    }
    PG8_WAIT_V(0);
    if constexpr (!ALIGN_EPI) { if (wr == 0) PG8_BAR; }
    PG8_BAR;
    if constexpr (Epi::AFTER_DRAIN) E.fused(acc, cur, wr, wc, fr, fq, lds);
#undef PG8_SA
#undef PG8_SB
#undef PG8_STAGE
#undef PG8_LDA
#undef PG8_LDB
#undef PG8_MMA
#undef PG8_WAIT_V
#undef PG8_WAIT_L
#undef PG8_BAR
#undef PG8_SCHED
}
}
using pg8::cvt_pk_bf16;

#define XB_TMO      128
#define XB_XCNT(j)  (256  + 64 * (j))
#define XB_XSUB(j)  (1280 + 64 * (j))
#define XB_XGEN(j)  (2304 + 64 * (j))
#define XB_TOP      3328
#define XB_TOPGEN   3392
#define XCD_BAR_WORDS 3456
#define XB_SPIN_CAP (1u << 18)
__device__ __forceinline__ unsigned xb_ld(unsigned* p)              { return __hip_atomic_load(p, __ATOMIC_RELAXED, __HIP_MEMORY_SCOPE_AGENT); }
__device__ __forceinline__ unsigned xb_add(unsigned* p, unsigned v) { return __hip_atomic_fetch_add(p, v, __ATOMIC_RELAXED, __HIP_MEMORY_SCOPE_AGENT); }
__device__ __forceinline__ unsigned xb_xcc_id() { return (unsigned)__builtin_amdgcn_s_getreg((3 << 11) | 20) & 0xFu; }
#define XB_SPIN(cond, bar) do { unsigned _sp = 0; while (cond) { __builtin_amdgcn_s_sleep(1); \
    if ((++_sp & 255u) == 0u) { if (xb_ld(&(bar)[XB_TMO])) break; if (_sp > XB_SPIN_CAP) { atomicAdd(&(bar)[XB_TMO], 1u); break; } } } } while (0)
struct XcdBarrier { unsigned* bar; unsigned x; volatile LAS unsigned* st; };
__device__ __forceinline__ XcdBarrier xcd_barrier_post(unsigned* bar, volatile LAS unsigned* st) {
    XcdBarrier b; b.bar = bar; b.x = xb_xcc_id(); b.st = st;
    if (threadIdx.x == 0) (void)xb_add(&bar[XB_XCNT(b.x)], 1u);
    return b;
}
__device__ __forceinline__ void xcd_barrier_complete(unsigned* bar, unsigned x, unsigned& nloc, unsigned& nx) {
    const unsigned G = gridDim.x * gridDim.y * gridDim.z;
    unsigned sum, cnt, mine, sp = 0u;
    for (;;) {
        sum = 0u; cnt = 0u; mine = 0u;
#pragma unroll
        for (unsigned j = 0; j < 16; ++j) { const unsigned c = xb_ld(&bar[XB_XCNT(j)]); sum += c; cnt += (c > 0u) ? 1u : 0u; mine = (j == x) ? c : mine; }
        if (sum == G) break;
        __builtin_amdgcn_s_sleep(1);
        if ((++sp & 255u) == 0u) { if (xb_ld(&bar[XB_TMO])) break; if (sp > XB_SPIN_CAP) { atomicAdd(&bar[XB_TMO], 1u); break; } }
    }
    nloc = mine > 0u ? mine : 1u; nx = cnt > 0u ? cnt : 1u;
}
__device__ __forceinline__ void xcd_barrier(const XcdBarrier& b) {
    asm volatile("s_waitcnt vmcnt(0)" ::: "memory");
    __syncthreads();
    if (threadIdx.x == 0) {
        unsigned* bar = b.bar;
        __builtin_amdgcn_s_waitcnt(0);
        unsigned nloc = b.st[0], nx = b.st[1];
        if (nloc == 0u) { xcd_barrier_complete(bar, b.x, nloc, nx); b.st[0] = nloc; b.st[1] = nx; }
        const unsigned old = xb_add(&bar[XB_XSUB(b.x)], 1u);
        const unsigned gen = old / nloc;
        if (old + 1u == (gen + 1u) * nloc) {
            __builtin_amdgcn_fence(__ATOMIC_RELEASE, "agent");
            asm volatile("s_waitcnt vmcnt(0)" ::: "memory");
            const unsigned og = xb_add(&bar[XB_TOP], 1u);
            const unsigned tg = og / nx;
            if (og + 1u == (tg + 1u) * nx) xb_add(&bar[XB_TOPGEN], 1u);
            else XB_SPIN(xb_ld(&bar[XB_TOPGEN]) == tg, bar);
            __builtin_amdgcn_fence(__ATOMIC_ACQUIRE, "agent");
            xb_add(&bar[XB_XGEN(b.x)], 1u);
            asm volatile("s_waitcnt vmcnt(0)" ::: "memory");
        } else {
            XB_SPIN(xb_ld(&bar[XB_XGEN(b.x)]) == gen, bar);
            __builtin_amdgcn_fence(__ATOMIC_ACQUIRE, "agent");
            asm volatile("s_waitcnt vmcnt(0)" ::: "memory");
        }
    }
    __syncthreads();
}

struct Args { const float* in[18]; float* out; unsigned char* ws; int ph_lo, ph_hi, li, pad; };
enum { I_X = 0, I_P, I_NORM_MIX, I_W_IN, I_QKN_NA, I_RPB, I_QKN_DIL, I_W_BNA, I_W_BDIL, I_W_OUT, I_NORM_FFN, I_WQ, I_SUBK, I_EU, I_EV, I_NORM_PLE, I_W_PLEG, I_W_PLE };

__device__ __forceinline__ int opaque_tid() { int t = threadIdx.x; asm volatile("" : "+v"(t)); return t; }
struct Ctx {
    LAS unsigned char* lds;
    int G, vcu;
    const Args* a;
};
#define CTX_LANES() const int tid_ = opaque_tid(); const int lane = tid_ & 63; const int wave = __builtin_amdgcn_readfirstlane(tid_ >> 6); (void)lane; (void)wave

__device__ __forceinline__ unsigned pk4_fp8(float a, float b, float c, float d) { int w = 0; w = __builtin_amdgcn_cvt_pk_fp8_f32(a, b, w, false); w = __builtin_amdgcn_cvt_pk_fp8_f32(c, d, w, true); return (unsigned)w; }
constexpr float W8_SCALE = 64.0f, A8_SCALE = 8.0f;
__device__ __forceinline__ void p0_transpose_item(const float* W, const float* gain, int K, int N, bf16_t* WT, LAS float* scr, int item, int lane) {
    const int nblk = N / 32, kb = item / nblk, nb = item % nblk, k0 = 64 * kb, n0 = 32 * nb;
    f32x4 t[8];
#pragma unroll
    for (int i = 0; i < 8; ++i) t[i] = __builtin_nontemporal_load((const f32x4*)(W + (size_t)(k0 + 8 * i + (lane >> 3)) * N + n0 + 4 * (lane & 7)));
#pragma unroll
    for (int i = 0; i < 8; ++i) { const int kk = 8 * i + (lane >> 3); f32x4 w = t[i]; if (gain) w *= gain[k0 + kk]; LAS float* d = scr + kk * 33 + 4 * (lane & 7); d[0] = w.x; d[1] = w.y; d[2] = w.z; d[3] = w.w; }
    asm volatile("s_waitcnt lgkmcnt(0)" ::: "memory");
    const int c = lane & 7;
#pragma unroll
    for (int j = 0; j < 4; ++j) { const int n = (lane >> 3) + 8 * j; const LAS float* s = scr + (8 * c) * 33 + n;
        u32x4 o; o.x = pk2(s[0 * 33], s[1 * 33]); o.y = pk2(s[2 * 33], s[3 * 33]); o.z = pk2(s[4 * 33], s[5 * 33]); o.w = pk2(s[6 * 33], s[7 * 33]);
        *(u32x4*)(WT + (size_t)(n0 + n) * K + k0 + 8 * c) = o; }
    asm volatile("s_waitcnt lgkmcnt(0)" ::: "memory");
}

__device__ __forceinline__ void p0_transpose_item_fp8(const float* W, const float* gain, int K, int N, unsigned char* WT, LAS float* scr, int item, int lane, int pitch = 0) {
    if (pitch == 0) pitch = K;
    const int nblk = N / 32, kb = item / nblk, nb = item % nblk, k0 = 64 * kb, n0 = 32 * nb;
    f32x4 t[8];
#pragma unroll
    for (int i = 0; i < 8; ++i) t[i] = __builtin_nontemporal_load((const f32x4*)(W + (size_t)(k0 + 8 * i + (lane >> 3)) * N + n0 + 4 * (lane & 7)));
#pragma unroll
    for (int i = 0; i < 8; ++i) { const int kk = 8 * i + (lane >> 3); f32x4 w = t[i] * W8_SCALE; if (gain) w *= gain[k0 + kk]; LAS float* d = scr + kk * 33 + 4 * (lane & 7); d[0] = w.x; d[1] = w.y; d[2] = w.z; d[3] = w.w; }
    asm volatile("s_waitcnt lgkmcnt(0)" ::: "memory");
    const int c = lane & 7;
#pragma unroll
    for (int j = 0; j < 4; ++j) { const int n = (lane >> 3) + 8 * j; const LAS float* s = scr + (8 * c) * 33 + n;
        *(u32x2*)(WT + (size_t)(n0 + n) * pitch + k0 + 8 * c) = (u32x2){pk4_fp8(s[0 * 33], s[1 * 33], s[2 * 33], s[3 * 33]), pk4_fp8(s[4 * 33], s[5 * 33], s[6 * 33], s[7 * 33])}; }
    asm volatile("s_waitcnt lgkmcnt(0)" ::: "memory");
}
__device__ __forceinline__ void phase_prologue(const Ctx& C) {
    const Args& A = *C.a; unsigned char* ws = A.ws; CTX_LANES();
    LAS float* scr = (LAS float*)(C.lds + wave * 16384);
    const int gw = C.vcu * 8 + wave, NGW = C.G * 8;
    for (int rp_ = 0; rp_ < 1 + ((PROBE_PRO >> 0) & 1); ++rp_)
    {
        constexpr int I_IN = (D / 64) * (IN_W / 32), I_NA = (512 / 64) * (D / 32), I_DL = (256 / 64) * (D / 32), I_OUT = (D / 64) * (D / 32), I_G = I_OUT, I_PL = (256 / 64) * (D / 32);
        constexpr int NITEMS = I_IN + I_NA + I_DL + I_OUT + I_G + I_PL;
        for (int it = gw; it < NITEMS; it += NGW) {
            int r = it;
            if (r < I_IN) { p0_transpose_item_fp8(A.in[I_W_IN], A.in[I_NORM_MIX], D, IN_W, ws + WS_WIN, scr, r, lane); continue; } r -= I_IN;
            if (r < I_NA) { p0_transpose_item_fp8(A.in[I_W_BNA], nullptr, 512, D, ws + WS_WNA, scr, r, lane, ACAT); continue; } r -= I_NA;
            if (r < I_DL) { p0_transpose_item_fp8(A.in[I_W_BDIL], nullptr, 256, D, ws + WS_WNA + 512, scr, r, lane, ACAT); continue; } r -= I_DL;
            if (r < I_OUT) { p0_transpose_item_fp8(A.in[I_W_OUT], nullptr, D, D, ws + WS_WOUT, scr, r, lane); continue; } r -= I_OUT;
            if (r < I_G) { p0_transpose_item(A.in[I_W_PLEG], A.in[I_NORM_PLE], D, D, (bf16_t*)(ws + WS_WG), scr, r, lane); continue; } r -= I_G;
            p0_transpose_item(A.in[I_W_PLE], nullptr, 256, D, (bf16_t*)(ws + WS_WPLE), scr, r, lane);
        }
    }
    for (int rp_ = 0; rp_ < 1 + ((PROBE_PRO >> 1) & 1); ++rp_)
    {
        const float* wq = A.in[I_WQ]; const float* sk = A.in[I_SUBK]; const float* gf = A.in[I_NORM_FFN];
        bf16_t* wsc = (bf16_t*)(ws + WS_WSC);
        for (int it = gw; it < 16 * 64; it += NGW) {
            const int hs = it >> 6, k0 = (it & 63) * 16, side = hs & 1;
#pragma unroll
            for (int i = 0; i < 8; ++i) { const int e = i * 64 + lane; const int kk = e >> 5, c4 = e & 31;
                *(LAS f32x4*)(scr + kk * 128 + c4 * 4) = *(const f32x4*)(wq + (size_t)(k0 + kk) * 2048 + hs * 128 + c4 * 4); }
            asm volatile("s_waitcnt lgkmcnt(0)" ::: "memory");
            float acc0[16], acc1[16];
#pragma unroll
            for (int kk = 0; kk < 16; ++kk) { acc0[kk] = 0.f; acc1[kk] = 0.f; }
            const float* r0 = sk + ((size_t)side * 128 + lane) * 128; const float* r1 = r0 + 64 * 128;
#pragma unroll 8
            for (int d4 = 0; d4 < 32; ++d4) {
                const f32x4 a = *(const f32x4*)(r0 + d4 * 4), b = *(const f32x4*)(r1 + d4 * 4);
#pragma unroll
                for (int kk = 0; kk < 16; ++kk) { const f32x4 w = *(const LAS f32x4*)(scr + kk * 128 + d4 * 4);
                    acc0[kk] += a.x * w.x + a.y * w.y + a.z * w.z + a.w * w.w; acc1[kk] += b.x * w.x + b.y * w.y + b.z * w.z + b.w * w.w; }
            }
            unsigned o0[8], o1[8];
#pragma unroll
            for (int j = 0; j < 8; ++j) { const float g0 = gf[k0 + 2 * j], g1 = gf[k0 + 2 * j + 1]; o0[j] = pk2(acc0[2 * j] * g0, acc0[2 * j + 1] * g1); o1[j] = pk2(acc1[2 * j] * g0, acc1[2 * j + 1] * g1); }
            bf16_t* d0 = wsc + (size_t)(hs * 128 + lane) * D + k0; bf16_t* d1 = d0 + (size_t)64 * D;
            *(u32x4*)d0 = (u32x4){o0[0], o0[1], o0[2], o0[3]}; *(u32x4*)(d0 + 8) = (u32x4){o0[4], o0[5], o0[6], o0[7]};
            *(u32x4*)d1 = (u32x4){o1[0], o1[1], o1[2], o1[3]}; *(u32x4*)(d1 + 8) = (u32x4){o1[4], o1[5], o1[6], o1[7]};
            asm volatile("s_waitcnt lgkmcnt(0)" ::: "memory");
        }
    }
    for (int rp_ = 0; rp_ < 1 + ((PROBE_PRO >> 2) & 1); ++rp_)
    {
        const size_t gt = (size_t)(C.vcu * 512 + tid_), NT = (size_t)C.G * 512;
#define CVT_PASS(SRC, DST, CNT) do { const float* s_ = (SRC); bf16_t* d_ = (DST); const size_t c_ = (CNT); \
            for (size_t i = gt; i < c_; i += 4 * NT) { f32x4 a_[4], b_[4]; \
                _Pragma("unroll") for (int q = 0; q < 4; ++q) { const size_t iq = i + q * NT; if (iq < c_) { a_[q] = __builtin_nontemporal_load((const f32x4*)(s_ + iq * 8)); b_[q] = __builtin_nontemporal_load((const f32x4*)(s_ + iq * 8 + 4)); } } \
                _Pragma("unroll") for (int q = 0; q < 4; ++q) { const size_t iq = i + q * NT; if (iq < c_) *(u32x4*)(d_ + iq * 8) = (u32x4){pk2(a_[q].x, a_[q].y), pk2(a_[q].z, a_[q].w), pk2(b_[q].x, b_[q].y), pk2(b_[q].z, b_[q].w)}; } } } while (0)
        CVT_PASS(A.in[I_P], (bf16_t*)(ws + WS_PB), (size_t)T * 256 / 8);
#undef CVT_PASS
        float* ct = (float*)(ws + WS_COS); float* st = (float*)(ws + WS_SIN);
        for (size_t i = gt; i < 4096 * 8; i += NT) {
            const int pos = (int)(i >> 3), f = (int)(i & 7);
            const float invf[8] = {1.0f, 0.19392274f, 0.03760603f, 0.0072926646f, 0.0014142136f, 0.0002742482f, 5.3182957e-05f, 1.0313385e-05f};
            float fr_ = invf[0];
#pragma unroll
            for (int q = 1; q < 8; ++q) fr_ = (f == q) ? invf[q] : fr_;
            const float ang = (float)pos * fr_;
            double tt = (double)ang * 0.15915494309189535; tt -= floor(tt);
            ct[i] = __builtin_amdgcn_cosf((float)tt); st[i] = __builtin_amdgcn_sinf((float)tt);
        }
    }
    for (int rp_ = 0; rp_ < 1 + ((PROBE_PRO >> 3) & 1); ++rp_)
    {
        auto load_rows = [&](f32x4 (&v)[4][4], const int rr0) __attribute__((always_inline)) {
#pragma unroll
            for (int r = 0; r < 4; ++r) { const int rr = rr0 + r, e = rr & (NEXP - 1), which = rr >> 14;
                const float* src = (which ? A.in[I_EV] : A.in[I_EU]) + (size_t)e * D + 16 * lane;
#pragma unroll
                for (int j = 0; j < 4; ++j) v[r][j] = __builtin_nontemporal_load((const f32x4*)(src + 4 * j)); }
        };
        auto quant_rows = [&](const f32x4 (&v)[4][4], const int rr0) __attribute__((always_inline)) {
#pragma unroll
            for (int r = 0; r < 4; ++r) { const int rr = rr0 + r, e = rr & (NEXP - 1), which = rr >> 14;
                float ss = 0.f;
#pragma unroll
                for (int j = 0; j < 4; ++j) ss += (v[r][j].x * v[r][j].x + v[r][j].y * v[r][j].y) + (v[r][j].z * v[r][j].z + v[r][j].w * v[r][j].w);
                ss = wave_sum_dpp(ss);
                const float rms = sqrtf(ss * (1.0f / D));
                const float sc = which ? 0.5f * rms : 0.335f * rms, inv = rms > 0.f ? 1.0f / sc : 0.f;
                unsigned w[2];
                if (which) {
#define NIB_FP4(x_) ({ const float t_ = (x_) * inv; const float a_ = fabsf(t_); \
                       (unsigned)((a_ >= 0.25f) + (a_ >= 0.75f) + (a_ >= 1.25f) + (a_ >= 1.75f) + (a_ >= 2.5f) + (a_ >= 3.5f) + (a_ >= 5.0f)) | (t_ < 0.f ? 8u : 0u); })
#pragma unroll
                    for (int hh = 0; hh < 2; ++hh) { const f32x4 a = v[r][2 * hh], b = v[r][2 * hh + 1];
                        w[hh] = NIB_FP4(a.x) | (NIB_FP4(a.y) << 4) | (NIB_FP4(a.z) << 8) | (NIB_FP4(a.w) << 12) | (NIB_FP4(b.x) << 16) | (NIB_FP4(b.y) << 20) | (NIB_FP4(b.z) << 24) | (NIB_FP4(b.w) << 28); }
#undef NIB_FP4
                } else {
#define NIB_I4(x_) ((unsigned)(int)fminf(fmaxf(__builtin_rintf((x_) * inv), -8.f), 7.f) & 15u)
#pragma unroll
                    for (int hh = 0; hh < 2; ++hh) { const f32x4 a = v[r][2 * hh], b = v[r][2 * hh + 1];
                        w[hh] = NIB_I4(a.x) | (NIB_I4(b.x) << 4) | (NIB_I4(a.y) << 8) | (NIB_I4(b.y) << 12) | (NIB_I4(a.z) << 16) | (NIB_I4(b.z) << 20) | (NIB_I4(a.w) << 24) | (NIB_I4(b.w) << 28); }
#undef NIB_I4
                }
                *(u32x2*)(ws + (which ? WS_EV : WS_EU) + (size_t)(lane >> 4) * (NEXP * 128) + (size_t)e * 128 + 8 * (lane & 15)) = (u32x2){w[0], w[1]};
                if (lane == 0) ((float*)(ws + (which ? WS_SV : WS_SU)))[e] = sc; }
        };
        {
            f32x4 va[4][4], vb[4][4];
            const int step = NGW * 4, end = 2 * NEXP, r0 = gw * 4;
            const int nb = r0 < end ? (end - r0 + step - 1) / step : 0;
            if (nb > 0) load_rows(va, r0);
            int k = 0;
#pragma unroll 1
            for (; k + 2 < nb; k += 2) {
                load_rows(vb, r0 + (k + 1) * step); quant_rows(va, r0 + k * step);
                load_rows(va, r0 + (k + 2) * step); quant_rows(vb, r0 + (k + 1) * step);
            }
            if (k + 1 < nb) { load_rows(vb, r0 + (k + 1) * step); quant_rows(va, r0 + k * step); quant_rows(vb, r0 + (k + 1) * step); }
            else if (k < nb) quant_rows(va, r0 + k * step);
        }
    }
    for (int rp_ = 0; rp_ < 1 + ((PROBE_PRO >> 4) & 1); ++rp_)
    {
        const float* x = A.in[I_X]; bf16_t* xb = (bf16_t*)((unsigned char*)A.out + DO_XB); float* rs = (float*)(ws + WS_RSTD1);
        auto load_x = [&](f32x4 (&v)[4][4], const int m0) __attribute__((always_inline)) {
#pragma unroll
            for (int r = 0; r < 4; ++r) { const f32x4* xr = (const f32x4*)(x + (size_t)(m0 + r) * D) + lane * 2;
#pragma unroll
                for (int j = 0; j < 2; ++j) { v[r][2 * j] = xr[128 * j]; v[r][2 * j + 1] = xr[128 * j + 1]; } }
        };
        auto conv_x = [&](const f32x4 (&v)[4][4], const int m0) __attribute__((always_inline)) {
#pragma unroll
            for (int r = 0; r < 4; ++r) { float s = 0.f;
#pragma unroll
                for (int j = 0; j < 4; ++j) s += (v[r][j].x * v[r][j].x + v[r][j].y * v[r][j].y) + (v[r][j].z * v[r][j].z + v[r][j].w * v[r][j].w);
                s = wave_sum_dpp(s);
                if (lane == 0) rs[m0 + r] = 1.0f / sqrtf(s * (1.0f / D) + RMS_EPS);
                u32x2* o = (u32x2*)((unsigned char*)xb + (size_t)(m0 + r) * D) + lane;
#pragma unroll
                for (int j = 0; j < 2; ++j) o[64 * j] = (u32x2){pk4_fp8(v[r][2 * j].x, v[r][2 * j].y, v[r][2 * j].z, v[r][2 * j].w), pk4_fp8(v[r][2 * j + 1].x, v[r][2 * j + 1].y, v[r][2 * j + 1].z, v[r][2 * j + 1].w)}; }
        };
        {
            f32x4 va[4][4], vb[4][4];
            const int step = NGW * 4, r0 = gw * 4;
            const int nb = r0 < T ? (T - r0 + step - 1) / step : 0;
            if (nb > 0) load_x(va, r0);
            int k = 0;
#pragma unroll 1
            for (; k + 2 < nb; k += 2) {
                load_x(vb, r0 + (k + 1) * step); conv_x(va, r0 + k * step);
                load_x(va, r0 + (k + 2) * step); conv_x(vb, r0 + (k + 1) * step);
            }
            if (k + 1 < nb) { load_x(vb, r0 + (k + 1) * step); conv_x(va, r0 + k * step); conv_x(vb, r0 + (k + 1) * step); }
            else if (k < nb) conv_x(va, r0 + k * step);
        }
    }
}

using pg8::Unit;
struct EpiProj {
    static constexpr bool AFTER_DRAIN = false;
    const float* rstd; const float* qkn_na; const float* qkn_dil; const float* cosT; const float* sinT;
    unsigned char* wsb;
    __device__ __forceinline__ void operator()(const f32x4 (&acc)[2][2][4][2], const Unit& u, int wr, int wc, int fr, int fq) const {
        const int pn = u.pn;
        int kind, sub;
        if (pn < 6) { kind = pn >> 1; sub = pn & 1; } else if (pn < 15) { kind = 3 + (pn - 6) / 3; sub = (pn - 6) % 3; } else { kind = 6; sub = pn - 15; }
        const bool is_qk = (kind == 0 || kind == 1 || kind == 3 || kind == 4);
        const bool is_dil = (kind >= 3 && kind <= 5);
        const float* gainp = (kind < 3 ? qkn_na : qkn_dil) + ((kind == 1 || kind == 4) ? 64 : 0);
        float gn[2][8];
#pragma unroll
        for (int bj = 0; bj < 2; ++bj) {
            if (is_qk) { const f32x4 g0 = *(const f32x4*)(gainp + 32 * bj + 8 * fq), g1 = *(const f32x4*)(gainp + 32 * bj + 8 * fq + 4);
                gn[bj][0] = g0.x; gn[bj][1] = g0.y; gn[bj][2] = g0.z; gn[bj][3] = g0.w; gn[bj][4] = g1.x; gn[bj][5] = g1.y; gn[bj][6] = g1.z; gn[bj][7] = g1.w; }
            else {
#pragma unroll
                for (int j = 0; j < 8; ++j) gn[bj][j] = 1.f; }
        }
        const float qs = (kind == 0 || kind == 3) ? QSCALE : 1.0f;
        const size_t boff = kind < 3 ? (WS_QNA + (size_t)kind * (WS_KNA - WS_QNA)) : (kind < 6 ? (WS_QDIL + (size_t)(kind - 3) * (WS_KDIL - WS_QDIL)) : WS_GATES);
        bf16_t* base = (bf16_t*)(wsb + boff);
        float rsv[8];
#pragma unroll
        for (int q = 0; q < 8; ++q) rsv[q] = rstd[u.pm * 256 + (q >> 2) * 128 + wr * 64 + (q & 3) * 16 + fr] * (1.0f / W8_SCALE);
        const float fr0 = 0.15915494f, fr1 = 0.030863762f, fr2 = 0.0059851858f, fr3 = 0.0011606637f, fr4 = 0.00022508f, fr5 = 4.3648e-05f, fr6 = 8.4643e-06f, fr7 = 1.6414e-06f;
#pragma unroll
        for (int ai = 0; ai < 2; ++ai)
#pragma unroll
            for (int m = 0; m < 4; ++m) {
                const int row = u.pm * 256 + ai * 128 + wr * 64 + m * 16 + fr;
                const float rs = rsv[ai * 4 + m];
                float v[2][8];
#pragma unroll
                for (int bj = 0; bj < 2; ++bj)
#pragma unroll
                    for (int n = 0; n < 2; ++n)
#pragma unroll
                        for (int j = 0; j < 4; ++j) v[bj][4 * n + j] = acc[ai][bj][m][n][j] * rs;
                if (kind == 6) {
                    bf16_t* rowp = base + (size_t)row * 2048 + sub * 256 + wc * 64 + 8 * fq;
#pragma unroll
                    for (int bj = 0; bj < 2; ++bj) { u32x4 w;
                        w.x = cvt_pk_bf16(sigmoidf_(v[bj][0]), sigmoidf_(v[bj][1])); w.y = cvt_pk_bf16(sigmoidf_(v[bj][2]), sigmoidf_(v[bj][3]));
                        w.z = cvt_pk_bf16(sigmoidf_(v[bj][4]), sigmoidf_(v[bj][5])); w.w = cvt_pk_bf16(sigmoidf_(v[bj][6]), sigmoidf_(v[bj][7]));
                        *(u32x4*)(rowp + 32 * bj) = w; }
                    continue;
                }
                if (is_qk) {
                    float ss = 0.f;
#pragma unroll
                    for (int bj = 0; bj < 2; ++bj)
#pragma unroll
                        for (int j = 0; j < 8; ++j) ss += v[bj][j] * v[bj][j];
                    ss = sum_x16_x32(ss);
                    const float r = 1.0f / sqrtf(ss * (1.0f / 64.0f) + RMS_EPS);
#pragma unroll
                    for (int bj = 0; bj < 2; ++bj)
#pragma unroll
                        for (int j = 0; j < 8; ++j) v[bj][j] = v[bj][j] * r * gn[bj][j];
                    if (is_dil) {
                        const float pos = (float)(row & (SEQ - 1));
                        const float frq[8] = {fr0, fr1, fr2, fr3, fr4, fr5, fr6, fr7};
                        float cs[8], sn[8];
#pragma unroll
                        for (int j = 0; j < 8; ++j) { const float t = __builtin_amdgcn_fractf(pos * frq[j]); cs[j] = __builtin_amdgcn_cosf(t); sn[j] = __builtin_amdgcn_sinf(t); }
#pragma unroll
                        for (int j = 0; j < 8; ++j) {
                            const float own = v[0][j], oth = other_x16(own, fq << 4);
                            const float rot = (fq == 0) ? (own * cs[j] - oth * sn[j]) : (own * cs[j] + oth * sn[j]);
                            v[0][j] = (fq < 2) ? rot : own;
                        }
                    }
                }
                const int b = row >> 12, s = row & (SEQ - 1);
                size_t off;
                if (!is_dil) { const int head = sub * 4 + wc; off = ((size_t)(b * NA_H + head) * SEQ + s) * HD; }
                else { const int g = sub, sh = 2 * g, L = SEQ >> sh; const int sp = (s & ((1 << sh) - 1)) * L + (s >> sh); off = ((size_t)((b * 3 + g) * 4 + wc) * SEQ + sp) * HD; }
                bf16_t* rowp = base + off + 8 * fq;
#pragma unroll
                for (int bj = 0; bj < 2; ++bj) { u32x4 w;
                    w.x = cvt_pk_bf16(v[bj][0] * qs, v[bj][1] * qs); w.y = cvt_pk_bf16(v[bj][2] * qs, v[bj][3] * qs); w.z = cvt_pk_bf16(v[bj][4] * qs, v[bj][5] * qs); w.w = cvt_pk_bf16(v[bj][6] * qs, v[bj][7] * qs);
                    *(u32x4*)(rowp + 32 * bj) = w; }
            }
    }
};
template <int MODE> struct EpiGate {
    static constexpr bool AFTER_DRAIN = false;
    bf16_t* O; const bf16_t* G; int ldg; int gcol0; const bf16_t* P; float ascale;
    __device__ __forceinline__ void operator()(const f32x4 (&acc)[2][2][4][2], const Unit& u, int wr, int wc, int fr, int fq) const {
        const int row0 = u.pm * 256 + wr * 64 + fr, col0 = u.pn * 256 + wc * 64 + 8 * fq;
        u32x4 gq[2][2], pq[2][2];
#define EG_LOAD(buf, it) do { const int r_ = row0 + ((it) >> 2) * 128 + ((it) & 3) * 16; \
            if (MODE <= 1) { gq[buf][0] = *(const u32x4*)(G + (size_t)r_ * ldg + gcol0 + col0); gq[buf][1] = *(const u32x4*)(G + (size_t)r_ * ldg + gcol0 + col0 + 32); } \
            if (MODE == 1) { pq[buf][0] = *(const u32x4*)(P + (size_t)r_ * D + col0); pq[buf][1] = *(const u32x4*)(P + (size_t)r_ * D + col0 + 32); } } while (0)
        EG_LOAD(0, 0);
#pragma unroll
        for (int it = 0; it < 8; ++it) {
            const int ai = it >> 2, m = it & 3, row = row0 + ai * 128 + m * 16;
            if (it + 1 < 8) EG_LOAD((it + 1) & 1, it + 1);
#pragma unroll
            for (int bj = 0; bj < 2; ++bj) {
                float v[8];
#pragma unroll
                for (int n = 0; n < 2; ++n)
#pragma unroll
                    for (int j = 0; j < 4; ++j) v[4 * n + j] = acc[ai][bj][m][n][j] * ascale;
                if (MODE <= 1) { const u32x4 g = gq[it & 1][bj];
                    v[0] *= bf_lo(g.x); v[1] *= bf_hi(g.x); v[2] *= bf_lo(g.y); v[3] *= bf_hi(g.y); v[4] *= bf_lo(g.z); v[5] *= bf_hi(g.z); v[6] *= bf_lo(g.w); v[7] *= bf_hi(g.w); }
                if (MODE == 1) { const u32x4 p = pq[it & 1][bj];
                    v[0] += bf_lo(p.x); v[1] += bf_hi(p.x); v[2] += bf_lo(p.y); v[3] += bf_hi(p.y); v[4] += bf_lo(p.z); v[5] += bf_hi(p.z); v[6] += bf_lo(p.w); v[7] += bf_hi(p.w); }
                if (MODE == 1) *(u32x2*)((unsigned char*)O + (size_t)row * D + col0 + 32 * bj) = (u32x2){pk4_fp8(v[0] * A8_SCALE, v[1] * A8_SCALE, v[2] * A8_SCALE, v[3] * A8_SCALE), pk4_fp8(v[4] * A8_SCALE, v[5] * A8_SCALE, v[6] * A8_SCALE, v[7] * A8_SCALE)};
                else *(u32x4*)(O + (size_t)row * D + col0 + 32 * bj) = (u32x4){cvt_pk_bf16(v[0], v[1]), cvt_pk_bf16(v[2], v[3]), cvt_pk_bf16(v[4], v[5]), cvt_pk_bf16(v[6], v[7])};
            }
            asm volatile("" ::: "memory");
        }
#undef EG_LOAD
    }
};
struct EpiMerge {
    static constexpr bool AFTER_DRAIN = false; static constexpr int MID_TILES = 4;
    unsigned char* O; const bf16_t* G; float ascale;
    __device__ __forceinline__ void mid(f32x4 (&acc)[2][2][4][2], const Unit& u, int wr, int wc, int fr, int fq) const {
        asm volatile("" : "+v"(fr), "+v"(fq));
        const int row0 = u.pm * 256 + wr * 64 + fr, col0 = u.pn * 256 + wc * 64 + 8 * fq;
#pragma unroll
        for (int it = 0; it < 8; ++it) {
            const int ai = it >> 2, m = it & 3, row = row0 + ai * 128 + m * 16;
            const bf16_t* gp = G + (size_t)row * 2048 + col0;
#define EM_R(nw, dw, lo) ((lo ? bf_lo(nw) : bf_hi(nw)) * __builtin_amdgcn_rcpf(fmaxf(lo ? bf_lo(dw) : bf_hi(dw), 1e-30f)))
#pragma unroll
            for (int bj = 0; bj < 2; ++bj) {
                const u32x4 n0 = *(const u32x4*)(gp + 32 * bj), d0 = *(const u32x4*)(gp + 1024 + 32 * bj);
                acc[ai][bj][m][0] *= (f32x4){EM_R(n0.x, d0.x, 1), EM_R(n0.x, d0.x, 0), EM_R(n0.y, d0.y, 1), EM_R(n0.y, d0.y, 0)}; acc[ai][bj][m][1] *= (f32x4){EM_R(n0.z, d0.z, 1), EM_R(n0.z, d0.z, 0), EM_R(n0.w, d0.w, 1), EM_R(n0.w, d0.w, 0)};
                asm volatile("" ::: "memory");
            }
#undef EM_R
            asm volatile("" ::: "memory");
        }
    }
    __device__ __forceinline__ void operator()(const f32x4 (&acc)[2][2][4][2], const Unit& u, int wr, int wc, int fr, int fq) const {
        asm volatile("" : "+v"(fr), "+v"(fq));
        const int row0 = u.pm * 256 + wr * 64 + fr, col0 = u.pn * 256 + wc * 64 + 8 * fq;
        u32x4 gq[2][2];
#define EM_LOAD(buf, it) do { const bf16_t* gp_ = G + (size_t)(row0 + ((it) >> 2) * 128 + ((it) & 3) * 16) * 2048 + 1024 + col0; gq[buf][0] = *(const u32x4*)gp_; gq[buf][1] = *(const u32x4*)(gp_ + 32); } while (0)
        EM_LOAD(0, 0);
        const float sc = ascale * A8_SCALE;
#pragma unroll
        for (int it = 0; it < 8; ++it) {
            const int ai = it >> 2, m = it & 3, row = row0 + ai * 128 + m * 16;
            if (it + 1 < 8) EM_LOAD((it + 1) & 1, it + 1);
#pragma unroll
            for (int bj = 0; bj < 2; ++bj) { const u32x4 g = gq[it & 1][bj]; const f32x4 a = acc[ai][bj][m][0] * sc, b = acc[ai][bj][m][1] * sc;
                *(u32x2*)(O + (size_t)row * D + col0 + 32 * bj) = (u32x2){pk4_fp8(a.x * bf_lo(g.x), a.y * bf_hi(g.x), a.z * bf_lo(g.y), a.w * bf_hi(g.y)), pk4_fp8(b.x * bf_lo(g.z), b.y * bf_hi(g.z), b.z * bf_lo(g.w), b.w * bf_hi(g.w))}; }
            asm volatile("" ::: "memory");
        }
#undef EM_LOAD
    }
};
struct EpiResid {
    static constexpr bool AFTER_DRAIN = false;
    const float* x; float* out; bf16_t* xb; float* ssq; float ascale;
    __device__ __forceinline__ void operator()(const f32x4 (&acc)[2][2][4][2], const Unit& u, int wr, int wc, int fr, int fq) const {
        const int row0 = u.pm * 256 + wr * 64 + fr, col0 = u.pn * 256 + wc * 64 + 8 * fq;
        f32x4 xq[2][4];
#define ER_LOAD(buf, it) do { const float* p_ = x + (size_t)(row0 + ((it) >> 2) * 128 + ((it) & 3) * 16) * D + col0; \
            xq[buf][0] = *(const f32x4*)p_; xq[buf][1] = *(const f32x4*)(p_ + 4); xq[buf][2] = *(const f32x4*)(p_ + 32); xq[buf][3] = *(const f32x4*)(p_ + 36); } while (0)
        ER_LOAD(0, 0);
#pragma unroll
        for (int it = 0; it < 8; ++it) {
            const int ai = it >> 2, m = it & 3, row = row0 + ai * 128 + m * 16;
            if (it + 1 < 8) ER_LOAD((it + 1) & 1, it + 1);
            float ss = 0.f;
#pragma unroll
            for (int bj = 0; bj < 2; ++bj) {
                const size_t o = (size_t)row * D + col0 + 32 * bj;
                const f32x4 a = xq[it & 1][2 * bj] + acc[ai][bj][m][0] * ascale, b = xq[it & 1][2 * bj + 1] + acc[ai][bj][m][1] * ascale;
                *(u32x4*)(xb + o) = (u32x4){cvt_pk_bf16(a.x, a.y), cvt_pk_bf16(a.z, a.w), cvt_pk_bf16(b.x, b.y), cvt_pk_bf16(b.z, b.w)};
                ss += (a.x * a.x + a.y * a.y) + (a.z * a.z + a.w * a.w) + (b.x * b.x + b.y * b.y) + (b.z * b.z + b.w * b.w);
            }
            ss = sum_x16_x32(ss);
            if (fq == 0) ssq[(size_t)row * 16 + u.pn * 4 + wc] = ss;
            asm volatile("" ::: "memory");
        }
#undef ER_LOAD
    }
};
struct EpiScores {
    static constexpr bool AFTER_DRAIN = false;
    const float* ssq; _Float16* S;
    __device__ __forceinline__ void operator()(const f32x4 (&acc)[2][2][4][2], const Unit& u, int wr, int wc, int fr, int fq) const {
        const int row0 = u.pm * 256 + wr * 64 + fr, col0 = u.pn * 256 + wc * 64 + 8 * fq;
        float rsv[8];
#pragma unroll
        for (int it = 0; it < 8; ++it) {
            const f32x4* sp = (const f32x4*)(ssq + (size_t)(row0 + (it >> 2) * 128 + (it & 3) * 16) * 16);
            const f32x4 s0 = sp[0], s1 = sp[1], s2 = sp[2], s3 = sp[3];
            const float tot = ((s0.x + s0.y) + (s0.z + s0.w)) + ((s1.x + s1.y) + (s1.z + s1.w)) + ((s2.x + s2.y) + (s2.z + s2.w)) + ((s3.x + s3.y) + (s3.z + s3.w));
            rsv[it] = 1.0f / sqrtf(tot * (1.0f / D) + RMS_EPS);
        }
#pragma unroll
        for (int it = 0; it < 8; ++it) {
            const int ai = it >> 2, m = it & 3, row = row0 + ai * 128 + m * 16; const float rs = rsv[it];
#pragma unroll
            for (int bj = 0; bj < 2; ++bj) {
                const size_t o = (size_t)row * 2048 + col0 + 32 * bj;
                const f32x4 a = acc[ai][bj][m][0] * rs, b = acc[ai][bj][m][1] * rs;
                *(h16x8*)(S + o) = (h16x8){(_Float16)a.x, (_Float16)a.y, (_Float16)a.z, (_Float16)a.w, (_Float16)b.x, (_Float16)b.y, (_Float16)b.z, (_Float16)b.w};
            }
        }
    }
};
struct EpiFinal {
    static constexpr bool AFTER_DRAIN = false;
    float* out; const float* rstd3; const bf16_t* ple; const bf16_t* x2b;
    __device__ __forceinline__ void operator()(const f32x4 (&acc)[2][2][4][2], const Unit& u, int wr, int wc, int fr, int fq) const {
        const int row0 = u.pm * 256 + wr * 64 + fr, col0 = u.pn * 256 + wc * 64 + 8 * fq;
        u32x4 pq[2][2], xq[2][2]; f32x4 qq[2][2];
#define EF_LOAD(buf, it) do { const size_t r_ = (size_t)(row0 + ((it) >> 2) * 128 + ((it) & 3) * 16); \
            pq[buf][0] = *(const u32x4*)(ple + r_ * D + col0); pq[buf][1] = *(const u32x4*)(ple + r_ * D + col0 + 32); \
            xq[buf][0] = *(const u32x4*)(x2b + r_ * D + col0); xq[buf][1] = *(const u32x4*)(x2b + r_ * D + col0 + 32); \
            qq[buf][0] = *(const f32x4*)(rstd3 + r_ * 8); qq[buf][1] = *(const f32x4*)(rstd3 + r_ * 8 + 4); } while (0)
        EF_LOAD(0, 0);
#pragma unroll
        for (int it = 0; it < 8; ++it) {
            const int ai = it >> 2, m = it & 3, row = row0 + ai * 128 + m * 16;
            if (it + 1 < 8) EF_LOAD((it + 1) & 1, it + 1);
            const f32x4 q0 = qq[it & 1][0], q1 = qq[it & 1][1];
            const float rs = 1.0f / sqrtf((((q0.x + q0.y) + (q0.z + q0.w)) + ((q1.x + q1.y) + (q1.z + q1.w))) * (1.0f / D) + RMS_EPS);
#pragma unroll
            for (int bj = 0; bj < 2; ++bj) {
                const size_t o = (size_t)row * D + col0 + 32 * bj;
                const u32x4 p = pq[it & 1][bj], xw = xq[it & 1][bj];
                f32x4 a = (f32x4){bf_lo(xw.x), bf_hi(xw.x), bf_lo(xw.y), bf_hi(xw.y)}, b = (f32x4){bf_lo(xw.z), bf_hi(xw.z), bf_lo(xw.w), bf_hi(xw.w)};
                const f32x4 g0 = acc[ai][bj][m][0] * rs, g1 = acc[ai][bj][m][1] * rs;
                a.x += sigmoidf_(g0.x) * bf_lo(p.x); a.y += sigmoidf_(g0.y) * bf_hi(p.x); a.z += sigmoidf_(g0.z) * bf_lo(p.y); a.w += sigmoidf_(g0.w) * bf_hi(p.y);
                b.x += sigmoidf_(g1.x) * bf_lo(p.z); b.y += sigmoidf_(g1.y) * bf_hi(p.z); b.z += sigmoidf_(g1.z) * bf_lo(p.w); b.w += sigmoidf_(g1.w) * bf_hi(p.w);
                __builtin_nontemporal_store(a, (f32x4*)(out + o)); __builtin_nontemporal_store(b, (f32x4*)(out + o + 4));
            }
            asm volatile("" ::: "memory");
        }
#undef EF_LOAD
    }
};

__device__ __forceinline__ void load_row64(const bf16_t* p, float (&q)[64]) {
#pragma unroll
    for (int i = 0; i < 8; ++i) { const u32x4 w = *(const u32x4*)(p + 8 * i);
        q[8 * i + 0] = bf_lo(w.x); q[8 * i + 1] = bf_hi(w.x); q[8 * i + 2] = bf_lo(w.y); q[8 * i + 3] = bf_hi(w.y); q[8 * i + 4] = bf_lo(w.z); q[8 * i + 5] = bf_hi(w.z); q[8 * i + 6] = bf_lo(w.w); q[8 * i + 7] = bf_hi(w.w); }
}
__device__ __forceinline__ float dot_row64(const bf16_t* p, const float (&q)[64]) {
    float s = 0.f;
#pragma unroll
    for (int i = 0; i < 8; ++i) { const u32x4 w = *(const u32x4*)(p + 8 * i);
        s += q[8 * i + 0] * bf_lo(w.x) + q[8 * i + 1] * bf_hi(w.x) + q[8 * i + 2] * bf_lo(w.y) + q[8 * i + 3] * bf_hi(w.y) + q[8 * i + 4] * bf_lo(w.z) + q[8 * i + 5] * bf_hi(w.z) + q[8 * i + 6] * bf_lo(w.w) + q[8 * i + 7] * bf_hi(w.w); }
    return s;
}
__device__ __forceinline__ void phase_attention_ref(const Ctx& C) {
    const Args& A = *C.a; unsigned char* ws = A.ws; CTX_LANES();
    const int gw = C.vcu * 8 + wave, NGW = C.G * 8;
    const bf16_t* qna = (const bf16_t*)(ws + WS_QNA); const bf16_t* kna = (const bf16_t*)(ws + WS_KNA); const bf16_t* vna = (const bf16_t*)(ws + WS_VNA);
    const float* rpb = A.in[I_RPB];
    bf16_t* outna = (bf16_t*)(ws + WS_OUTNA);
    for (int it = gw; it < BATCH * NA_H * SEQ; it += NGW) {
        const int c = it & 63, r = (it >> 6) & 63, h = (it >> 12) & 7, b = it >> 15;
        const int rs = min(max(r - 4, 0), 56), cs = min(max(c - 8, 0), 48);
        const size_t hb = (size_t)(b * NA_H + h) * SEQ;
        float q[64]; load_row64(qna + (hb + r * 64 + c) * HD, q);
        float sc[2];
#pragma unroll
        for (int t = 0; t < 2; ++t) { const int kr = rs + (lane >> 4) + 4 * t, kc = cs + (lane & 15);
            const float s = dot_row64(kna + (hb + kr * 64 + kc) * HD, q);
            const float bias = rpb[(h * 15 + (kr - r + 7)) * 31 + (kc - c + 15)];
            sc[t] = s + bias * LOG2E; }
        const float mx = wave_max(fmaxf(sc[0], sc[1]));
        const float p0 = __builtin_amdgcn_exp2f(sc[0] - mx), p1 = __builtin_amdgcn_exp2f(sc[1] - mx);
        const float l = wave_sum(p0 + p1);
        float o = 0.f;
        for (int kk = 0; kk < 128; ++kk) { const int src = kk & 63; const float p = __shfl(kk < 64 ? p0 : p1, src);
            const int kr = rs + (src >> 4) + 4 * (kk >> 6), kc = cs + (src & 15);
            o += p * bf2f(vna[(hb + kr * 64 + kc) * HD + lane]); }
        outna[(size_t)(b * SEQ + r * 64 + c) * 512 + h * 64 + lane] = (bf16_t)f2bf(o / l);
    }
    const bf16_t* qd = (const bf16_t*)(ws + WS_QDIL); const bf16_t* kd = (const bf16_t*)(ws + WS_KDIL); const bf16_t* vd = (const bf16_t*)(ws + WS_VDIL);
    bf16_t* og = (bf16_t*)((unsigned char*)A.out + DO_OG); float* lse = (float*)(ws + WS_LSE);
    for (int it = gw; it < BATCH * DIL_H * SEQ; it += NGW) {
        const int sp = it & 4095, bh = it >> 12, hh = bh & 3, g = (bh >> 2) % 3, b = bh / 12;
        const int sh = 2 * g, L = SEQ >> sh, res = sp / L, mq = sp % L;
        const size_t hb = (size_t)bh * SEQ + (size_t)res * L;
        float q[64]; load_row64(qd + (hb + mq) * HD, q);
        float sc[3];
#pragma unroll
        for (int t = 0; t < 3; ++t) { const int kk = lane + 64 * t, mk = mq - 64 + kk; const bool ok = (kk <= 128) && (mk >= 0) && (mk < L);
            const int mc = min(max(mk, 0), L - 1);
            const float s = dot_row64(kd + (hb + mc) * HD, q);
            sc[t] = ok ? s : -INFINITY; }
        const float mx = wave_max(fmaxf(fmaxf(sc[0], sc[1]), sc[2]));
        float p[3];
#pragma unroll
        for (int t = 0; t < 3; ++t) p[t] = __builtin_amdgcn_exp2f(sc[t] - mx);
        const float l = wave_sum(p[0] + p[1] + p[2]);
        float o = 0.f;
        for (int kk = 0; kk <= 128; ++kk) { const int src = kk & 63; const float pv = __shfl(kk < 64 ? p[0] : (kk < 128 ? p[1] : p[2]), src);
            const int mc = min(max(mq - 64 + kk, 0), L - 1);
            o += pv * bf2f(vd[(hb + mc) * HD + lane]); }
        const int s = mq * (1 << sh) + res;
        const size_t tok = (size_t)b * SEQ + s;
        og[((size_t)g * T + tok) * 256 + hh * 64 + lane] = (bf16_t)f2bf(o / l);
        if (lane == 0) lse[((size_t)g * T + tok) * 4 + hh] = mx + __builtin_amdgcn_logf(l);
    }
}


typedef short s16x4 __attribute__((ext_vector_type(4)));
__device__ __forceinline__ void glds16(const void* g, LAS unsigned char* l) { __builtin_amdgcn_global_load_lds((const unsigned*)g, (LAS unsigned*)l, 16, 0, 0); }
__device__ __forceinline__ bf16x8 tr_pair(LAS unsigned char* p) {
    const s16x4 lo = __builtin_amdgcn_ds_read_tr16_b64_v4i16((LAS s16x4*)p), hi = __builtin_amdgcn_ds_read_tr16_b64_v4i16((LAS s16x4*)(p + 16 * 128));
    return __builtin_shufflevector(lo, hi, 0, 1, 2, 3, 4, 5, 6, 7);
}
__device__ __forceinline__ bf16x8 pack_p(const f32x4& a, const f32x4& b) {
    u32x4 w; w.x = cvt_pk_bf16(a.x, a.y); w.y = cvt_pk_bf16(a.z, a.w); w.z = cvt_pk_bf16(b.x, b.y); w.w = cvt_pk_bf16(b.z, b.w);
    return __builtin_bit_cast(bf16x8, w);
}
constexpr int DIL_KB = 32768, DIL_VB = 34816, DIL_BUF = DIL_KB + DIL_VB;
constexpr int NA_TILE = 15 * 32 * 128, NA_BIAS_OFF = 2 * NA_TILE;

struct DilUnit { int bh, g, sh, L, res, M0; };
__device__ __forceinline__ DilUnit dil_unit(int u) { DilUnit d; d.bh = u >> 5; d.g = (d.bh >> 2) % 3; d.sh = 2 * d.g; d.L = SEQ >> d.sh; const int sp0 = (u & 31) * 128; d.res = sp0 >> (12 - d.sh); d.M0 = sp0 & (d.L - 1); return d; }

__device__ __forceinline__ void phase_attention(const Ctx& C) {
    const Args& A = *C.a; unsigned char* ws = A.ws; CTX_LANES();
    const int i16 = lane & 15, g4 = lane >> 4;
    LAS unsigned char* lds = C.lds;
    const int kaddr0 = i16 * 128 + ((g4 ^ (i16 & 7)) * 16), kaddr1 = i16 * 128 + (((g4 + 4) ^ (i16 & 7)) * 16);
    int vaddr[4];
#pragma unroll
    for (int n = 0; n < 4; ++n) vaddr[n] = (4 * g4 + (i16 >> 2)) * 128 + ((n ^ (2 * (g4 & 1) + (i16 >> 3))) * 32) + (i16 & 3) * 8;
    const int lrow = lane >> 3, cpos = lane & 7;

    {
        const bf16_t* qna = (const bf16_t*)(ws + WS_QNA); const bf16_t* kna = (const bf16_t*)(ws + WS_KNA); const bf16_t* vna = (const bf16_t*)(ws + WS_VNA);
        const float* rpb = A.in[I_RPB]; bf16_t* outna = (bf16_t*)(ws + WS_OUTNA);
        LAS float* bt = (LAS float*)(lds + NA_BIAS_OFF);
        for (int u = C.vcu; u < BATCH * NA_H * 4 * 8; u += C.G) {
            const int R = u & 7, j = (u >> 3) & 3, h = (u >> 5) & 7, b = u >> 8;
            const int lo = min(max(8 * R - 4, 0), 49), kc0 = min(max(16 * j - 8, 0), 32);
            const size_t hb = (size_t)(b * NA_H + h) * SEQ;
#pragma unroll
            for (int i = 0; i < 8; ++i) { const int inst = wave + 8 * i;
                if (inst < 60) { const size_t tok = hb + (size_t)(lo + (inst >> 2)) * 64 + kc0 + 8 * (inst & 3) + lrow;
                    glds16(kna + tok * HD + ((cpos ^ lrow) * 8), lds + inst * 1024);
                    glds16(vna + tok * HD + ((cpos ^ (2 * ((lrow >> 1) & 3))) * 8), lds + NA_TILE + inst * 1024); } }
            if (tid_ < 15 * 32) { const int dr = tid_ >> 5, dc = tid_ & 31; bt[8 + tid_] = (dc < 31) ? rpb[(h * 15 + dr) * 31 + dc] * LOG2E : 0.f; }
            const int r = 8 * R + wave, rs = min(max(r - 4, 0), 56), roff = rs - lo, c = 16 * j + i16, cs = min(max(c - 8, 0), 48);
            bf16x8 qf0, qf1;
            { const bf16_t* qp = qna + (hb + r * 64 + c) * HD + 8 * g4; qf0 = *(const bf16x8*)qp; qf1 = *(const bf16x8*)(qp + 32); }
            asm volatile("s_waitcnt vmcnt(0) lgkmcnt(0)" ::: "memory");
            __syncthreads();
            f32x4 s[16];
            LAS unsigned char* kb = lds + roff * 32 * 128;
#pragma unroll
            for (int hf = 0; hf < 2; ++hf) {
                bf16x8 kf[8][2];
#pragma unroll
                for (int tt = 0; tt < 8; ++tt) { const int t = 8 * hf + tt, koff = ((t >> 1) * 32 + 16 * (t & 1)) * 128; kf[tt][0] = *(const LAS bf16x8*)(kb + koff + kaddr0); kf[tt][1] = *(const LAS bf16x8*)(kb + koff + kaddr1); }
#pragma unroll
                for (int tt = 0; tt < 8; ++tt) { f32x4 acc = (f32x4){0.f, 0.f, 0.f, 0.f};
                    acc = __builtin_amdgcn_mfma_f32_16x16x32_bf16(kf[tt][0], qf0, acc, 0, 0, 0);
                    acc = __builtin_amdgcn_mfma_f32_16x16x32_bf16(kf[tt][1], qf1, acc, 0, 0, 0);
                    s[8 * hf + tt] = acc; }
            }
            const int kcl0 = kc0 + 4 * g4 - cs;
            const LAS float* bp = bt + 8 + (rs - r + 7) * 32 + (kc0 + 4 * g4 - c + 15);
            float mx = -INFINITY;
#pragma unroll
            for (int t = 0; t < 16; ++t)
#pragma unroll
                for (int e = 0; e < 4; ++e) { const int rel = kcl0 + 16 * (t & 1) + e; const bool ok = (rel >= 0) && (rel < 16);
                    const float v = s[t][e] + bp[(t >> 1) * 32 + 16 * (t & 1) + e];
                    s[t][e] = ok ? v : -INFINITY; mx = fmaxf(mx, s[t][e]); }
            mx = max_x16_x32(mx);
            float l = 0.f;
#pragma unroll
            for (int t = 0; t < 16; ++t)
#pragma unroll
                for (int e = 0; e < 4; ++e) { s[t][e] = __builtin_amdgcn_exp2f(s[t][e] - mx); l += s[t][e]; }
            l = sum_x16_x32(l);
            f32x4 o[4];
#pragma unroll
            for (int n = 0; n < 4; ++n) o[n] = (f32x4){0.f, 0.f, 0.f, 0.f};
            LAS unsigned char* vb = lds + NA_TILE + roff * 32 * 128;
            {
                bf16x8 va[4], vn[4];
#pragma unroll
                for (int n = 0; n < 4; ++n) va[n] = tr_pair(vb + vaddr[n]);
#pragma unroll
                for (int ks = 0; ks < 8; ++ks) {
                    if (ks + 1 < 8) {
#pragma unroll
                        for (int n = 0; n < 4; ++n) vn[n] = tr_pair(vb + (ks + 1) * 32 * 128 + vaddr[n]); }
                    const bf16x8 pf = pack_p(s[2 * ks], s[2 * ks + 1]);
#pragma unroll
                    for (int n = 0; n < 4; ++n) o[n] = __builtin_amdgcn_mfma_f32_16x16x32_bf16(va[n], pf, o[n], 0, 0, 0);
#pragma unroll
                    for (int n = 0; n < 4; ++n) va[n] = vn[n];
                }
            }
            const float inv = 1.0f / l;
            unsigned char* op = (unsigned char*)outna + ((size_t)b * SEQ + r * 64 + c) * ACAT + h * 64 + 4 * g4;
            const float inv8 = inv * A8_SCALE;
#pragma unroll
            for (int n = 0; n < 4; ++n) *(unsigned*)(op + 16 * n) = pk4_fp8(o[n].x * inv8, o[n].y * inv8, o[n].z * inv8, o[n].w * inv8);
            __syncthreads();
        }
    }
    {
        const bf16_t* qd = (const bf16_t*)(ws + WS_QDIL); const bf16_t* kd = (const bf16_t*)(ws + WS_KDIL); const bf16_t* vd = (const bf16_t*)(ws + WS_VDIL);
        bf16_t* og = (bf16_t*)((unsigned char*)A.out + DO_OG); float* lse = (float*)(ws + WS_LSE);
        constexpr int NU = BATCH * DIL_H * 32;
        bf16x8 qn0, qn1;
        auto issue = [&](int u, int buf) {
            const DilUnit d = dil_unit(u);
            const size_t sb = (size_t)d.bh * SEQ + (size_t)d.res * d.L;
            LAS unsigned char* kb = lds + buf * DIL_BUF; LAS unsigned char* vb = kb + DIL_KB;
#pragma unroll
            for (int i = 0; i < 4; ++i) { const int inst = wave * 4 + i, row = inst * 8 + lrow; const int mp = min(max(d.M0 - 64 + row, 0), d.L - 1);
                glds16(kd + (sb + mp) * HD + ((cpos ^ lrow) * 8), kb + inst * 1024);
                glds16(vd + (sb + mp) * HD + ((cpos ^ (2 * ((lrow >> 1) & 3))) * 8), vb + inst * 1024); }
            if (wave < 2) { const int inst = 32 + wave, row = inst * 8 + lrow; const int mp = min(max(d.M0 - 64 + row, 0), d.L - 1);
                glds16(vd + (sb + mp) * HD + ((cpos ^ (2 * ((lrow >> 1) & 3))) * 8), vb + inst * 1024); }
            const bf16_t* qp = qd + (sb + d.M0 + 16 * wave + i16) * HD + 8 * g4; qn0 = *(const bf16x8*)qp; qn1 = *(const bf16x8*)(qp + 32);
        };
        int u = C.vcu, it = 0;
        if (u < NU) issue(u, 0);
        for (; u < NU; u += C.G, ++it) {
            const int buf = it & 1;
            asm volatile("s_waitcnt vmcnt(0)" ::: "memory");
            asm volatile("s_waitcnt lgkmcnt(0)" ::: "memory"); __builtin_amdgcn_s_barrier(); asm volatile("" ::: "memory");
            const bf16x8 qf0 = qn0, qf1 = qn1;
            if (u + C.G < NU) issue(u + C.G, buf ^ 1);
            const DilUnit d = dil_unit(u);
            LAS unsigned char* kb = lds + buf * DIL_BUF + wave * 16 * 128; LAS unsigned char* vb = lds + buf * DIL_BUF + DIL_KB + wave * 16 * 128;
            f32x4 s[10];
            {   bf16x8 kf[9][2];
#pragma unroll
                for (int t = 0; t < 9; ++t) { kf[t][0] = *(const LAS bf16x8*)(kb + t * 16 * 128 + kaddr0); kf[t][1] = *(const LAS bf16x8*)(kb + t * 16 * 128 + kaddr1); }
#pragma unroll
                for (int t = 0; t < 9; ++t) { f32x4 acc = (f32x4){0.f, 0.f, 0.f, 0.f};
                    acc = __builtin_amdgcn_mfma_f32_16x16x32_bf16(kf[t][0], qf0, acc, 0, 0, 0);
                    acc = __builtin_amdgcn_mfma_f32_16x16x32_bf16(kf[t][1], qf1, acc, 0, 0, 0);
                    s[t] = acc; }
            }
            s[9] = (f32x4){0.f, 0.f, 0.f, 0.f};
            const int mlo = d.M0 + 16 * wave - 64;
            float mx = -INFINITY;
#pragma unroll
            for (int t = 0; t < 9; ++t)
#pragma unroll
                for (int e = 0; e < 4; ++e) { const int kk = 16 * t + 4 * g4 + e, mk = mlo + kk; const bool ok = (kk >= i16) && (kk <= i16 + 128) && (mk >= 0) && (mk < d.L);
                    s[t][e] = ok ? s[t][e] : -INFINITY; mx = fmaxf(mx, s[t][e]); }
            mx = max_x16_x32(mx);
            float l = 0.f;
#pragma unroll
            for (int t = 0; t < 9; ++t)
#pragma unroll
                for (int e = 0; e < 4; ++e) { s[t][e] = __builtin_amdgcn_exp2f(s[t][e] - mx); l += s[t][e]; }
            l = sum_x16_x32(l);
            f32x4 o[4];
#pragma unroll
            for (int n = 0; n < 4; ++n) o[n] = (f32x4){0.f, 0.f, 0.f, 0.f};
            {   bf16x8 va[4], vn[4];
#pragma unroll
                for (int n = 0; n < 4; ++n) va[n] = tr_pair(vb + vaddr[n]);
#pragma unroll
                for (int ks = 0; ks < 5; ++ks) {
                    if (ks + 1 < 5) {
#pragma unroll
                        for (int n = 0; n < 4; ++n) vn[n] = tr_pair(vb + (ks + 1) * 32 * 128 + vaddr[n]); }
                    const bf16x8 pf = pack_p(s[2 * ks], s[2 * ks + 1]);
#pragma unroll
                    for (int n = 0; n < 4; ++n) o[n] = __builtin_amdgcn_mfma_f32_16x16x32_bf16(va[n], pf, o[n], 0, 0, 0);
#pragma unroll
                    for (int n = 0; n < 4; ++n) va[n] = vn[n];
                }
            }
            const float inv = 1.0f / l;
            const int m = d.M0 + 16 * wave + i16, b = d.bh / 12, hh = d.bh & 3;
            const size_t tok = (size_t)b * SEQ + ((size_t)m << d.sh) + d.res;
            bf16_t* op = og + ((size_t)d.g * T + tok) * 256 + hh * 64 + 4 * g4;
#pragma unroll
            for (int n = 0; n < 4; ++n) *(u32x2*)(op + 16 * n) = (u32x2){cvt_pk_bf16(o[n].x * inv, o[n].y * inv), cvt_pk_bf16(o[n].z * inv, o[n].w * inv)};
            if (g4 == 0) lse[((size_t)d.g * T + tok) * 4 + hh] = mx + __builtin_amdgcn_logf(l);
        }
        asm volatile("s_waitcnt vmcnt(0)" ::: "memory");
        __syncthreads();
    }
}

__device__ __forceinline__ void phase_dil_combine(const Ctx& C) {
    const Args& A = *C.a; unsigned char* ws = A.ws;
    const bf16_t* og = (const bf16_t*)((unsigned char*)A.out + DO_OG); const float* lse = (const float*)(ws + WS_LSE);
    unsigned char* od = ws + WS_OUTNA + 512; CTX_LANES();
    const size_t gt = (size_t)(C.vcu * 512 + tid_), NT = (size_t)C.G * 512;
    for (size_t i = gt; i < (size_t)T * 32; i += NT) {
        const size_t tok = i >> 5; const int ch = (int)(i & 31), hh = ch >> 3;
        const float l0 = lse[(0 * (size_t)T + tok) * 4 + hh], l1 = lse[(1 * (size_t)T + tok) * 4 + hh], l2 = lse[(2 * (size_t)T + tok) * 4 + hh];
        const float mx = fmaxf(l0, fmaxf(l1, l2));
        float w0 = __builtin_amdgcn_exp2f(l0 - mx), w1 = __builtin_amdgcn_exp2f(l1 - mx), w2 = __builtin_amdgcn_exp2f(l2 - mx);
        const float inv = 1.0f / (w0 + w1 + w2); w0 *= inv; w1 *= inv; w2 *= inv;
        const u32x4 a = *(const u32x4*)(og + (0 * (size_t)T + tok) * 256 + ch * 8), b = *(const u32x4*)(og + (1 * (size_t)T + tok) * 256 + ch * 8), c = *(const u32x4*)(og + (2 * (size_t)T + tok) * 256 + ch * 8);
        w0 *= A8_SCALE; w1 *= A8_SCALE; w2 *= A8_SCALE;
        u32x2 o;
        o.x = pk4_fp8(w0 * bf_lo(a.x) + w1 * bf_lo(b.x) + w2 * bf_lo(c.x), w0 * bf_hi(a.x) + w1 * bf_hi(b.x) + w2 * bf_hi(c.x), w0 * bf_lo(a.y) + w1 * bf_lo(b.y) + w2 * bf_lo(c.y), w0 * bf_hi(a.y) + w1 * bf_hi(b.y) + w2 * bf_hi(c.y));
        o.y = pk4_fp8(w0 * bf_lo(a.z) + w1 * bf_lo(b.z) + w2 * bf_lo(c.z), w0 * bf_hi(a.z) + w1 * bf_hi(b.z) + w2 * bf_hi(c.z), w0 * bf_lo(a.w) + w1 * bf_lo(b.w) + w2 * bf_lo(c.w), w0 * bf_hi(a.w) + w1 * bf_hi(b.w) + w2 * bf_hi(c.w));
        *(u32x2*)(od + tok * ACAT + ch * 8) = o;
    }
}

__device__ __forceinline__ void ins16(float (&a)[16], float x) {
    float prev = a[0]; a[0] = fmaxf(prev, x);
#pragma unroll
    for (int i = 1; i < 16; ++i) { const float cur = a[i]; a[i] = __builtin_amdgcn_fmed3f(prev, cur, x); prev = cur; }
}
struct EpiScoresTopk {
    static constexpr bool AFTER_DRAIN = true;
    const float* ssq; unsigned short* ridx; float* rg;
    __device__ __forceinline__ void fused(const f32x4 (&acc)[2][2][4][2], const Unit& u, int wr, int wc, int fr, int fq, PG8_LAS unsigned char* lds) const {
        constexpr int SROW = 528;
        const int tid = opaque_tid();
        {
            const int row0l = wr * 64 + fr, colb = (wc * 64 + 8 * fq) * 2;
#pragma unroll
            for (int it = 0; it < 8; ++it) {
                const int ai = it >> 2, m = it & 3, rl = row0l + ai * 128 + m * 16;
                const f32x4* sp = (const f32x4*)(ssq + (size_t)(u.pm * 256 + rl) * 16);
                const f32x4 s0 = sp[0], s1 = sp[1], s2 = sp[2], s3 = sp[3];
                const float tot = ((s0.x + s0.y) + (s0.z + s0.w)) + ((s1.x + s1.y) + (s1.z + s1.w)) + ((s2.x + s2.y) + (s2.z + s2.w)) + ((s3.x + s3.y) + (s3.z + s3.w));
                const float rs = 1.0f / sqrtf(tot * (1.0f / D) + RMS_EPS);
#pragma unroll
                for (int bj = 0; bj < 2; ++bj) {
                    const f32x4 a = acc[ai][bj][m][0] * rs, b = acc[ai][bj][m][1] * rs;
                    *(PG8_LAS h16x8*)(lds + rl * SROW + colb + 64 * bj) = (h16x8){(_Float16)a.x, (_Float16)a.y, (_Float16)a.z, (_Float16)a.w, (_Float16)b.x, (_Float16)b.y, (_Float16)b.z, (_Float16)b.w};
                }
            }
        }
        __syncthreads();
        const int row = tid & 255, side = tid >> 8;
        float a1[16];
#pragma unroll
        for (int i = 0; i < 16; ++i) a1[i] = -1e30f;
#pragma unroll
        for (int i = 0; i < 16; ++i) { const h16x8 v = *(const PG8_LAS h16x8*)(lds + row * SROW + side * 256 + i * 16);
#pragma unroll
            for (int j = 0; j < 8; ++j) ins16(a1, __builtin_bit_cast(float, (__builtin_bit_cast(unsigned, (float)v[j]) & ~0x7Fu) | (unsigned)(i * 8 + j))); }
        __syncthreads();
        PG8_LAS float* lst = (PG8_LAS float*)(lds + tid * 80);
#pragma unroll
        for (int i = 0; i < 4; ++i) *(PG8_LAS f32x4*)(lst + 4 * i) = (f32x4){a1[4 * i], a1[4 * i + 1], a1[4 * i + 2], a1[4 * i + 3]};
        __syncthreads();
        if (side == 0) {
            float a2[16];
            const PG8_LAS float* pl = (const PG8_LAS float*)(lds + (tid + 256) * 80);
#pragma unroll
            for (int i = 0; i < 4; ++i) { const f32x4 q = *(const PG8_LAS f32x4*)(pl + 4 * i); a2[4 * i] = q.x; a2[4 * i + 1] = q.y; a2[4 * i + 2] = q.z; a2[4 * i + 3] = q.w; }
            PG8_LAS unsigned char* ib = lds + 512 * 80 + tid * 32;
            float v1[16], v2[16];
#pragma unroll
            for (int i = 0; i < 16; ++i) { const unsigned b1 = __builtin_bit_cast(unsigned, a1[i]), b2 = __builtin_bit_cast(unsigned, a2[i]);
                v1[i] = __builtin_bit_cast(float, b1 & ~0x7Fu); v2[i] = __builtin_bit_cast(float, b2 & ~0x7Fu);
                ib[i] = (unsigned char)(b1 & 0x7Fu); ib[16 + i] = (unsigned char)(b2 & 0x7Fu); }
            float cc[16];
#pragma unroll
            for (int i = 0; i < 16; ++i) cc[i] = -1e30f;
#pragma unroll
            for (int i = 0; i < 16; ++i)
#pragma unroll
                for (int j = 0; j < 16; ++j)
                    if ((i + 1) * (j + 1) <= 16) { const float s = v1[i] + v2[j]; ins16(cc, __builtin_bit_cast(float, (__builtin_bit_cast(unsigned, s) & ~0xFFu) | (unsigned)(i * 16 + j))); }
            asm volatile("s_waitcnt lgkmcnt(0)" ::: "memory");
            float sv[16]; int ei[16]; float mx = -1e30f;
#pragma unroll
            for (int k = 0; k < 16; ++k) { const unsigned b = __builtin_bit_cast(unsigned, cc[k]); sv[k] = __builtin_bit_cast(float, b & ~0xFFu); const int i = (b >> 4) & 15, j = b & 15;
                const int i1 = ib[i], i2 = ib[16 + j]; ei[k] = i1 * 128 + i2; mx = fmaxf(mx, sv[k]); }
            float sum = 0.f;
#pragma unroll
            for (int k = 0; k < 16; ++k) { sv[k] = __expf(sv[k] - mx); sum += sv[k]; }
            const float inv = 1.0f / sum;
            const size_t ob = (size_t)(u.pm * 256 + row) * 128 + (size_t)u.pn * 16;
#pragma unroll
            for (int k = 0; k < 4; ++k) { *(f32x4*)(rg + ob + 4 * k) = (f32x4){sv[4 * k] * inv, sv[4 * k + 1] * inv, sv[4 * k + 2] * inv, sv[4 * k + 3] * inv};
                *(u32x2*)(ridx + ob + 4 * k) = (u32x2){(unsigned)ei[4 * k] | ((unsigned)ei[4 * k + 1] << 16), (unsigned)ei[4 * k + 2] | ((unsigned)ei[4 * k + 3] << 16)}; }
        }
        asm volatile("s_waitcnt lgkmcnt(0)" ::: "memory");
        __syncthreads();
    }
};
__device__ __forceinline__ void phase_topk(const Ctx& C) {
    const Args& A = *C.a; unsigned char* ws = A.ws; CTX_LANES();
    const _Float16* S = (const _Float16*)(ws + WS_SCORES); unsigned short* ridx = (unsigned short*)(ws + WS_RIDX); float* rg = (float*)(ws + WS_RG);
    LAS unsigned char* scr = C.lds + wave * 9216;
    const int gw = C.vcu * 8 + wave, NGW = C.G * 8;
    for (int it = gw; it < T / 8; it += NGW) {
        const _Float16* base = S + (size_t)it * 8 * 2048;
        float a1[16], a2[16];
#pragma unroll
        for (int i = 0; i < 16; ++i) { a1[i] = -1e30f; a2[i] = -1e30f; }
#pragma unroll 1
        for (int c = 0; c < 4; ++c) {
#pragma unroll
            for (int i = 0; i < 8; ++i) { const int q = i * 64 + lane, task = q >> 3, part = q & 7;
                *(LAS u32x4*)(scr + task * 144 + part * 16) = *(const u32x4*)(base + (size_t)task * 256 + c * 64 + part * 8); }
            asm volatile("s_waitcnt vmcnt(0) lgkmcnt(0)" ::: "memory");
            if (c < 2) {
#pragma unroll
                for (int i = 0; i < 8; ++i) { const h16x8 v = *(const LAS h16x8*)(scr + lane * 144 + i * 16);
#pragma unroll
                    for (int j = 0; j < 8; ++j) { const unsigned id = (unsigned)(c * 64 + i * 8 + j); ins16(a1, __builtin_bit_cast(float, (__builtin_bit_cast(unsigned, (float)v[j]) & ~0x7Fu) | id)); } }
            } else {
#pragma unroll
                for (int i = 0; i < 8; ++i) { const h16x8 v = *(const LAS h16x8*)(scr + lane * 144 + i * 16);
#pragma unroll
                    for (int j = 0; j < 8; ++j) { const unsigned id = (unsigned)((c - 2) * 64 + i * 8 + j); ins16(a2, __builtin_bit_cast(float, (__builtin_bit_cast(unsigned, (float)v[j]) & ~0x7Fu) | id)); } }
            }
            asm volatile("s_waitcnt lgkmcnt(0)" ::: "memory");
        }
        float v1[16], v2[16];
#pragma unroll
        for (int i = 0; i < 16; ++i) { const unsigned b1 = __builtin_bit_cast(unsigned, a1[i]), b2 = __builtin_bit_cast(unsigned, a2[i]);
            v1[i] = __builtin_bit_cast(float, b1 & ~0x7Fu); v2[i] = __builtin_bit_cast(float, b2 & ~0x7Fu);
            *(LAS unsigned char*)(scr + lane * 144 + i) = (unsigned char)(b1 & 0x7Fu); *(LAS unsigned char*)(scr + lane * 144 + 16 + i) = (unsigned char)(b2 & 0x7Fu); }
        float cc[16];
#pragma unroll
        for (int i = 0; i < 16; ++i) cc[i] = -1e30f;
#pragma unroll
        for (int i = 0; i < 16; ++i)
#pragma unroll
            for (int j = 0; j < 16; ++j)
                if ((i + 1) * (j + 1) <= 16) { const float s = v1[i] + v2[j]; ins16(cc, __builtin_bit_cast(float, (__builtin_bit_cast(unsigned, s) & ~0xFFu) | (unsigned)(i * 16 + j))); }
        asm volatile("s_waitcnt lgkmcnt(0)" ::: "memory");
        float sv[16]; int ei[16]; float mx = -1e30f;
#pragma unroll
        for (int k = 0; k < 16; ++k) { const unsigned b = __builtin_bit_cast(unsigned, cc[k]); sv[k] = __builtin_bit_cast(float, b & ~0xFFu); const int i = (b >> 4) & 15, j = b & 15;
            const int i1 = *(const LAS unsigned char*)(scr + lane * 144 + i), i2 = *(const LAS unsigned char*)(scr + lane * 144 + 16 + j);
            ei[k] = i1 * 128 + i2; mx = fmaxf(mx, sv[k]); }
        float sum = 0.f;
#pragma unroll
        for (int k = 0; k < 16; ++k) { sv[k] = __expf(sv[k] - mx); sum += sv[k]; }
        const float inv = 1.0f / sum;
        const size_t ob = (size_t)it * 8 * 128 + (size_t)lane * 16;
#pragma unroll
        for (int k = 0; k < 4; ++k) { *(f32x4*)(rg + ob + 4 * k) = (f32x4){sv[4 * k] * inv, sv[4 * k + 1] * inv, sv[4 * k + 2] * inv, sv[4 * k + 3] * inv};
            *(u32x2*)(ridx + ob + 4 * k) = (u32x2){(unsigned)ei[4 * k] | ((unsigned)ei[4 * k + 1] << 16), (unsigned)ei[4 * k + 2] | ((unsigned)ei[4 * k + 3] << 16)}; }
        asm volatile("s_waitcnt lgkmcnt(0)" ::: "memory");
    }
}
__device__ __forceinline__ void phase_hq(const Ctx& C) {
    const Args& A = *C.a; unsigned char* ws = A.ws; CTX_LANES();
    const int gw = C.vcu * 8 + wave, NGW = C.G * 8;
    {
        const bf16_t* x1 = (const bf16_t*)(ws + WS_X1B); const float* gf = A.in[I_NORM_FFN]; unsigned char* hq = ws + WS_HQ; float* hs = (float*)(ws + WS_HS);
        f32x4 gv[4];
#pragma unroll
        for (int j = 0; j < 4; ++j) gv[j] = *(const f32x4*)(gf + 16 * lane + 4 * j);
        for (int tok0 = gw * 4; tok0 < T; tok0 += NGW * 4) {
            u32x2 xw[4][4];
#pragma unroll
            for (int r = 0; r < 4; ++r)
#pragma unroll
                for (int j = 0; j < 4; ++j) xw[r][j] = *(const u32x2*)(x1 + (size_t)(tok0 + r) * D + 16 * lane + 4 * j);
#pragma unroll
            for (int r = 0; r < 4; ++r) { const int tok = tok0 + r;
                f32x4 h[4]; float am = 0.f;
#pragma unroll
                for (int j = 0; j < 4; ++j) { h[j] = (f32x4){bf_lo(xw[r][j].x), bf_hi(xw[r][j].x), bf_lo(xw[r][j].y), bf_hi(xw[r][j].y)} * gv[j]; am = fmaxf(am, fmaxf(fmaxf(fabsf(h[j].x), fabsf(h[j].y)), fmaxf(fabsf(h[j].z), fabsf(h[j].w)))); }
                am = fmaxf(am, dppc<0xB1>(am)); am = fmaxf(am, dppc<0x4E>(am)); am = fmaxf(am, dppc<0x141>(am));
                const float inv = am > 0.f ? 127.0f / am : 0.f;
                unsigned w[4];
#pragma unroll
                for (int j = 0; j < 4; ++j) { const int q0 = (int)__builtin_rintf(h[j].x * inv), q1 = (int)__builtin_rintf(h[j].y * inv), q2 = (int)__builtin_rintf(h[j].z * inv), q3 = (int)__builtin_rintf(h[j].w * inv);
                    w[j] = ((unsigned)q0 & 0xffu) | (((unsigned)q1 & 0xffu) << 8) | (((unsigned)q2 & 0xffu) << 16) | ((unsigned)q3 << 24); }
                *(u32x4*)(hq + (size_t)tok * D + 16 * lane) = (u32x4){w[0], w[1], w[2], w[3]};
                if ((lane & 7) == 0) hs[(size_t)tok * 8 + (lane >> 3)] = am * (1.0f / 127.0f); }
        }
    }
}

__device__ __forceinline__ float ub0(unsigned w) { return (float)(w & 0xffu); }
__device__ __forceinline__ float ub1(unsigned w) { return (float)((w >> 8) & 0xffu); }
__device__ __forceinline__ float ub2(unsigned w) { return (float)((w >> 16) & 0xffu); }
__device__ __forceinline__ float ub3(unsigned w) { return (float)(w >> 24); }
__device__ __forceinline__ float dot16(const u32x4& r, const f32x4 (&h)[4], float acc) {
    f32x2 a = (f32x2){acc, 0.f};
    a += (f32x2){ub0(r.x), ub1(r.x)} * (f32x2){h[0].x, h[0].y}; a += (f32x2){ub2(r.x), ub3(r.x)} * (f32x2){h[0].z, h[0].w};
    a += (f32x2){ub0(r.y), ub1(r.y)} * (f32x2){h[1].x, h[1].y}; a += (f32x2){ub2(r.y), ub3(r.y)} * (f32x2){h[1].z, h[1].w};
    a += (f32x2){ub0(r.z), ub1(r.z)} * (f32x2){h[2].x, h[2].y}; a += (f32x2){ub2(r.z), ub3(r.z)} * (f32x2){h[2].z, h[2].w};
    a += (f32x2){ub0(r.w), ub1(r.w)} * (f32x2){h[3].x, h[3].y}; a += (f32x2){ub2(r.w), ub3(r.w)} * (f32x2){h[3].z, h[3].w};
    return a.x + a.y;
}
__device__ __forceinline__ void axpy16(const u32x4& r, float c, f32x4 (&o)[4]) {
    o[0].x += c * ub0(r.x); o[0].y += c * ub1(r.x); o[0].z += c * ub2(r.x); o[0].w += c * ub3(r.x);
    o[1].x += c * ub0(r.y); o[1].y += c * ub1(r.y); o[1].z += c * ub2(r.y); o[1].w += c * ub3(r.y);
    o[2].x += c * ub0(r.z); o[2].y += c * ub1(r.z); o[2].z += c * ub2(r.z); o[2].w += c * ub3(r.z);
    o[3].x += c * ub0(r.w); o[3].y += c * ub1(r.w); o[3].z += c * ub2(r.w); o[3].w += c * ub3(r.w);
}
__device__ __forceinline__ float reduce8_safe(const float (&p)[8], int lane) {
    float t = 0.f;
#pragma unroll
    for (int r = 0; r < 8; ++r) { const float s = wave_sum(p[r]); t = ((lane & 7) == r) ? s : t; }
    return t;
}
__device__ __forceinline__ float reduce8(const float (&p)[8], int lane) {
    const bool u4 = (lane & 4) != 0, u2 = (lane & 2) != 0, u1 = (lane & 1) != 0;
    float q[4];
#pragma unroll
    for (int r = 0; r < 4; ++r) { const float keep = u4 ? p[r + 4] : p[r], send = u4 ? p[r] : p[r + 4]; q[r] = keep + dppc<0x141>(send); }
    float s[2];
#pragma unroll
    for (int r = 0; r < 2; ++r) { const float keep = u2 ? q[r + 2] : q[r], send = u2 ? q[r] : q[r + 2]; s[r] = keep + dppc<0x4E>(send); }
    float t; { const float keep = u1 ? s[1] : s[0], send = u1 ? s[0] : s[1]; t = keep + dppc<0xB1>(send); }
    t += dppc<0x128>(t);
    { float a = t, b = t; asm volatile("s_nop 1\n\tv_permlane16_swap_b32 %0, %1" : "+v"(a), "+v"(b)); t = a + b; }
    { float a = t, b = t; asm volatile("s_nop 1\n\tv_permlane32_swap_b32 %0, %1" : "+v"(a), "+v"(b)); t = a + b; }
    return t;
}
__device__ __forceinline__ float reduce8_grp(const float (&p)[8], int lane) {
    const bool u4 = (lane & 4) != 0, u2 = (lane & 2) != 0, u1 = (lane & 1) != 0;
    float q[4];
#pragma unroll
    for (int r = 0; r < 4; ++r) { const float keep = u4 ? p[r + 4] : p[r], send = u4 ? p[r] : p[r + 4]; q[r] = keep + dppc<0x141>(send); }
    float s[2];
#pragma unroll
    for (int r = 0; r < 2; ++r) { const float keep = u2 ? q[r + 2] : q[r], send = u2 ? q[r] : q[r + 2]; s[r] = keep + dppc<0x4E>(send); }
    const float keep = u1 ? s[1] : s[0], send = u1 ? s[0] : s[1];
    return keep + dppc<0xB1>(send);
}
constexpr int PEER_NCHUNK = T / 16;
#define SB() __builtin_amdgcn_sched_barrier(0)
#define PEER_LOAD8(dst, b) do { const u32x4 ia_ = *(const LAS u32x4*)(ip + 4 * (b)); \
        dst[0] = *(const u32x4*)(tab + (ia_.x & 0xffffu) * 128u); dst[1] = *(const u32x4*)(tab + (ia_.x >> 16) * 128u); dst[2] = *(const u32x4*)(tab + (ia_.y & 0xffffu) * 128u); dst[3] = *(const u32x4*)(tab + (ia_.y >> 16) * 128u); \
        dst[4] = *(const u32x4*)(tab + (ia_.z & 0xffffu) * 128u); dst[5] = *(const u32x4*)(tab + (ia_.z >> 16) * 128u); dst[6] = *(const u32x4*)(tab + (ia_.w & 0xffffu) * 128u); dst[7] = *(const u32x4*)(tab + (ia_.w >> 16) * 128u); } while (0)
typedef int i32x4 __attribute__((ext_vector_type(4)));
template <int CTRL> __device__ __forceinline__ int dppi(int v) { return __builtin_amdgcn_update_dpp(0, v, CTRL, 0xf, 0xf, true); }
__device__ __forceinline__ int reduce8_grp_i(const int (&p)[8], int lane) {
    const bool u4 = (lane & 4) != 0, u2 = (lane & 2) != 0, u1 = (lane & 1) != 0;
    int q[4];
#pragma unroll
    for (int r = 0; r < 4; ++r) { const int keep = u4 ? p[r + 4] : p[r], send = u4 ? p[r] : p[r + 4]; q[r] = keep + dppi<0x141>(send); }
    int s[2];
#pragma unroll
    for (int r = 0; r < 2; ++r) { const int keep = u2 ? q[r + 2] : q[r], send = u2 ? q[r] : q[r + 2]; s[r] = keep + dppi<0x4E>(send); }
    const int keep = u1 ? s[1] : s[0], send = u1 ? s[0] : s[1];
    return keep + dppi<0xB1>(send);
}
__device__ __forceinline__ int dot32n(const u32x4& r, const u32x4& ha, const u32x4& hb) {
    int a = __builtin_amdgcn_sdot8((int)r.x, (int)ha.x, 0, false); a = __builtin_amdgcn_sdot8((int)r.y, (int)ha.y, a, false);
    a = __builtin_amdgcn_sdot8((int)r.z, (int)ha.z, a, false); a = __builtin_amdgcn_sdot8((int)r.w, (int)ha.w, a, false);
    int b = __builtin_amdgcn_sdot8((int)r.x, (int)hb.x, 0, false); b = __builtin_amdgcn_sdot8((int)r.y, (int)hb.y, b, false);
    b = __builtin_amdgcn_sdot8((int)r.z, (int)hb.z, b, false); b = __builtin_amdgcn_sdot8((int)r.w, (int)hb.w, b, false);
    return (a << 4) + b;
}
__device__ __forceinline__ void phase_peer_u(const Ctx& C) {
    const Args& A = *C.a; unsigned char* ws = A.ws; CTX_LANES();
    const int g = lane >> 3, c = lane & 7;
    const unsigned* ridx = (const unsigned*)(ws + WS_RIDX); const float* gfp = A.in[I_NORM_FFN];
    unsigned* Q = (unsigned*)(ws + WS_CTL) + CW_QU + A.li * 1024;
    LAS unsigned* sidx = (LAS unsigned*)(C.lds + wave * 16384);
    const int xcc = (int)(xb_xcc_id() & 7u);
    for (int so = 0; so < 4; ++so) {
        const int s = (xcc + so) & 3;
        const unsigned char* tab = ws + WS_EU + (size_t)s * (NEXP * 128) + 16 * c;
        const bf16_t* x1s = (const bf16_t*)(ws + WS_X1B) + 256 * s + 32 * c;
        f32x4 gv[8];
#pragma unroll
        for (int j = 0; j < 8; ++j) gv[j] = *(const f32x4*)(gfp + 256 * s + 32 * c + 4 * j);
        _Float16* part = (_Float16*)(ws + WS_PART) + (size_t)s * T * 128;
        for (;;) {
            int ch = 0; if (lane == 0) ch = (int)atomicAdd(&Q[64 * s], 1u);
            ch = __builtin_amdgcn_readfirstlane(ch);
            if (ch >= PEER_NCHUNK) break;
            const int tok0 = ch * 16;
#pragma unroll
            for (int i = 0; i < 4; ++i) *(LAS u32x4*)(sidx + (i * 64 + lane) * 4) = __builtin_nontemporal_load((const u32x4*)(ridx + (size_t)tok0 * 64) + i * 64 + lane);
            u32x4 wa[4];
#pragma unroll
            for (int i = 0; i < 4; ++i) wa[i] = *(const u32x4*)(x1s + (size_t)(tok0 + g) * D + 8 * i);
#pragma unroll 1
            for (int sub = 0; sub < 2; ++sub) {
                const int tok = tok0 + sub * 8 + g;
                u32x4 ha, hb; float sc;
                {
                  f32x4 hv[8];
#pragma unroll
                  for (int i = 0; i < 4; ++i) { hv[2 * i] = (f32x4){bf_lo(wa[i].x), bf_hi(wa[i].x), bf_lo(wa[i].y), bf_hi(wa[i].y)} * gv[2 * i]; hv[2 * i + 1] = (f32x4){bf_lo(wa[i].z), bf_hi(wa[i].z), bf_lo(wa[i].w), bf_hi(wa[i].w)} * gv[2 * i + 1]; }
                  float am = 0.f;
#pragma unroll
                  for (int j = 0; j < 8; ++j) am = fmaxf(am, fmaxf(fmaxf(fabsf(hv[j].x), fabsf(hv[j].y)), fmaxf(fabsf(hv[j].z), fabsf(hv[j].w))));
                  am = fmaxf(am, dppc<0xB1>(am)); am = fmaxf(am, dppc<0x4E>(am)); am = fmaxf(am, dppc<0x141>(am));
                  const float qi = am > 0.f ? 119.0f / am : 0.f; sc = am * (1.0f / 119.0f);
                  unsigned e[8];
#pragma unroll
                  for (int j = 0; j < 8; ++j) { const int q0 = (int)__builtin_rintf(hv[j].x * qi) + 8, q1 = (int)__builtin_rintf(hv[j].y * qi) + 8, q2 = (int)__builtin_rintf(hv[j].z * qi) + 8, q3 = (int)__builtin_rintf(hv[j].w * qi) + 8;
                      e[j] = ((unsigned)q0 & 0xffu) | (((unsigned)q1 & 0xffu) << 8) | (((unsigned)q2 & 0xffu) << 16) | ((unsigned)q3 << 24); }
                  unsigned a4[4], b4[4];
#pragma unroll
                  for (int j = 0; j < 4; ++j) { a4[j] = ((e[2 * j] >> 4) & 0x0F0F0F0Fu) | (e[2 * j + 1] & 0xF0F0F0F0u); b4[j] = ((e[2 * j] & 0x0F0F0F0Fu) | ((e[2 * j + 1] & 0x0F0F0F0Fu) << 4)) ^ 0x88888888u; }
                  ha = (u32x4){a4[0], a4[1], a4[2], a4[3]}; hb = (u32x4){b4[0], b4[1], b4[2], b4[3]}; }
                if (sub == 0) {
#pragma unroll
                    for (int i = 0; i < 4; ++i) wa[i] = *(const u32x4*)(x1s + (size_t)(tok + 8) * D + 8 * i); }
                const LAS unsigned* ip = sidx + (sub * 8 + g) * 64;
                _Float16* pp = part + (size_t)tok * 128 + c;
                u32x4 r0[8], r1[8], r2[8], r3[8];
#define PEER_DOTB(src, b) do { int p_[8]; _Pragma("unroll") for (int k_ = 0; k_ < 8; ++k_) p_[k_] = dot32n(src[k_], ha, hb); __builtin_nontemporal_store((_Float16)((float)reduce8_grp_i(p_, lane) * sc), pp + 8 * (b)); } while (0)
                PEER_LOAD8(r0, 0); PEER_LOAD8(r1, 1); PEER_LOAD8(r2, 2); PEER_LOAD8(r3, 3); SB();
#pragma unroll
                for (int b4_ = 0; b4_ < 16; b4_ += 4) {
                    PEER_DOTB(r0, b4_); SB(); if (b4_ + 4 < 16) PEER_LOAD8(r0, b4_ + 4); SB();
                    PEER_DOTB(r1, b4_ + 1); SB(); if (b4_ + 5 < 16) PEER_LOAD8(r1, b4_ + 5); SB();
                    PEER_DOTB(r2, b4_ + 2); SB(); if (b4_ + 6 < 16) PEER_LOAD8(r2, b4_ + 6); SB();
                    PEER_DOTB(r3, b4_ + 3); SB(); if (b4_ + 7 < 16) PEER_LOAD8(r3, b4_ + 7); SB();
                }
#undef PEER_DOTB
            }
        }
    }
}
__device__ __forceinline__ void phase_peer_coef(const Ctx& C) {
    const Args& A = *C.a; unsigned char* ws = A.ws; CTX_LANES();
    const _Float16* part = (const _Float16*)(ws + WS_PART); const float* SU = (const float*)(ws + WS_SU); const float* SV = (const float*)(ws + WS_SV);
    const unsigned short* ridx = (const unsigned short*)(ws + WS_RIDX); const float* rg = (const float*)(ws + WS_RG); const float* ssq = (const float*)(ws + WS_SSQ2); _Float16* coef = (_Float16*)(ws + WS_COEF);
    typedef _Float16 h16x4 __attribute__((ext_vector_type(4)));
    const size_t gt = (size_t)(C.vcu * 512 + tid_), NT = (size_t)C.G * 512;
    for (size_t i4 = gt; i4 < (size_t)T * 32; i4 += NT) {
        const size_t tok = i4 >> 5, i = i4 * 4;
        const f32x4* sp = (const f32x4*)(ssq + tok * 16);
        const f32x4 s0 = sp[0], s1 = sp[1], s2 = sp[2], s3 = sp[3];
        const float tot = ((s0.x + s0.y) + (s0.z + s0.w)) + ((s1.x + s1.y) + (s1.z + s1.w)) + ((s2.x + s2.y) + (s2.z + s2.w)) + ((s3.x + s3.y) + (s3.z + s3.w));
        const float rs2 = 1.0f / sqrtf(tot * (1.0f / D) + RMS_EPS);
        f32x4 a = (f32x4){0.f, 0.f, 0.f, 0.f};
#pragma unroll
        for (int s = 0; s < 4; ++s) { const h16x4 p = __builtin_nontemporal_load((const h16x4*)(part + (size_t)s * T * 128 + i)); a += (f32x4){(float)p.x, (float)p.y, (float)p.z, (float)p.w}; }
        const u32x2 ew = *(const u32x2*)(ridx + i); const f32x4 g = *(const f32x4*)(rg + i);
        const unsigned e0 = ew.x & 0xffffu, e1 = ew.x >> 16, e2 = ew.y & 0xffffu, e3 = ew.y >> 16;
        f32x4 cf = (f32x4){gelu_erf(a.x * SU[e0] * rs2) * g.x * SV[e0], gelu_erf(a.y * SU[e1] * rs2) * g.y * SV[e1], gelu_erf(a.z * SU[e2] * rs2) * g.z * SV[e2], gelu_erf(a.w * SU[e3] * rs2) * g.w * SV[e3]};
        { h16x4 o; o.x = (_Float16)cf.x; o.y = (_Float16)cf.y; o.z = (_Float16)cf.z; o.w = (_Float16)cf.w; *(h16x4*)(coef + i) = o; }
        cf *= 256.0f;
        unsigned char* c8 = ws + WS_COEF8 + tok * 384 + (i & 127);
#pragma unroll
        for (int part_ = 0; part_ < 3; ++part_) {
            const unsigned w8 = pk4_fp8(cf.x, cf.y, cf.z, cf.w);
            *(unsigned*)(c8 + part_ * 128) = w8;
            cf -= (f32x4){__builtin_amdgcn_cvt_f32_fp8((int)w8, 0), __builtin_amdgcn_cvt_f32_fp8((int)w8, 1), __builtin_amdgcn_cvt_f32_fp8((int)w8, 2), __builtin_amdgcn_cvt_f32_fp8((int)w8, 3)};
        }
    }
}
typedef _Float16 h16x2 __attribute__((ext_vector_type(2)));
__device__ __forceinline__ void axpy32_fp4(const u32x4& r, _Float16 c, h16x2 (&o)[16]) {
    const h16x2 cc = (h16x2){c, c};
#define CV4(w, k) __builtin_bit_cast(h16x2, __builtin_amdgcn_cvt_scalef32_pk_f16_fp4((w), 1.0f, (k)))
#define AX4(j, w) do { o[4 * (j) + 0] += cc * CV4(w, 0); o[4 * (j) + 1] += cc * CV4(w, 1); o[4 * (j) + 2] += cc * CV4(w, 2); o[4 * (j) + 3] += cc * CV4(w, 3); } while (0)
    AX4(0, r.x); AX4(1, r.y); AX4(2, r.z); AX4(3, r.w);
#undef AX4
#undef CV4
}
constexpr int VW_LDS = 20352;
typedef int i32x2v __attribute__((ext_vector_type(2))); using pg8::i32x4v; using pg8::i32x8v;
#define V_BODY(T_, A0_, A1_, XW_, BO_, GATHER_, YOUNGER_) do { const int t = (T_); u32x4& a0 = A0_; u32x4& a1 = A1_; u32x2& xw = XW_; const int bo = (BO_); constexpr bool GATHER = GATHER_, YOUNGER = YOUNGER_; \
                const int tok = tok0 + t; \
                if (YOUNGER) asm volatile("s_waitcnt vmcnt(19)" : "+v"(a0), "+v"(a1) :: "memory"); \
                else asm volatile("s_waitcnt vmcnt(0)" : "+v"(a0), "+v"(a1) :: "memory"); \
                if (t > 0) { \
                    *(u32x2*)(x2b + (size_t)(tok - 1) * D + 256 * s + 4 * lane) = xo; \
                    ssq3[(size_t)(tok - 1) * 8 + s] = sso; ssq3[(size_t)(tok - 1) * 8 + 4 + s] = 0.f; \
                } \
                u32x2 xc; \
                { const bf16_t* xp_ = x1b + (size_t)tok * D + 256 * s + 4 * lane; asm volatile("global_load_dwordx2 %0, %1, off" : "=v"(xc) : "v"(xp_) : "memory"); } \
                i32x4v b[16]; \
_Pragma("unroll") \
                for (int j = 0; j < 16; ++j) { i32x2v lo, hi; \
                    if (bo == 0) { if (j & 1) { asm volatile("ds_read_b64_tr_b4 %0, %1 offset:8" : "=v"(lo) : "v"(adr[j >> 1]) : "memory"); asm volatile("ds_read_b64_tr_b4 %0, %1 offset:2056" : "=v"(hi) : "v"(adr[j >> 1]) : "memory"); } \
                                   else       { asm volatile("ds_read_b64_tr_b4 %0, %1" : "=v"(lo) : "v"(adr[j >> 1]) : "memory"); asm volatile("ds_read_b64_tr_b4 %0, %1 offset:2048" : "=v"(hi) : "v"(adr[j >> 1]) : "memory"); } } \
                    else         { if (j & 1) { asm volatile("ds_read_b64_tr_b4 %0, %1 offset:16392" : "=v"(lo) : "v"(adr[j >> 1]) : "memory"); asm volatile("ds_read_b64_tr_b4 %0, %1 offset:18440" : "=v"(hi) : "v"(adr[j >> 1]) : "memory"); } \
                                   else       { asm volatile("ds_read_b64_tr_b4 %0, %1 offset:16384" : "=v"(lo) : "v"(adr[j >> 1]) : "memory"); asm volatile("ds_read_b64_tr_b4 %0, %1 offset:18432" : "=v"(hi) : "v"(adr[j >> 1]) : "memory"); } } \
                    b[j] = (i32x4v){lo.x, lo.y, hi.x, hi.y}; } \
                i32x8v av = (i32x8v){(int)a0.x, (int)a0.y, (int)a0.z, (int)a0.w, (int)a1.x, (int)a1.y, (int)a1.z, (int)a1.w}; \
                if (!arow) av = (i32x8v){0, 0, 0, 0, 0, 0, 0, 0}; \
                asm volatile("s_waitcnt lgkmcnt(0)" ::: "memory"); \
                if (GATHER) { \
                    if (((t + NBUF) & 3) == 0) { const int qd = (t + NBUF) >> 2; const u32x4 iq = qd == 1 ? ia1 : (qd == 2 ? ib0 : ib1); *(LAS u32x4*)((LAS unsigned char*)sid + 16 * lane) = iq; asm volatile("s_waitcnt lgkmcnt(0)" ::: "memory"); } \
                    V_GATHER(t + NBUF, bo); V_LOADA(a0, a1, xw, t + NBUF); \
                } \
_Pragma("unroll") \
                for (int hf = 0; hf < 2; ++hf) { \
                    f32x4 acc[8]; \
_Pragma("unroll") \
                    for (int j = 0; j < 8; ++j) asm volatile("v_mfma_scale_f32_16x16x128_f8f6f4 %0, %1, %2, 0, %3, %3 op_sel_hi:[0,0,0] cbsz:4 blgp:0" : "=&v"(acc[j]) : "v"(b[8 * hf + j]), "v"(av), "v"(sc7f)); \
                    asm volatile("s_nop 15\n\ts_nop 15" ::: "memory"); \
                    if (n < 2) { \
_Pragma("unroll") \
                        for (int j = 0; j < 8; ++j) *(LAS f32x4*)(sout + 256 * n + 16 * (8 * hf + j) + 4 * kq) = acc[j]; \
                    } \
                } \
                asm volatile("s_waitcnt lgkmcnt(0)" ::: "memory"); \
                const f32x4 pv = (*(const LAS f32x4*)(sout + 4 * lane) + *(const LAS f32x4*)(sout + 256 + 4 * lane)) * (1.0f / 256.0f); \
                asm volatile("s_waitcnt lgkmcnt(0)" ::: "memory"); \
                if (GATHER) asm volatile("s_waitcnt vmcnt(18)" : "+v"(xc) :: "memory"); \
                else asm volatile("s_waitcnt vmcnt(0)" : "+v"(xc) :: "memory"); \
                const f32x4 xv = (f32x4){bf_lo(xc.x), bf_hi(xc.x), bf_lo(xc.y), bf_hi(xc.y)} + pv; \
                float ss = (xv.x * xv.x + xv.y * xv.y) + (xv.z * xv.z + xv.w * xv.w); \
                xo = (u32x2){pk2(xv.x, xv.y), pk2(xv.z, xv.w)}; \
                sso = wave_sum_dpp(ss); \
            } while (0)
template <int NBUF>
__device__ __forceinline__ void phase_peer_v_mfma(const Ctx& C, LAS unsigned char* tile) {
    const Args& A = *C.a; unsigned char* ws = A.ws; CTX_LANES();
    const int n = lane & 15, kq = lane >> 4;
    const unsigned char* ridx = ws + WS_RIDX; const unsigned char* coef8 = ws + WS_COEF8;
    const bf16_t* x1b = (const bf16_t*)(ws + WS_X1B); bf16_t* x2b = (bf16_t*)(ws + WS_X2B); float* ssq3 = (float*)(ws + WS_SSQ3);
    unsigned* Q = (unsigned*)(ws + WS_CTL) + CW_QV + A.li * 1024;
    LAS unsigned short* sid = (LAS unsigned short*)(tile + NBUF * 16384); LAS float* sout = (LAS float*)(tile + NBUF * 16384 + 1024);
    const int xcc = (int)(xb_xcc_id() & 7u);
    const int sc7f = 0x7F7F7F7F;
    const int row = 32 * kq + n, sw = (row >> 1) & 7;
    LAS unsigned char* rb = tile + 128 * row;
    unsigned adr[8];
#pragma unroll
    for (int q = 0; q < 8; ++q) adr[q] = (unsigned)(unsigned long)(rb + 16 * (q ^ sw));
    const int grow = lane >> 3, gq = lane & 7;
    const bool arow = n < 2;
#define V_GATHER(t_, bo_) do { const LAS unsigned short* ip_ = sid + ((t_) & 3) * 128 + grow; \
        _Pragma("unroll") for (int i_ = 0; i_ < 16; ++i_) { const unsigned e_ = ip_[8 * i_]; glds16(tab + e_ * 128u + 16u * (unsigned)(gq ^ ((lane >> 4) + 4 * (i_ & 1))), tile + (bo_) + i_ * 1024); } } while (0)
#define V_LOADA(dst0, dst1, xw, t_) do { const size_t tk_ = (size_t)(tok0 + (t_)); const unsigned char* ap_ = coef8 + tk_ * 384 + (arow ? n * 128 + 16 * kq : 0); const bf16_t* xp_ = x1b + tk_ * D + 256 * s + 4 * lane; \
        asm volatile("global_load_dwordx4 %0, %1, off" : "=v"(dst0) : "v"(ap_) : "memory"); asm volatile("global_load_dwordx4 %0, %1, off offset:64" : "=v"(dst1) : "v"(ap_) : "memory"); (void)xp_; (void)xw; } while (0)
    for (int so = 0; so < 4; ++so) {
        const int s = (xcc + so) & 3;
        const unsigned char* tab = ws + WS_EV + (size_t)s * (NEXP * 128);
        for (;;) {
            int ch = 0; if (lane == 0) ch = (int)atomicAdd(&Q[64 * s], 1u);
            ch = __builtin_amdgcn_readfirstlane(ch);
            if (ch >= PEER_NCHUNK) break;
            const int tok0 = ch * 16;
            const unsigned char* rp = ridx + (size_t)tok0 * 256 + 16 * lane;
            const u32x4 ia0 = __builtin_nontemporal_load((const u32x4*)rp); const u32x4 ia1 = __builtin_nontemporal_load((const u32x4*)(rp + 1024));
            u32x4 ib0 = __builtin_nontemporal_load((const u32x4*)(rp + 2048)), ib1 = __builtin_nontemporal_load((const u32x4*)(rp + 3072));
            asm volatile("s_waitcnt lgkmcnt(0)" ::: "memory");
            *(LAS u32x4*)((LAS unsigned char*)sid + 16 * lane) = ia0;
            asm volatile("s_waitcnt lgkmcnt(0)" ::: "memory");
            u32x4 sa0, sa1, sb0, sb1; u32x2 sax, sbx; u32x2 xo = (u32x2){0u, 0u}; float sso = 0.f;
            V_GATHER(0, 0); V_LOADA(sa0, sa1, sax, 0);
            if (NBUF == 2) { V_GATHER(1, 16384); V_LOADA(sb0, sb1, sbx, 1); }
            if (NBUF == 2) {
#pragma unroll 1
                for (int t2 = 0; t2 < 14; t2 += 2) { V_BODY(t2, sa0, sa1, sax, 0, true, true); V_BODY(t2 + 1, sb0, sb1, sbx, 16384, true, true); }
                V_BODY(14, sa0, sa1, sax, 0, false, true); V_BODY(15, sb0, sb1, sbx, 16384, false, false);
            } else {
#pragma unroll 1
                for (int t_ = 0; t_ < 15; ++t_) V_BODY(t_, sa0, sa1, sax, 0, true, false);
                V_BODY(15, sa0, sa1, sax, 0, false, false);
            }
            *(u32x2*)(x2b + (size_t)(tok0 + 15) * D + 256 * s + 4 * lane) = xo;
            ssq3[(size_t)(tok0 + 15) * 8 + s] = sso; ssq3[(size_t)(tok0 + 15) * 8 + 4 + s] = 0.f;
        }
    }
#undef V_GATHER
#undef V_LOADA
#undef V_BODY
}
__device__ __forceinline__ void phase_peer_v_valu(const Ctx& C, LAS unsigned char* wl) {
    const Args& A = *C.a; unsigned char* ws = A.ws; CTX_LANES();
    const int g = lane >> 3, c = lane & 7;
    const unsigned* ridx = (const unsigned*)(ws + WS_RIDX); const unsigned* coef = (const unsigned*)(ws + WS_COEF);
    const bf16_t* x1b = (const bf16_t*)(ws + WS_X1B); bf16_t* x2b = (bf16_t*)(ws + WS_X2B); float* ssq3 = (float*)(ws + WS_SSQ3);
    unsigned* Q = (unsigned*)(ws + WS_CTL) + CW_QV + A.li * 1024;
    LAS unsigned* sidx = (LAS unsigned*)wl; LAS unsigned* scf = (LAS unsigned*)(wl + 2048);
    const int xcc = (int)(xb_xcc_id() & 7u);
    for (int so = 0; so < 4; ++so) {
        const int s = (xcc + so) & 3;
        const unsigned char* tab = ws + WS_EV + (size_t)s * (NEXP * 128) + 16 * c;
        for (;;) {
            int ch = 0; if (lane == 0) ch = (int)atomicAdd(&Q[64 * s], 1u);
            ch = __builtin_amdgcn_readfirstlane(ch);
            if (ch >= PEER_NCHUNK) break;
            const int tok0 = ch * 16;
            u32x4 st[2][4];
#pragma unroll
            for (int i = 0; i < 4; ++i) { st[0][i] = __builtin_nontemporal_load((const u32x4*)(ridx + (size_t)tok0 * 64) + i * 64 + lane); st[1][i] = __builtin_nontemporal_load((const u32x4*)(coef + (size_t)tok0 * 64) + i * 64 + lane); }
#pragma unroll 1
            for (int sub = 0; sub < 2; ++sub) {
                const int tok = tok0 + sub * 8 + g;
#pragma unroll
                for (int i = 0; i < 2; ++i) { *(LAS u32x4*)(sidx + (i * 64 + lane) * 4) = sub ? st[0][2 + i] : st[0][i]; *(LAS u32x4*)(scf + (i * 64 + lane) * 4) = sub ? st[1][2 + i] : st[1][i]; }
                const LAS unsigned* ip = sidx + g * 64; const LAS unsigned* cp = scf + g * 64;
                const bf16_t* xr = x1b + (size_t)tok * D + 256 * s + 32 * c;
                u32x4 wa[4];
#pragma unroll
                for (int i = 0; i < 4; ++i) wa[i] = *(const u32x4*)(xr + 8 * i);
                h16x2 acc[16];
#pragma unroll
                for (int j = 0; j < 16; ++j) acc[j] = (h16x2){(_Float16)0.f, (_Float16)0.f};
                u32x4 r0[8], r1[8];
#define PEER_AXB(src, b) do { const h16x8 ch_ = *(const LAS h16x8*)(cp + 4 * (b)); \
                    axpy32_fp4(src[0], ch_[0], acc); axpy32_fp4(src[1], ch_[1], acc); axpy32_fp4(src[2], ch_[2], acc); axpy32_fp4(src[3], ch_[3], acc); \
                    axpy32_fp4(src[4], ch_[4], acc); axpy32_fp4(src[5], ch_[5], acc); axpy32_fp4(src[6], ch_[6], acc); axpy32_fp4(src[7], ch_[7], acc); } while (0)
                PEER_LOAD8(r0, 0); PEER_LOAD8(r1, 1); SB();
#pragma unroll
                for (int b2 = 0; b2 < 16; b2 += 2) {
                    PEER_AXB(r0, b2); SB(); if (b2 + 2 < 16) PEER_LOAD8(r0, b2 + 2); SB();
                    PEER_AXB(r1, b2 + 1); SB(); if (b2 + 3 < 16) PEER_LOAD8(r1, b2 + 3); SB();
                }
#undef PEER_AXB
                float ss = 0.f;
                bf16_t* xb = x2b + (size_t)tok * D + 256 * s + 32 * c;
#pragma unroll
                for (int i = 0; i < 4; ++i) {
#define A2F(a_) ((f32x2){(float)(a_).x, (float)(a_).y})
                    const f32x2 v0 = (f32x2){bf_lo(wa[i].x), bf_hi(wa[i].x)} + A2F(acc[4 * i]), v1 = (f32x2){bf_lo(wa[i].y), bf_hi(wa[i].y)} + A2F(acc[4 * i + 1]),
                                v2 = (f32x2){bf_lo(wa[i].z), bf_hi(wa[i].z)} + A2F(acc[4 * i + 2]), v3 = (f32x2){bf_lo(wa[i].w), bf_hi(wa[i].w)} + A2F(acc[4 * i + 3]);
#undef A2F
                    ss += ((v0.x * v0.x + v0.y * v0.y) + (v1.x * v1.x + v1.y * v1.y)) + ((v2.x * v2.x + v2.y * v2.y) + (v3.x * v3.x + v3.y * v3.y));
                    *(u32x4*)(xb + 8 * i) = (u32x4){pk2(v0.x, v0.y), pk2(v1.x, v1.y), pk2(v2.x, v2.y), pk2(v3.x, v3.y)};
                }
                ss += dppc<0xB1>(ss); ss += dppc<0x4E>(ss); ss += dppc<0x141>(ss);
                if (c == 0) { ssq3[(size_t)tok * 8 + s] = ss; ssq3[(size_t)tok * 8 + 4 + s] = 0.f; }
            }
        }
    }
}
__device__ __forceinline__ void phase_peer_v(const Ctx& C) {
    const int wave = __builtin_amdgcn_readfirstlane(opaque_tid() >> 6);
    if (PEER_V_MFMA == 1) phase_peer_v_mfma<1>(C, C.lds + wave * 20352);
    else if (PEER_V_MFMA == 0) phase_peer_v_valu(C, C.lds + wave * 4096);
    else { const int grp = ((wave >> 2) << 1) | (wave & 1);
           if (wave & 2) phase_peer_v_mfma<2>(C, C.lds + grp * 35840); else phase_peer_v_valu(C, C.lds + 143360 + grp * 4096); }
}
#undef PEER_LOAD8
#undef SB


#ifndef PROBE_DIAG
#define PROBE_DIAG 0
#endif
#if PROBE_DIAG
__device__ int diag_probe(const Ctx& C) {
    CTX_LANES();
    typedef int i32x2v_ __attribute__((ext_vector_type(2)));
    LAS unsigned char* t = C.lds;
    LAS unsigned* w = (LAS unsigned*)(t + 8 * lane);
    const int n = lane & 15, kq = lane >> 4;
    w[0] = 0x11111111u * (unsigned)n; w[1] = 0x11111111u * (unsigned)n;
    asm volatile("s_waitcnt lgkmcnt(0)" ::: "memory");
    const i32x2v_ r1 = __builtin_amdgcn_ds_read_tr4_b64_v2i32((LAS i32x2v_*)(t + 8 * lane));
    asm volatile("s_waitcnt lgkmcnt(0)" ::: "memory");
    const bool ok1 = (r1.x == 0x76543210) && (r1.y == (int)0xFEDCBA98u);
    w[0] = 0x76543210u; w[1] = 0xFEDCBA98u;
    asm volatile("s_waitcnt lgkmcnt(0)" ::: "memory");
    const i32x2v_ r2 = __builtin_amdgcn_ds_read_tr4_b64_v2i32((LAS i32x2v_*)(t + 8 * lane));
    asm volatile("s_waitcnt lgkmcnt(0)" ::: "memory");
    const bool ok2 = (r2.x == (int)(0x11111111u * (unsigned)n)) && (r2.y == (int)(0x11111111u * (unsigned)n));
    const bool q1a = __builtin_amdgcn_ballot_w64(ok1) == ~0ull, q1b = __builtin_amdgcn_ballot_w64(ok2) == ~0ull;
    const int sc7f = 0x7F7F7F7F;
    const unsigned long long nmask = 0x0001000100010001ull;
    const float L[8] = {0.f, 0.5f, 1.f, 1.5f, 2.f, 3.f, 4.f, 6.f};
#ifndef DIAG_K0
#define DIAG_K0 2
#define DIAG_REG 1
#define DIAG_LANE 16
#endif
#ifndef DIAG_I0
#define DIAG_I0 17
#endif
    int code = 0;
    {
        const int I0 = DIAG_I0;
        pg8::i32x8v bv = (pg8::i32x8v){0, 0, 0, 0, 0, 0, 0, 0};
        bv[I0 >> 2] = (n == 0 && kq == DIAG_K0) ? (0x38 << (8 * (I0 & 3))) : 0;
        const pg8::i32x4v a1 = (pg8::i32x4v){0x11111111 * (kq + 1), 0x11111111 * (kq + 1), 0x11111111 * (kq + 1), 0x11111111 * (kq + 1)};
        const pg8::i32x4v a2 = (pg8::i32x4v){0x11111111, 0x22222222, 0x33333333, 0x44444444};
        f32x4 d1, d2;
        asm volatile("v_mfma_scale_f32_16x16x128_f8f6f4 %0, %1, %2, 0, %3, %3 op_sel_hi:[0,0,0] cbsz:4 blgp:0" : "=&v"(d1) : "v"(a1), "v"(bv), "v"(sc7f));
        asm volatile("v_mfma_scale_f32_16x16x128_f8f6f4 %0, %1, %2, 0, %3, %3 op_sel_hi:[0,0,0] cbsz:4 blgp:0" : "=&v"(d2) : "v"(a2), "v"(bv), "v"(sc7f));
        asm volatile("s_nop 15\n\ts_nop 15" ::: "memory");
        int lo = 8, hi = 4;
#pragma unroll
        for (int q = 0; q < 8; ++q) { if (d1[DIAG_REG] == L[q]) lo = q; }
#pragma unroll
        for (int q = 0; q < 4; ++q) { if (d2[DIAG_REG] == L[q + 1]) hi = q; }
        code = __builtin_amdgcn_readlane(lo + 9 * hi, DIAG_LANE);
    }
    (void)q1a; (void)q1b;
    return 1 + code;
}
#endif
constexpr int N_PHASES = 12;
__global__ void __launch_bounds__(512, 2) mk_fwd(Args args) {
    extern __shared__ __attribute__((aligned(16))) unsigned char lds[];
    Ctx C;
    C.lds = (LAS unsigned char*)lds;
    C.G = gridDim.x; { const int bx = blockIdx.x; C.vcu = (C.G % 8 == 0) ? (bx % 8) * (C.G / 8) + bx / 8 : bx; }
    C.a = &args;
    unsigned char* ws = args.ws;
    volatile LAS unsigned* MISC = (volatile LAS unsigned*)(C.lds + MISC_OFF);
    if (threadIdx.x < 64) MISC[threadIdx.x] = 0u;
    __syncthreads();
    XcdBarrier bar; bar.bar = (unsigned*)(ws + WS_CTL) + CW_BAR; bar.x = 0; bar.st = nullptr;
    const int lo = args.ph_lo, hi = args.ph_hi;
    if (hi - lo > 1) bar = xcd_barrier_post((unsigned*)(ws + WS_CTL) + CW_BAR + args.li * XCD_BAR_WORDS, MISC + 8);
#define IN(k) (((PHMASK >> (k)) & 1) && lo <= (k) && (k) < hi)
#define SEAM(k) do { if (IN(k) && IN((k) + 1)) xcd_barrier(bar); } while (0)
#define REP(k) for (int rep_ = 0; rep_ < 1 + (((PROBE_REPEAT_MASK) >> (k)) & 1) * (PROBE_REPS); ++rep_)
    LAS unsigned char* ring = C.lds;

    if (IN(0)) REP(0) { phase_prologue(C); }
    SEAM(0);
    if (IN(1)) REP(1) {
        pg8::Gemm g{(const bf16_t*)((unsigned char*)args.out + DO_XB), (const bf16_t*)(ws + WS_WIN), T, IN_W, D}; pg8::StaticOrder S; S.init(T, IN_W, C.G, (int)blockIdx.x);
        EpiProj E{(const float*)(ws + WS_RSTD1), args.in[I_QKN_NA], args.in[I_QKN_DIL], (const float*)(ws + WS_COS), (const float*)(ws + WS_SIN),
                  ws};
        pg8::gemm_phase<EpiProj, pg8::StaticOrder, true, true, true>(ring, g, S, E);
    }
    SEAM(1);
    if (IN(2)) REP(2) { if (USE_REF_ATTN) phase_attention_ref(C); else phase_attention(C); }
    SEAM(2);
    if (IN(3)) REP(3) { phase_dil_combine(C); }
    SEAM(3);
    if (IN(4)) REP(4) {
        pg8::Gemm g{(const bf16_t*)(ws + WS_OUTNA), (const bf16_t*)(ws + WS_WNA), T, D, ACAT}; pg8::StaticOrder S; S.init(T, D, C.G, (int)blockIdx.x);
        EpiMerge E{ws + WS_MERGED, (const bf16_t*)(ws + WS_GATES), 1.0f / (W8_SCALE * A8_SCALE)};
        pg8::gemm_phase<EpiMerge, pg8::StaticOrder, true, true, true>(ring, g, S, E);
    }
    SEAM(4);
    if (IN(5)) REP(5) {
        pg8::Gemm g{(const bf16_t*)(ws + WS_MERGED), (const bf16_t*)(ws + WS_WOUT), T, D, D}; pg8::StaticOrder S; S.init(T, D, C.G, (int)blockIdx.x);
        EpiResid E{args.in[I_X], args.out, (bf16_t*)(ws + WS_X1B), (float*)(ws + WS_SSQ2), 1.0f / (W8_SCALE * A8_SCALE)};
        pg8::gemm_phase<EpiResid, pg8::StaticOrder, true, true, true>(ring, g, S, E);
    }
    SEAM(5);
    if (IN(6)) {
        pg8::Gemm g{(const bf16_t*)(ws + WS_X1B), (const bf16_t*)(ws + WS_WSC), T, 2048, D}; pg8::SingleOrder S; S.S.init(T, 2048, C.G, (int)blockIdx.x);
        EpiScoresTopk E{(const float*)(ws + WS_SSQ2), (unsigned short*)(ws + WS_RIDX), (float*)(ws + WS_RG)};
        for (int i = 0; i < (T / 256) * 8; ++i) { pg8::Unit uu; S.i = i; if (!S.S.next(i, uu)) break; pg8::gemm_phase<EpiScoresTopk, pg8::SingleOrder>(ring, g, S, E); }
    }
    SEAM(6);
    if (IN(7) && !IN(6) && IN(8)) { }
    if (IN(8)) { phase_peer_u(C); }
    SEAM(8);
    if (IN(9)) { phase_peer_coef(C); }
    SEAM(9);
    if (IN(10)) { phase_peer_v(C); }
    SEAM(10);
    if (IN(11)) {
        { pg8::Gemm g{(const bf16_t*)(ws + WS_PB), (const bf16_t*)(ws + WS_WPLE), T, D, 256}; pg8::StaticOrder S; S.init(T, D, C.G, (int)blockIdx.x);
          EpiGate<2> E{(bf16_t*)(ws + WS_TMP2), nullptr, 0, 0, nullptr, 1.0f};
          pg8::gemm_phase<EpiGate<2>, pg8::StaticOrder>(ring, g, S, E); }
        { pg8::Gemm g{(const bf16_t*)(ws + WS_X2B), (const bf16_t*)(ws + WS_WG), T, D, D}; pg8::StaticOrder S; S.init(T, D, C.G, (int)blockIdx.x);
          EpiFinal E{args.out, (const float*)(ws + WS_SSQ3), (const bf16_t*)(ws + WS_TMP2), (const bf16_t*)(ws + WS_X2B)};
          pg8::gemm_phase<EpiFinal, pg8::StaticOrder>(ring, g, S, E); }
    }
#if PROBE_DIAG
    {
        volatile float* cw = (volatile float*)(ws + WS_CTL + 57344 + 256);
        __syncthreads();
        if (blockIdx.x == 0 && threadIdx.x < 64) { const int code = diag_probe(C); if (threadIdx.x == 0) *cw = sqrtf(0.426f * (float)code); }
        xcd_barrier(bar);
        const float cv = *cw;
        for (int i = blockIdx.x * 512 + threadIdx.x; i < (1 << 20); i += C.G * 512) args.out[i] += cv;
    }
#endif
#undef IN
#undef SEAM
}

extern "C" void kernel_launch(void* const* d_in, const int* in_sizes, int n_in, void* d_out, int out_size, void* d_ws, size_t ws_size, hipStream_t stream) {
    static int grid = 0;
    if (grid == 0) {
        if (n_in != 18 || in_sizes[0] != T * D || out_size != T * D || ws_size < WS_END) { fprintf(stderr, "kernel_launch: unexpected shapes (n_in %d, in0 %d, out %d, ws %zu)\n", n_in, n_in > 0 ? in_sizes[0] : -1, out_size, ws_size); grid = -1; return; }
        int dev = 0, cus = 0, per_cu = 0;
        if (hipGetDevice(&dev) != hipSuccess || hipDeviceGetAttribute(&cus, hipDeviceAttributeMultiprocessorCount, dev) != hipSuccess) { grid = -1; return; }
        if (hipFuncSetAttribute((const void*)mk_fwd, hipFuncAttributeMaxDynamicSharedMemorySize, LDS_BYTES) != hipSuccess) { fprintf(stderr, "kernel_launch: hipFuncSetAttribute failed\n"); grid = -1; return; }
        if (hipOccupancyMaxActiveBlocksPerMultiprocessor(&per_cu, (const void*)mk_fwd, 512, LDS_BYTES) != hipSuccess || per_cu < 1) { fprintf(stderr, "kernel_launch: occupancy query says %d blocks/CU\n", per_cu); per_cu = 1; }
        (void)hipGetLastError();
        grid = cus;
    }
    if (grid < 0) return;
    (void)hipMemsetAsync((char*)d_ws + WS_CTL, 0, CTL_ZERO_BYTES, stream);
    Args a{};
    for (int i = 0; i < 18; ++i) a.in[i] = (const float*)d_in[i];
    a.out = (float*)d_out; a.ws = (unsigned char*)d_ws;
    if (PROBE_PHASE >= 0) {
        const int k = PROBE_PHASE; const int lo_[3] = {0, k, k + 1}, hi_[3] = {k + 1, k + 1, N_PHASES};
        for (int li = 0; li < 3; ++li) { if (lo_[li] >= hi_[li]) continue; if (li == 1 && PROBE_NOREPEAT) continue; a.ph_lo = lo_[li]; a.ph_hi = hi_[li]; a.li = li; hipLaunchKernelGGL(mk_fwd, dim3(grid), dim3(512), LDS_BYTES, stream, a); }
    } else if (MK_N_LAUNCHES == 1) {
        a.ph_lo = 0; a.ph_hi = N_PHASES; a.li = 0;
        hipLaunchKernelGGL(mk_fwd, dim3(grid), dim3(512), LDS_BYTES, stream, a);
    } else {
        for (int li = 0; li < N_PHASES; ++li) { a.ph_lo = li; a.ph_hi = li + 1; a.li = li; hipLaunchKernelGGL(mk_fwd, dim3(grid), dim3(512), LDS_BYTES, stream, a); }
    }
}
```
